# Optimizing an MI355X kernel written in HIP

```python
import math
import jax, jax.numpy as jnp
from jax import lax
import numpy as np

D_MODEL = 1024
BATCH = 1
SEQ = 16384
DEPTH = 1
DEC_BATCH = 16
DEC_SEQ = 16
PAST_LEN = 4096

CHUNK = 64
N_META = 16
D_MIX = D_MODEL
D_LRU = D_MIX // 2
LRU_BLOCKS = 8
LRU_BLK = D_LRU // LRU_BLOCKS
CONV_W = 4
LRU_C = 8.0
N_HEADS = 4
HEAD_DIM = 64
V_DIM = 2 * HEAD_DIM
D_QK = N_HEADS * 2 * HEAD_DIM
D_ATT = N_HEADS * V_DIM
D_IN = 2 * D_LRU + 2 * D_QK + 2 * D_ATT
SPLITS = (D_LRU, 2 * D_LRU, 2 * D_LRU + D_QK, 2 * D_LRU + 2 * D_QK, 2 * D_LRU + 2 * D_QK + D_ATT)
Q_BLOCK = 128
ROPE_THETA = 10000.0
EPS = 1e-6
SCALE = HEAD_DIM ** -0.5
NEG_INF = -1e30

kernel_name = 'hybrid_rglru_diffattn_stream'


def lambda_init(layer_idx):
    return 0.8 - 0.6 * math.exp(-0.3 * layer_idx)


def rmsnorm(x, w):
    xf = x.astype(jnp.float32)
    y = xf * lax.rsqrt(jnp.mean(xf * xf, axis=-1, keepdims=True) + EPS)
    return (y * w.astype(jnp.float32)).astype(x.dtype)


def rope(x, pos):
    half = HEAD_DIM // 2
    inv = ROPE_THETA ** (-jnp.arange(0, HEAD_DIM, 2, dtype=jnp.float32) / HEAD_DIM)
    ang = pos.astype(jnp.float32)[:, None] * inv[None, :]
    cos = jnp.cos(ang)[None, :, None, None, :]
    sin = jnp.sin(ang)[None, :, None, None, :]
    xf = x.astype(jnp.float32)
    x1, x2 = xf[..., :half], xf[..., half:]
    return jnp.concatenate([x1 * cos - x2 * sin, x1 * sin + x2 * cos], axis=-1).astype(x.dtype)


def rglru_branch(xa, conv_prev, h0, conv_w, conv_b, ga_w, ga_b, gx_w, gx_b, lru_lam):
    B, T, _ = xa.shape
    xp = jnp.concatenate([conv_prev.astype(xa.dtype), xa], axis=1)
    conv = conv_b + sum(xp[:, j:j + T] * conv_w[j] for j in range(CONV_W))
    cf = conv.astype(jnp.float32)
    cb = cf.reshape(B, T, LRU_BLOCKS, LRU_BLK)
    r = jax.nn.sigmoid(jnp.einsum('btnc,ncd->btnd', cb, ga_w.astype(jnp.float32)) + ga_b.astype(jnp.float32)).reshape(B, T, D_LRU)
    i = jax.nn.sigmoid(jnp.einsum('btnc,ncd->btnd', cb, gx_w.astype(jnp.float32)) + gx_b.astype(jnp.float32)).reshape(B, T, D_LRU)
    log_a = -LRU_C * r * jax.nn.softplus(-lru_lam.astype(jnp.float32))
    a = jnp.exp(log_a)
    b = jnp.sqrt(-jnp.expm1(2.0 * log_a)) * (i * cf)
    b = b.at[:, 0].add(a[:, 0] * h0.astype(jnp.float32))
    def combine(u, v):
        return (u[0] * v[0], v[0] * u[1] + v[1])
    h = lax.associative_scan(combine, (a, b), axis=1)[1]
    return h.astype(xa.dtype), h[:, -1].astype(h0.dtype), xp[:, -(CONV_W - 1):]


def diff_core(q, k, v, mask, lam):
    s = jnp.einsum('bqhcd,bkhcd->bhcqk', q.astype(jnp.float32), k.astype(jnp.float32)) * SCALE
    if mask is not None:
        s = jnp.where(mask, s, NEG_INF)
    p = jax.nn.softmax(s, axis=-1)
    pd = p[:, :, 0] - lam * p[:, :, 1]
    o = jnp.einsum('bhqk,bkhe->bqhe', pd, v.astype(jnp.float32))
    return o.astype(v.dtype)


def attend_prompt(q, k, v, lam):
    B, T = q.shape[0], q.shape[1]
    S = T - N_META
    n_blk = S // Q_BLOCK
    chunk_k = jnp.concatenate([jnp.full((N_META,), -1, jnp.int32), jnp.arange(S, dtype=jnp.int32) // CHUNK])
    o_meta = diff_core(q[:, :N_META], k[:, :N_META], v[:, :N_META], None, lam)
    qb = q[:, N_META:].reshape(B, n_blk, Q_BLOCK, N_HEADS, 2, HEAD_DIM).transpose(1, 0, 2, 3, 4, 5)
    def block(args):
        qi, bi = args
        chunk_q = (bi * Q_BLOCK + jnp.arange(Q_BLOCK, dtype=jnp.int32)) // CHUNK
        mask = chunk_k[None, :] <= chunk_q[:, None]
        return diff_core(qi, k, v, mask, lam)
    ob = lax.map(block, (qb, jnp.arange(n_blk, dtype=jnp.int32)))
    o_real = ob.transpose(1, 0, 2, 3, 4).reshape(B, S, N_HEADS, V_DIM)
    return jnp.concatenate([o_meta, o_real], axis=1)


def layer_forward(x, pos, h0, conv_prev, kv_past, lw, layer_idx):
    (norm_w, w_in, w_out, conv_w, conv_b, ga_w, ga_b, gx_w, gx_b, lru_lam,
     qn_w, kn_w, lq1, lk1, lq2, lk2, subln_w) = lw
    B, T, _ = x.shape
    u = rmsnorm(x, norm_w) @ w_in
    xa, ga, q, k, v, gb = jnp.split(u, SPLITS, axis=-1)
    h_seq, h_last, conv_tail = rglru_branch(xa, conv_prev, h0, conv_w, conv_b, ga_w, ga_b, gx_w, gx_b, lru_lam)
    y_a = h_seq * jax.nn.silu(ga)
    q = rope(rmsnorm(q.reshape(B, T, N_HEADS, 2, HEAD_DIM), qn_w), pos)
    k = rope(rmsnorm(k.reshape(B, T, N_HEADS, 2, HEAD_DIM), kn_w), pos)
    v = v.reshape(B, T, N_HEADS, V_DIM)
    lam0 = lambda_init(layer_idx)
    lam = (jnp.exp(jnp.sum(lq1.astype(jnp.float32) * lk1.astype(jnp.float32)))
           - jnp.exp(jnp.sum(lq2.astype(jnp.float32) * lk2.astype(jnp.float32))) + lam0)
    if kv_past is None:
        o = attend_prompt(q, k, v, lam)
    else:
        k_all = jnp.concatenate([kv_past[0].astype(k.dtype), k], axis=1)
        v_all = jnp.concatenate([kv_past[1].astype(v.dtype), v], axis=1)
        o = diff_core(q, k_all, v_all, None, lam)
    o = rmsnorm(o, subln_w) * (1.0 - lam0)
    y_b = o.reshape(B, T, D_ATT) * jax.nn.silu(gb)
    y = x + jnp.concatenate([y_a, y_b], axis=-1) @ w_out
    return y, k, v, h_last, conv_tail


def setup_inputs(seed: int = 0) -> dict:
    key = jax.random.key(seed)
    ks = jax.random.split(key, 24)
    f32 = jnp.float32
    nrm = lambda kk, shape, s: jax.random.normal(kk, shape, f32) * s
    u = jax.random.uniform(ks[16], (DEPTH, D_LRU), f32, minval=0.9, maxval=0.999)
    return {
        'x_prompt': nrm(ks[0], (BATCH, SEQ, D_MODEL), 1.0),
        'x_sample': nrm(ks[1], (DEC_BATCH, DEC_SEQ, D_MODEL), 1.0),
        'cache_k': nrm(ks[2], (DEPTH, DEC_BATCH, PAST_LEN, N_HEADS, 2, HEAD_DIM), 1.0),
        'cache_v': nrm(ks[3], (DEPTH, DEC_BATCH, PAST_LEN, N_HEADS, V_DIM), 1.0),
        'state_h': nrm(ks[4], (DEPTH, DEC_BATCH, D_LRU), 0.5),
        'state_conv': nrm(ks[5], (DEPTH, DEC_BATCH, CONV_W - 1, D_LRU), 1.0),
        'meta_tokens': nrm(ks[6], (N_META, D_MODEL), 1.0),
        'norm_w': 1.0 + nrm(ks[7], (DEPTH, D_MODEL), 0.02),
        'w_in': nrm(ks[8], (DEPTH, D_MODEL, D_IN), D_MODEL ** -0.5),
        'w_out': nrm(ks[9], (DEPTH, D_MIX, D_MODEL), D_MIX ** -0.5),
        'conv_w': nrm(ks[10], (DEPTH, CONV_W, D_LRU), CONV_W ** -0.5),
        'conv_b': nrm(ks[11], (DEPTH, D_LRU), 0.01),
        'gate_a_w': nrm(ks[12], (DEPTH, LRU_BLOCKS, LRU_BLK, LRU_BLK), LRU_BLK ** -0.5),
        'gate_a_b': nrm(ks[13], (DEPTH, LRU_BLOCKS, LRU_BLK), 0.01),
        'gate_x_w': nrm(ks[14], (DEPTH, LRU_BLOCKS, LRU_BLK, LRU_BLK), LRU_BLK ** -0.5),
        'gate_x_b': nrm(ks[15], (DEPTH, LRU_BLOCKS, LRU_BLK), 0.01),
        'lru_lambda': jnp.log(u) - jnp.log1p(-u),
        'q_norm_w': 1.0 + nrm(ks[17], (DEPTH, HEAD_DIM), 0.02),
        'k_norm_w': 1.0 + nrm(ks[18], (DEPTH, HEAD_DIM), 0.02),
        'lambda_q1': nrm(ks[19], (DEPTH, HEAD_DIM), 0.1),
        'lambda_k1': nrm(ks[20], (DEPTH, HEAD_DIM), 0.1),
        'lambda_q2': nrm(ks[21], (DEPTH, HEAD_DIM), 0.1),
        'lambda_k2': nrm(ks[22], (DEPTH, HEAD_DIM), 0.1),
        'subln_w': 1.0 + nrm(ks[23], (DEPTH, V_DIM), 0.02),
    }


def reference(x_prompt, x_sample, cache_k, cache_v, state_h, state_conv, meta_tokens,
              norm_w, w_in, w_out, conv_w, conv_b, gate_a_w, gate_a_b, gate_x_w, gate_x_b,
              lru_lambda, q_norm_w, k_norm_w, lambda_q1, lambda_k1, lambda_q2, lambda_k2, subln_w):
    B, S, _ = x_prompt.shape
    past = cache_k.shape[2]
    s_new = x_sample.shape[1]
    xp = jnp.concatenate([jnp.broadcast_to(meta_tokens[None].astype(x_prompt.dtype), (B, N_META, D_MODEL)), x_prompt], axis=1)
    xs = x_sample
    pos_p = jnp.arange(N_META + S, dtype=jnp.int32)
    pos_s = past + jnp.arange(s_new, dtype=jnp.int32)
    h_zero = jnp.zeros((B, D_LRU), jnp.float32)
    conv_zero = jnp.zeros((B, CONV_W - 1, D_LRU), x_prompt.dtype)
    kp_l, vp_l, hp_l, cp_l, ks_l, vs_l, hs_l, cs_l = [], [], [], [], [], [], [], []
    for l in range(DEPTH):
        lw = (norm_w[l], w_in[l], w_out[l], conv_w[l], conv_b[l], gate_a_w[l], gate_a_b[l],
              gate_x_w[l], gate_x_b[l], lru_lambda[l], q_norm_w[l], k_norm_w[l],
              lambda_q1[l], lambda_k1[l], lambda_q2[l], lambda_k2[l], subln_w[l])
        xp, kp, vp, hp, cp = layer_forward(xp, pos_p, h_zero, conv_zero, None, lw, l)
        xs, kss, vss, hss, css = layer_forward(xs, pos_s, state_h[l], state_conv[l], (cache_k[l], cache_v[l]), lw, l)
        kp_l.append(kp); vp_l.append(vp); hp_l.append(hp); cp_l.append(cp)
        ks_l.append(kss); vs_l.append(vss); hs_l.append(hss); cs_l.append(css)
    y_prompt = xp[:, N_META:]
    y_sample = xs
    return (y_prompt, y_sample,
            jnp.stack(kp_l), jnp.stack(vp_l), jnp.stack(hp_l), jnp.stack(cp_l),
            jnp.stack(ks_l), jnp.stack(vs_l), jnp.stack(hs_l), jnp.stack(cs_l))
```

```cpp
#include <hip/hip_runtime.h>
#include <hip/hip_cooperative_groups.h>
#include <cstdio>
#include <cstdint>
namespace cg = cooperative_groups;
namespace pg8 {
#define PG8_LAS __attribute__((address_space(3)))
typedef unsigned short bf16_t;
typedef short bf16x8 __attribute__((ext_vector_type(8)));
typedef float f32x4 __attribute__((ext_vector_type(4)));
typedef unsigned u32x4 __attribute__((ext_vector_type(4)));
constexpr int BM = 256, BK = 64, HALF = 128, HTB = HALF * BK * 2  , STAGE_BYTES = 8 * HTB, NXCD = 8, WGM = 8;

__host__ __device__ __forceinline__ int lds_byte(int r, int c) { const int st = (r >> 4) * 2 + (c >> 5), rr = r & 15, cc = c & 31, ob = rr * 64 + cc * 2; return st * 1024 + (ob ^ (((ob >> 9) & 1) << 5)); }
__host__ __device__ __forceinline__ void stage_rc(int b, int& R, int& C) { const int st = b / 1024, sb = b % 1024, swz = sb ^ (((sb >> 9) & 1) << 5); R = (st >> 1) * 16 + swz / 64; C = (st & 1) * 32 + (swz % 64) / 2; }
__host__ __device__ __forceinline__ int perm32(int rho) { const int n = rho >> 4, i = rho & 15; return 8 * (i >> 2) + 4 * n + (i & 3); }

struct Unit { int pm, pn; };
struct Gemm { const bf16_t* A; const bf16_t* Bt; int M, N, K; };

struct StaticOrder {
    int nM, nN, nwg, G, c;
    __host__ __device__ void init(int M, int N, int G_, int c_) { nM = M / BM; nN = N / BM; nwg = nM * nN; G = G_; c = c_; }
    __host__ __device__ bool next(int i, Unit& u) const {
        const long L = (long)i * G + c; if (L >= nwg) return false;
        int wgid = (int)L; { const int q = nwg / NXCD, r = nwg % NXCD, xcd = wgid % NXCD, off = wgid / NXCD; wgid = (xcd < r ? xcd * (q + 1) : r * (q + 1) + (xcd - r) * q) + off; }
        const int nig = WGM * nN, gid = wgid / nig, fm = gid * WGM, gsz = (nM - fm) < WGM ? (nM - fm) : WGM;
        u.pm = fm + ((wgid % nig) % gsz); u.pn = (wgid % nig) / gsz; return true;
    }
    __device__ __forceinline__ void a_ready(const Unit&) const {}
    __device__ __forceinline__ void done(const Unit&) const {}
};

template <class Epi, class Sched, bool ALIGN_EPI = false, bool SP2 = false>
__device__ __forceinline__ void gemm_phase(PG8_LAS unsigned char* lds, const Gemm g, const Sched& S, const Epi& E) {
    const int tid = threadIdx.x, wid = __builtin_amdgcn_readfirstlane(tid >> 6), lane = tid & 63, wr = wid >> 2, wc = wid & 3, fr = lane & 15, fq = lane >> 4;
    const int K = g.K, nt = K / BK;
    unsigned voffA[2], voffB[2];
#pragma unroll
    for (int i = 0; i < 2; ++i) { int R, C; stage_rc(tid * 16 + i * 8192, R, C); const int Rb = Epi::PERM ? ((R & ~31) + perm32(R & 31)) : R;
        voffA[i] = (unsigned)(R * K + C) * 2u; voffB[i] = (unsigned)(Rb * K + C) * 2u; }
    const size_t kstep = (size_t)(BK * 2);
    const size_t hstep = (size_t)HALF * K * 2;
    const size_t tstep = 2 * hstep;
    const unsigned ldsw = (unsigned)wid * 1024u;
    const int aoff = lds_byte(wr * 64 + fr, fq * 8), boff = lds_byte(wc * 32 + fr, fq * 8);
#define PG8_SA(b, h) (((b) * 2 + (h)) * HTB)
#define PG8_SB(b, h) ((4 + (b) * 2 + (h)) * HTB)
#define PG8_STAGE(bufoff, gbase, voff) do { _Pragma("unroll") for (int _i = 0; _i < 2; ++_i) \
        __builtin_amdgcn_global_load_lds((const unsigned*)((const char*)(gbase) + (voff)[_i]), (PG8_LAS unsigned*)(lds + (bufoff) + ldsw + _i * 8192), 16, 0, 0); } while (0)
#define PG8_LDA(dst, b, h) do { _Pragma("unroll") for (int m = 0; m < 4; ++m) _Pragma("unroll") for (int k = 0; k < 2; ++k) dst[m][k] = *(const PG8_LAS bf16x8*)(lds + PG8_SA(b, h) + aoff + m * 2048 + k * 1024); } while (0)
#define PG8_LDB(dst, b, h) do { _Pragma("unroll") for (int n = 0; n < 2; ++n) _Pragma("unroll") for (int k = 0; k < 2; ++k) dst[n][k] = *(const PG8_LAS bf16x8*)(lds + PG8_SB(b, h) + boff + n * 2048 + k * 1024); } while (0)
#define PG8_MMA(ai, bj, At, Bt) do { __builtin_amdgcn_s_setprio(1); _Pragma("unroll") for (int m = 0; m < 4; ++m) _Pragma("unroll") for (int n = 0; n < 2; ++n) _Pragma("unroll") for (int k = 0; k < 2; ++k) \
        acc[ai][bj][m][n] = __builtin_amdgcn_mfma_f32_16x16x32_bf16(Bt[n][k], At[m][k], acc[ai][bj][m][n], 0, 0, 0); __builtin_amdgcn_s_setprio(0); } while (0)
#define PG8_WAIT_V(n) asm volatile("s_waitcnt vmcnt(" #n ")" ::: "memory")
#define PG8_WAIT_L(n) asm volatile("s_waitcnt lgkmcnt(" #n ")" ::: "memory")
#define PG8_BAR __builtin_amdgcn_s_barrier()
#define PG8_SCHED __builtin_amdgcn_sched_barrier(0)
    Unit cur, nxt; int ui = 0;
    if (!S.next(0, cur)) return;
    f32x4 acc[2][2][4][2];
#pragma unroll
    for (int a = 0; a < 2; ++a)
#pragma unroll
        for (int b = 0; b < 2; ++b)
#pragma unroll
            for (int m = 0; m < 4; ++m)
#pragma unroll
                for (int n = 0; n < 2; ++n) acc[a][b][m][n] = (f32x4){0.f, 0.f, 0.f, 0.f};
    bf16x8 At[4][2], B0[2][2], B1[2][2];
    const char* cA = (const char*)g.A + (size_t)cur.pm * tstep; const char* cB = (const char*)g.Bt + (size_t)cur.pn * tstep;
    S.a_ready(cur);
    if constexpr (SP2) {
        PG8_STAGE(PG8_SB(0, 0), cB, voffB); PG8_STAGE(PG8_SB(0, 1), cB + hstep, voffB); PG8_STAGE(PG8_SA(0, 0), cA, voffA); PG8_STAGE(PG8_SA(0, 1), cA + hstep, voffA);
        if (wr == 1) PG8_BAR;
        PG8_WAIT_V(2); PG8_BAR;
        PG8_STAGE(PG8_SB(1, 0), cB + kstep, voffB); PG8_STAGE(PG8_SA(1, 0), cA + kstep, voffA); PG8_STAGE(PG8_SB(1, 1), cB + hstep + kstep, voffB);
        PG8_WAIT_V(6); PG8_BAR;
    } else {
        PG8_STAGE(PG8_SB(0, 0), cB, voffB); PG8_STAGE(PG8_SA(0, 0), cA, voffA); PG8_STAGE(PG8_SB(0, 1), cB + hstep, voffB); PG8_STAGE(PG8_SA(0, 1), cA + hstep, voffA);
        if (wr == 1) PG8_BAR;
        PG8_WAIT_V(4); PG8_BAR;
        PG8_STAGE(PG8_SB(1, 0), cB + kstep, voffB); PG8_STAGE(PG8_SA(1, 0), cA + kstep, voffA); PG8_STAGE(PG8_SB(1, 1), cB + hstep + kstep, voffB);
        PG8_WAIT_V(6); PG8_BAR;
    }
    for (;;) {
        const bool has_next = S.next(ui + 1, nxt);
        const char* nA = has_next ? (const char*)g.A + (size_t)nxt.pm * tstep : cA; const char* nB = has_next ? (const char*)g.Bt + (size_t)nxt.pn * tstep : cB;
        for (int t = 0; t < nt; t += 2) {
            const bool last = (t == nt - 2);
            const char* a1 = cA + (size_t)(t + 1) * kstep;
            const char* a2 = last ? nA : cA + (size_t)(t + 2) * kstep; const char* b2 = last ? nB : cB + (size_t)(t + 2) * kstep;
            const char* a3 = a2 + kstep; const char* b3 = b2 + kstep;
            if (last && has_next) S.a_ready(nxt);
            if constexpr (SP2) {
            PG8_LDB(B0, 0, 0); PG8_LDB(B1, 0, 1); PG8_SCHED; PG8_LDA(At, 0, 0); PG8_STAGE(PG8_SA(1, 1), a1 + hstep, voffA);
            PG8_WAIT_V(8); PG8_WAIT_L(0); PG8_BAR; PG8_MMA(0, 0, At, B0); PG8_MMA(0, 1, At, B1); PG8_BAR; PG8_SCHED;
            PG8_LDA(At, 0, 1); PG8_STAGE(PG8_SB(0, 0), b2, voffB); PG8_STAGE(PG8_SB(0, 1), b2 + hstep, voffB); PG8_STAGE(PG8_SA(0, 0), a2, voffA);
            PG8_WAIT_V(8); PG8_WAIT_L(0); PG8_BAR; PG8_MMA(1, 0, At, B0); PG8_MMA(1, 1, At, B1); PG8_BAR; PG8_SCHED;
            PG8_LDB(B0, 1, 0); PG8_LDB(B1, 1, 1); PG8_SCHED; PG8_LDA(At, 1, 0); PG8_STAGE(PG8_SA(0, 1), a2 + hstep, voffA);
            PG8_WAIT_V(8); PG8_WAIT_L(0); PG8_BAR; PG8_MMA(0, 0, At, B0); PG8_MMA(0, 1, At, B1); PG8_BAR; PG8_SCHED;
            PG8_LDA(At, 1, 1); PG8_STAGE(PG8_SB(1, 0), b3, voffB); PG8_STAGE(PG8_SB(1, 1), b3 + hstep, voffB); PG8_STAGE(PG8_SA(1, 0), a3, voffA);
            PG8_WAIT_V(8); PG8_WAIT_L(0); PG8_BAR; PG8_MMA(1, 0, At, B0); PG8_MMA(1, 1, At, B1); PG8_BAR; PG8_SCHED;
            } else {
            PG8_LDB(B0, 0, 0); PG8_SCHED; PG8_LDA(At, 0, 0); PG8_STAGE(PG8_SA(1, 1), a1 + hstep, voffA);
            PG8_WAIT_L(8); PG8_BAR; PG8_WAIT_L(0); PG8_MMA(0, 0, At, B0); PG8_BAR; PG8_SCHED;
            PG8_LDB(B1, 0, 1); PG8_STAGE(PG8_SB(0, 0), b2, voffB);
            PG8_BAR; PG8_WAIT_L(0); PG8_MMA(0, 1, At, B1); PG8_BAR;
            PG8_LDA(At, 0, 1); PG8_STAGE(PG8_SA(0, 0), a2, voffA);
            PG8_BAR; PG8_WAIT_L(0); PG8_MMA(1, 0, At, B0); PG8_BAR; PG8_SCHED;
            PG8_STAGE(PG8_SB(0, 1), b2 + hstep, voffB);
            PG8_WAIT_V(6); PG8_BAR; PG8_MMA(1, 1, At, B1); PG8_BAR;
            PG8_LDB(B0, 1, 0); PG8_SCHED; PG8_LDA(At, 1, 0); PG8_STAGE(PG8_SA(0, 1), a2 + hstep, voffA);
            PG8_WAIT_L(8); PG8_BAR; PG8_WAIT_L(0); PG8_MMA(0, 0, At, B0); PG8_BAR; PG8_SCHED;
            PG8_LDB(B1, 1, 1); PG8_STAGE(PG8_SB(1, 0), b3, voffB);
            PG8_BAR; PG8_WAIT_L(0); PG8_MMA(0, 1, At, B1); PG8_BAR;
            PG8_LDA(At, 1, 1); PG8_STAGE(PG8_SA(1, 0), a3, voffA);
            PG8_BAR; PG8_WAIT_L(0); PG8_MMA(1, 0, At, B0); PG8_BAR; PG8_SCHED;
            PG8_STAGE(PG8_SB(1, 1), b3 + hstep, voffB);
            PG8_WAIT_V(6); PG8_BAR; PG8_MMA(1, 1, At, B1); PG8_BAR;
            }
        }
        if constexpr (ALIGN_EPI) { if (wr == 0) PG8_BAR; }
        if constexpr (!Epi::AFTER_DRAIN) { E(acc, cur, wr, wc, fr, fq); S.done(cur); }
        if (!has_next) break;
#pragma unroll
        for (int a = 0; a < 2; ++a)
#pragma unroll
            for (int b = 0; b < 2; ++b)
#pragma unroll
                for (int m = 0; m < 4; ++m)
#pragma unroll
                    for (int n = 0; n < 2; ++n) acc[a][b][m][n] = (f32x4){0.f, 0.f, 0.f, 0.f};
        cur = nxt; cA = nA; cB = nB; ++ui;
        if constexpr (ALIGN_EPI) { if (wr == 1) PG8_BAR; }
    }
    PG8_WAIT_V(0);
    if constexpr (!ALIGN_EPI) { if (wr == 0) PG8_BAR; }
    PG8_BAR;
    if constexpr (Epi::AFTER_DRAIN) { E.fused(acc, cur, wr, wc, fr, fq, lds, wid, lane); S.done(cur); }
#undef PG8_SA
#undef PG8_SB
#undef PG8_STAGE
#undef PG8_LDA
#undef PG8_LDB
#undef PG8_MMA
#undef PG8_WAIT_V
#undef PG8_WAIT_L
#undef PG8_BAR
#undef PG8_SCHED
}
}

#define LAS __attribute__((address_space(3)))
typedef unsigned short bf16;
typedef short bf16x8 __attribute__((ext_vector_type(8)));
typedef short s16x4 __attribute__((ext_vector_type(4)));
typedef float f32x4 __attribute__((ext_vector_type(4)));
typedef float f32x16 __attribute__((ext_vector_type(16)));
typedef unsigned u32x4 __attribute__((ext_vector_type(4)));
typedef unsigned u32x2 __attribute__((ext_vector_type(2)));

constexpr int NTHREADS = 512;
constexpr int DM = 1024, NMETA = 16, TP = 16400, NSAMP = 256, MROWS = TP + NSAMP  , MPAD = 16896, PAST = 4096;
constexpr int DL = 512, DIN = 3072;
constexpr float EPS = 1e-6f;
constexpr float C2 = 0.18033688011112042f;
constexpr float LOG2E = 1.4426950408889634f;
constexpr float ONE_M_LAM0 = 0.8f, LAM0 = 0.2f;

constexpr size_t O_YP = 0, O_YS = 16777216, O_KP = 17039360, O_VP = 25436160, O_HP = 33832960, O_CP = 33833472,
                 O_KS = 33835008, O_VS = 33966080, O_HS = 34097152, O_CS = 34105344, O_END = 34129920;

constexpr size_t MiB = 1u << 20;
constexpr size_t WS_CTL = 0, WS_XN = 1 * MiB, WS_W1T = 35 * MiB, WS_W2T = 41 * MiB, WS_ROPE = 43 * MiB, WS_XA = 48 * MiB, WS_SGA = 82 * MiB,
                 WS_SGB = 99 * MiB, WS_QB = 116 * MiB, WS_KB = 133 * MiB, WS_VB = 150 * MiB, WS_YCAT = 167 * MiB, WS_HLOC = 201 * MiB,
                 WS_CUMA = 234 * MiB, WS_SUMA = 267 * MiB, WS_SUMB = 269 * MiB, WS_END = 272 * MiB;
constexpr int LDS_BYTES = 131072 + 1024;

constexpr int LRU_CH = 32;
constexpr int N_LRU_P = (TP + LRU_CH - 1) / LRU_CH;
constexpr int N_LRU = N_LRU_P + 16;
constexpr int N_ATT = 512 + 64;
constexpr int N_P2 = N_LRU + N_ATT;

struct Params { const float* in[24]; float* out; unsigned char* ws; };

__device__ __forceinline__ unsigned cvtpk(float lo, float hi) {
    typedef float f2 __attribute__((ext_vector_type(2))); typedef __bf16 b2 __attribute__((ext_vector_type(2)));
    f2 v = {lo, hi}; b2 b = __builtin_convertvector(v, b2); return __builtin_bit_cast(unsigned, b);
}
__device__ __forceinline__ float bf2f(bf16 v) { return __uint_as_float(((unsigned)v) << 16); }
__device__ __forceinline__ bf16 f2bf(float f) { return (bf16)(cvtpk(f, 0.f) & 0xffffu); }
__device__ __forceinline__ float wave_sum(float v) {
#pragma unroll
    for (int o = 1; o < 64; o <<= 1) v += __shfl_xor(v, o);
    return v;
}
__device__ __forceinline__ int crow(int r, int hi) { return (r & 3) + 8 * (r >> 2) + 4 * hi; }
__device__ __forceinline__ float silu_f(float x) { return x / (1.0f + __expf(-x)); }

__device__ __forceinline__ void p0_row(const Params& p, int m, int lane) {
    unsigned long long* dst = (unsigned long long*)(p.ws + WS_XN + (size_t)m * DM * 2) + lane;
    if (m >= MROWS) {
#pragma unroll
        for (int j = 0; j < 4; ++j) dst[64 * j] = 0ull;
        return;
    }
    const float* src = m < NMETA ? p.in[6] + (size_t)m * DM : (m < TP ? p.in[0] + (size_t)(m - NMETA) * DM : p.in[1] + (size_t)(m - TP) * DM);
    const f32x4* s4 = (const f32x4*)src + lane;
    const f32x4* w4 = (const f32x4*)p.in[7] + lane;
    f32x4 v[4]; float s = 0.f;
#pragma unroll
    for (int j = 0; j < 4; ++j) { v[j] = s4[64 * j]; s += (v[j].x * v[j].x + v[j].y * v[j].y) + (v[j].z * v[j].z + v[j].w * v[j].w); }
    s = wave_sum(s);
    const float rs = 1.0f / sqrtf(s * (1.0f / DM) + EPS);
#pragma unroll
    for (int j = 0; j < 4; ++j) {
        const f32x4 w = w4[64 * j]; const f32x4 o = (v[j] * rs) * w;
        dst[64 * j] = (unsigned long long)cvtpk(o.x, o.y) | ((unsigned long long)cvtpk(o.z, o.w) << 32);
    }
}
__device__ __forceinline__ int permrow(int n) {
    const int pn = n >> 8, a = n & 255, wc = a >> 6, bj = (a >> 5) & 1, fq = (a >> 3) & 3, n2 = (a >> 2) & 1, e = a & 3;
    return pn * 256 + 128 * bj + 32 * wc + 16 * n2 + 4 * fq + e;
}
template <bool PERMW>
__device__ __forceinline__ void p0_transpose_item(const float* W, int K, int N, bf16* WT, LAS float* scr, int item, int lane) {
    const int nblk = N / 32, kb = item / nblk, nb = item % nblk, k0 = 64 * kb, n0 = 32 * nb;
#pragma unroll 8
    for (int i = 0; i < 32; ++i) { const int kk = 2 * i + (lane >> 5); scr[kk * 33 + (lane & 31)] = W[(size_t)(k0 + kk) * N + n0 + (lane & 31)]; }
    asm volatile("s_waitcnt lgkmcnt(0)" ::: "memory");
    const int c = lane & 7;
#pragma unroll
    for (int j = 0; j < 4; ++j) {
        const int n = (lane >> 3) + 8 * j; const LAS float* s = scr + (8 * c) * 33 + n;
        u32x4 o; o.x = cvtpk(s[0 * 33], s[1 * 33]); o.y = cvtpk(s[2 * 33], s[3 * 33]); o.z = cvtpk(s[4 * 33], s[5 * 33]); o.w = cvtpk(s[6 * 33], s[7 * 33]);
        const int row = PERMW ? permrow(n0 + n) : (n0 + n);
        *(u32x4*)(WT + (size_t)row * K + k0 + 8 * c) = o;
    }
    asm volatile("s_waitcnt lgkmcnt(0)" ::: "memory");
}
__device__ __forceinline__ void rope_entry(int pos, int i, float& c, float& s) {
    double inv = 1.0; for (int k = 0; k < i; ++k) inv *= 0.7498942093324558;
    const double ang = (double)pos * inv;
    const double kq = __builtin_rint(ang * 0.63661977236758134308);
    double r = __builtin_fma(-kq, 1.57079632673412561417e+00, ang); r = __builtin_fma(-kq, 6.07710050650619224932e-11, r);
    const int q = (int)((long long)kq & 3);
    const double z = r * r;
    const double sn = r + r * z * (-1.66666666666666324348e-01 + z * (8.33333333332248946124e-03 + z * (-1.98412698298579493134e-04 + z * (2.75573137070700676789e-06 + z * (-2.50507602534068634195e-08 + z * 1.58969099521155010221e-10)))));
    const double cs = 1.0 - 0.5 * z + z * z * (4.16666666666666019037e-02 + z * (-1.38888888888741095749e-03 + z * (2.48015872894767294178e-05 + z * (-2.75573143513906633035e-07 + z * (2.08757232129817482790e-09 + z * -1.13596475577881948265e-11)))));
    double cc, ss;
    if (q == 0) { cc = cs; ss = sn; } else if (q == 1) { cc = -sn; ss = cs; } else if (q == 2) { cc = -cs; ss = -sn; } else { cc = sn; ss = -cs; }
    c = (float)cc; s = (float)ss;
}
__device__ __forceinline__ void phase0(const Params& p, LAS unsigned char* lds) {
    const int tid = threadIdx.x, lane = tid & 63, wave = tid >> 6;
    const int gw = blockIdx.x * 8 + wave, NGW = gridDim.x * 8;
    LAS float* scr = (LAS float*)(lds + wave * 16384);
    constexpr int I1 = (DM / 64) * (DIN / 32), I2 = (DM / 64) * (DM / 32);
    for (int it = gw; it < I1 + I2; it += NGW) {
        if (it < I1) p0_transpose_item<true>(p.in[8], DM, DIN, (bf16*)(p.ws + WS_W1T), scr, it, lane);
        else p0_transpose_item<false>(p.in[9], DM, DM, (bf16*)(p.ws + WS_W2T), scr, it - I1, lane);
    }
    for (int m = gw; m < MPAD; m += NGW) p0_row(p, m, lane);
    float* rope = (float*)(p.ws + WS_ROPE);
    for (int e = blockIdx.x * NTHREADS + tid; e < TP * 32; e += gridDim.x * NTHREADS) {
        float c, s; rope_entry(e >> 5, e & 31, c, s); rope[2 * e] = c; rope[2 * e + 1] = s;
    }
}

struct EpiIn {
    static constexpr bool PERM = false, AFTER_DRAIN = false;
    float* out; unsigned char* ws; const float* qnw; const float* knw;
    __device__ __forceinline__ void operator()(const f32x4 (&acc)[2][2][4][2], const pg8::Unit& u, int wr, int wc, int fr, int fq) const {
        const int typ = u.pn >> 1;
        const int segc = (u.pn & 1) * 256 + wc * 64 + fq * 8;
        if (typ == 2 || typ == 3) {
            const float* nwp = (typ == 2) ? qnw : knw;
            float w1[8], w2[8];
#pragma unroll
            for (int t = 0; t < 8; ++t) { w1[t] = nwp[fq * 8 + t]; w2[t] = nwp[32 + fq * 8 + t]; }
            bf16* dstb = (bf16*)(ws + (typ == 2 ? WS_QB : WS_KB));
            const float osc = (typ == 2) ? C2 : 1.0f;
#pragma unroll
            for (int ai = 0; ai < 2; ++ai)
#pragma unroll
                for (int m = 0; m < 4; ++m) {
                    const int r = u.pm * 256 + ai * 128 + wr * 64 + m * 16 + fr;
                    float v1[8], v2[8]; float ss = 0.f;
#pragma unroll
                    for (int n = 0; n < 2; ++n)
#pragma unroll
                        for (int e = 0; e < 4; ++e) { v1[4 * n + e] = acc[ai][0][m][n][e]; v2[4 * n + e] = acc[ai][1][m][n][e]; ss += v1[4 * n + e] * v1[4 * n + e] + v2[4 * n + e] * v2[4 * n + e]; }
                    ss += __shfl_xor(ss, 16); ss += __shfl_xor(ss, 32);
                    const float rinv = 1.0f / sqrtf(ss * (1.0f / 64.0f) + EPS);
                    const int pos = r < TP ? r : (r < MROWS ? PAST + ((r - TP) & 15) : 0);
                    const f32x4* rp = (const f32x4*)(ws + WS_ROPE) + (size_t)pos * 16 + fq * 4;
                    float o1[8], o2[8];
#pragma unroll
                    for (int t2 = 0; t2 < 4; ++t2) {
                        const f32x4 cs = rp[t2];
                        { const float y1 = (v1[2 * t2] * rinv) * w1[2 * t2], y2 = (v2[2 * t2] * rinv) * w2[2 * t2]; o1[2 * t2] = y1 * cs.x - y2 * cs.y; o2[2 * t2] = y1 * cs.y + y2 * cs.x; }
                        { const float y1 = (v1[2 * t2 + 1] * rinv) * w1[2 * t2 + 1], y2 = (v2[2 * t2 + 1] * rinv) * w2[2 * t2 + 1]; o1[2 * t2 + 1] = y1 * cs.z - y2 * cs.w; o2[2 * t2 + 1] = y1 * cs.w + y2 * cs.z; }
                    }
                    u32x4 b1, b2;
                    b1.x = cvtpk(o1[0] * osc, o1[1] * osc); b1.y = cvtpk(o1[2] * osc, o1[3] * osc); b1.z = cvtpk(o1[4] * osc, o1[5] * osc); b1.w = cvtpk(o1[6] * osc, o1[7] * osc);
                    b2.x = cvtpk(o2[0] * osc, o2[1] * osc); b2.y = cvtpk(o2[2] * osc, o2[3] * osc); b2.z = cvtpk(o2[4] * osc, o2[5] * osc); b2.w = cvtpk(o2[6] * osc, o2[7] * osc);
                    *(u32x4*)(dstb + (size_t)r * 512 + segc) = b1; *(u32x4*)(dstb + (size_t)r * 512 + segc + 32) = b2;
                    if (typ == 3 && r < MROWS) {
                        float* d = (r < TP) ? out + O_KP + (size_t)r * 512 : out + O_KS + (size_t)(r - TP) * 512;
                        *(f32x4*)(d + segc) = (f32x4){o1[0], o1[1], o1[2], o1[3]}; *(f32x4*)(d + segc + 4) = (f32x4){o1[4], o1[5], o1[6], o1[7]};
                        *(f32x4*)(d + segc + 32) = (f32x4){o2[0], o2[1], o2[2], o2[3]}; *(f32x4*)(d + segc + 36) = (f32x4){o2[4], o2[5], o2[6], o2[7]};
                    }
                }
        } else {
#pragma unroll
            for (int ai = 0; ai < 2; ++ai)
#pragma unroll
                for (int m = 0; m < 4; ++m) {
                    const int r = u.pm * 256 + ai * 128 + wr * 64 + m * 16 + fr;
#pragma unroll
                    for (int bj = 0; bj < 2; ++bj) {
                        const f32x4 a0 = acc[ai][bj][m][0], a1 = acc[ai][bj][m][1];
                        const int col = segc + 32 * bj;
                        if (typ == 0) {
                            float* d = (float*)(ws + WS_XA) + (size_t)r * 512 + col;
                            *(f32x4*)d = a0; *(f32x4*)(d + 4) = a1;
                        } else if (typ == 4) {
                            u32x4 b; b.x = cvtpk(a0.x, a0.y); b.y = cvtpk(a0.z, a0.w); b.z = cvtpk(a1.x, a1.y); b.w = cvtpk(a1.z, a1.w);
                            *(u32x4*)((bf16*)(ws + WS_VB) + (size_t)r * 512 + col) = b;
                            if (r < MROWS) {
                                float* d = ((r < TP) ? out + O_VP + (size_t)r * 512 : out + O_VS + (size_t)(r - TP) * 512) + col;
                                *(f32x4*)d = a0; *(f32x4*)(d + 4) = a1;
                            }
                        } else {
                            u32x4 b; b.x = cvtpk(silu_f(a0.x), silu_f(a0.y)); b.y = cvtpk(silu_f(a0.z), silu_f(a0.w)); b.z = cvtpk(silu_f(a1.x), silu_f(a1.y)); b.w = cvtpk(silu_f(a1.z), silu_f(a1.w));
                            *(u32x4*)((bf16*)(ws + (typ == 1 ? WS_SGA : WS_SGB)) + (size_t)r * 512 + col) = b;
                        }
                    }
                }
        }
    }
};
struct EpiOut {
    static constexpr bool PERM = false, AFTER_DRAIN = false;
    float* out; const float* xp; const float* xs;
    __device__ __forceinline__ void operator()(const f32x4 (&acc)[2][2][4][2], const pg8::Unit& u, int wr, int wc, int fr, int fq) const {
#pragma unroll
        for (int ai = 0; ai < 2; ++ai)
#pragma unroll
            for (int m = 0; m < 4; ++m) {
                const int r = u.pm * 256 + ai * 128 + wr * 64 + m * 16 + fr;
                if (r < NMETA || r >= MROWS) continue;
                const float* xr; float* orow;
                if (r < TP) { xr = xp + (size_t)(r - NMETA) * DM; orow = out + O_YP + (size_t)(r - NMETA) * DM; }
                else { xr = xs + (size_t)(r - TP) * DM; orow = out + O_YS + (size_t)(r - TP) * DM; }
#pragma unroll
                for (int bj = 0; bj < 2; ++bj)
#pragma unroll
                    for (int n = 0; n < 2; ++n) {
                        const int col = u.pn * 256 + bj * 128 + wc * 32 + n * 16 + fq * 4;
                        const f32x4 xv = *(const f32x4*)(xr + col);
                        *(f32x4*)(orow + col) = xv + acc[ai][bj][m][n];
                    }
            }
    }
};

__device__ __forceinline__ void lru_item(const Params& p, LAS unsigned char* lds, int idx) {
    const int ch = threadIdx.x;
    const int grp = __builtin_amdgcn_readfirstlane(ch >> 6), d = ch & 63;
    LAS float* cfs = (LAS float*)lds;
    const float* XA = (const float*)(p.ws + WS_XA);
    const bool samp = idx >= N_LRU_P;
    int row0, L, ci = 0, b = 0; float xl3, xl2, xl1, h;
    if (!samp) {
        ci = idx; row0 = LRU_CH * ci; L = (TP - row0) < LRU_CH ? (TP - row0) : LRU_CH; h = 0.f;
        if (ci > 0) { xl3 = XA[(size_t)(row0 - 3) * 512 + ch]; xl2 = XA[(size_t)(row0 - 2) * 512 + ch]; xl1 = XA[(size_t)(row0 - 1) * 512 + ch]; }
        else { xl3 = 0.f; xl2 = 0.f; xl1 = 0.f; }
    } else {
        b = idx - N_LRU_P; row0 = TP + 16 * b; L = 16; h = p.in[4][b * 512 + ch];
        xl3 = p.in[5][(b * 3 + 0) * 512 + ch]; xl2 = p.in[5][(b * 3 + 1) * 512 + ch]; xl1 = p.in[5][(b * 3 + 2) * 512 + ch];
    }
    const float cw0 = p.in[10][ch], cw1 = p.in[10][512 + ch], cw2 = p.in[10][1024 + ch], cw3 = p.in[10][1536 + ch], cb = p.in[11][ch];
    for (int t = 0; t < L; ++t) {
        const float x = XA[(size_t)(row0 + t) * 512 + ch];
        cfs[t * 512 + ch] = cb + cw0 * xl3 + cw1 * xl2 + cw2 * xl1 + cw3 * x;
        xl3 = xl2; xl2 = xl1; xl1 = x;
    }
    __syncthreads();
    float wr_[64], wi_[64];
#pragma unroll
    for (int c = 0; c < 64; ++c) { wr_[c] = p.in[12][(grp * 64 + c) * 64 + d]; wi_[c] = p.in[14][(grp * 64 + c) * 64 + d]; }
    const float gab = p.in[13][ch], gxb = p.in[15][ch];
    const float sp = log1pf(expf(-p.in[16][ch]));
    float ca = 1.0f;
    float* HLOC = (float*)(p.ws + WS_HLOC); float* CUMA = (float*)(p.ws + WS_CUMA);
    const bf16* SGA = (const bf16*)(p.ws + WS_SGA); bf16* YCAT = (bf16*)(p.ws + WS_YCAT);
    for (int t = 0; t < L; ++t) {
        float ar = gab, ai = gxb;
        const LAS f32x4* cv = (const LAS f32x4*)(cfs + t * 512 + grp * 64);
#pragma unroll
        for (int c4 = 0; c4 < 16; ++c4) {
            const f32x4 x4 = cv[c4];
            ar += x4.x * wr_[4 * c4]; ai += x4.x * wi_[4 * c4];
            ar += x4.y * wr_[4 * c4 + 1]; ai += x4.y * wi_[4 * c4 + 1];
            ar += x4.z * wr_[4 * c4 + 2]; ai += x4.z * wi_[4 * c4 + 2];
            ar += x4.w * wr_[4 * c4 + 3]; ai += x4.w * wi_[4 * c4 + 3];
        }
        const float rg = 1.0f / (1.0f + expf(-ar)), ig = 1.0f / (1.0f + expf(-ai));
        const float la = -8.0f * rg * sp;
        const float a = expf(la);
        const float bb = sqrtf(-expm1f(2.0f * la)) * (ig * cfs[t * 512 + ch]);
        h = a * h + bb; ca *= a;
        const size_t row = (size_t)(row0 + t);
        if (!samp) { HLOC[row * 512 + ch] = h; CUMA[row * 512 + ch] = ca; }
        else YCAT[row * 1024 + ch] = f2bf(h * bf2f(SGA[row * 512 + ch]));
    }
    if (!samp) {
        ((float*)(p.ws + WS_SUMA))[ci * 512 + ch] = ca; ((float*)(p.ws + WS_SUMB))[ci * 512 + ch] = h;
        if (ci == N_LRU_P - 1) { p.out[O_CP + ch] = xl3; p.out[O_CP + 512 + ch] = xl2; p.out[O_CP + 1024 + ch] = xl1; }
    } else {
        p.out[O_HS + b * 512 + ch] = h;
        p.out[O_CS + (b * 3 + 0) * 512 + ch] = xl3; p.out[O_CS + (b * 3 + 1) * 512 + ch] = xl2; p.out[O_CS + (b * 3 + 2) * 512 + ch] = xl1;
    }
    __syncthreads();
}
__device__ __forceinline__ void lru_fix(const Params& p, int ci) {
    const int ch = threadIdx.x;
    const float* SA = (const float*)(p.ws + WS_SUMA); const float* SB = (const float*)(p.ws + WS_SUMB);
    float H = 0.f;
    int k = 0;
    for (; k + 8 <= ci; k += 8) {
        float a8[8], b8[8];
#pragma unroll
        for (int j = 0; j < 8; ++j) { a8[j] = SA[(k + j) * 512 + ch]; b8[j] = SB[(k + j) * 512 + ch]; }
#pragma unroll
        for (int j = 0; j < 8; ++j) H = a8[j] * H + b8[j];
    }
    for (; k < ci; ++k) H = SA[k * 512 + ch] * H + SB[k * 512 + ch];
    const int row0 = LRU_CH * ci, L = (TP - row0) < LRU_CH ? (TP - row0) : LRU_CH;
    const float* HLOC = (const float*)(p.ws + WS_HLOC); const float* CUMA = (const float*)(p.ws + WS_CUMA);
    const bf16* SGA = (const bf16*)(p.ws + WS_SGA); bf16* YCAT = (bf16*)(p.ws + WS_YCAT);
    float h = 0.f;
    for (int t = 0; t < L; ++t) {
        const size_t row = (size_t)(row0 + t);
        h = HLOC[row * 512 + ch] + CUMA[row * 512 + ch] * H;
        YCAT[row * 1024 + ch] = f2bf(h * bf2f(SGA[row * 512 + ch]));
    }
    if (ci == N_LRU_P - 1) p.out[O_HP + ch] = h;
}

__device__ __forceinline__ s16x4 tr16(const LAS unsigned char* p) {
    typedef short v4i16_t __attribute__((ext_vector_type(4)));
    return __builtin_bit_cast(s16x4, __builtin_amdgcn_ds_read_tr16_b64_v4i16((LAS v4i16_t*)p));
}
__device__ __forceinline__ void attn_item(const Params& p, LAS unsigned char* lds, int kind, int a, int h, float negm, float lam) {
    const int tid = threadIdx.x, lane = tid & 63, r32 = lane & 31, hi = lane >> 5;
    const int wid = __builtin_amdgcn_readfirstlane(tid >> 6), qs = wid & 3, c = wid >> 2;
    const bf16* QBp = (const bf16*)(p.ws + WS_QB); const bf16* KBp = (const bf16*)(p.ws + WS_KB); const bf16* VBp = (const bf16*)(p.ws + WS_VB);
    int qrow, NT, myNT;
    if (kind == 0) { qrow = NMETA + 128 * a + 32 * qs + r32; NT = 2 * a + 3; myNT = (qs < 2) ? NT - 1 : NT; }
    else { qrow = TP + 16 * a + (r32 & 15); NT = 65; myNT = 65; }
    bf16x8 qr[4];
    { const bf16* q = QBp + (size_t)qrow * 512 + h * 128 + c * 64 + hi * 8;
#pragma unroll
      for (int d0 = 0; d0 < 4; ++d0) qr[d0] = *(const bf16x8*)(q + d0 * 16); }
    f32x16 o[4];
#pragma unroll
    for (int i = 0; i < 4; ++i)
#pragma unroll
        for (int r = 0; r < 16; ++r) o[i][r] = 0.f;
    float lacc = 0.f;
    const int kkey = tid >> 3, kch = tid & 7, kcol = h * 128 + kch * 8;
    const unsigned kdst = kch * 1024 + kkey * 16;
    int vkey[2], vcol[2]; unsigned vdst[2];
#pragma unroll
    for (int i = 0; i < 2; ++i) { const int pp = tid + 512 * i, q16 = pp & 15; vkey[i] = pp >> 4; vcol[i] = h * 128 + q16 * 8;
        vdst[i] = 16384 + ((q16 >> 2) * 4 + (vkey[i] >> 4)) * 1024 + (vkey[i] & 15) * 64 + (q16 & 3) * 16; }
    f32x4 st[8]; bool stf32 = false;
#define ATT_LOAD(j) do { bool f_; size_t row0_; \
        if (kind == 0) { f_ = false; row0_ = ((j) == 0) ? 0 : (size_t)(NMETA + 64 * ((j) - 1)); } \
        else { if ((j) < 64) { f_ = true; row0_ = (size_t)a * PAST + 64 * (j); } else { f_ = false; row0_ = (size_t)(TP + 16 * a); } } \
        stf32 = f_; \
        if (f_) { const float* ck = p.in[2] + (row0_ + kkey) * 512 + kcol; \
            st[0] = *(const f32x4*)ck; st[1] = *(const f32x4*)(ck + 4); st[2] = *(const f32x4*)(ck + 64); st[3] = *(const f32x4*)(ck + 68); \
            _Pragma("unroll") for (int i_ = 0; i_ < 2; ++i_) { const float* cv = p.in[3] + (row0_ + vkey[i_]) * 512 + vcol[i_]; st[4 + 2 * i_] = *(const f32x4*)cv; st[5 + 2 * i_] = *(const f32x4*)(cv + 4); } } \
        else { const bf16* ck = KBp + (row0_ + kkey) * 512 + kcol; \
            st[0] = __builtin_bit_cast(f32x4, *(const u32x4*)ck); st[1] = __builtin_bit_cast(f32x4, *(const u32x4*)(ck + 64)); \
            _Pragma("unroll") for (int i_ = 0; i_ < 2; ++i_) st[2 + i_] = __builtin_bit_cast(f32x4, *(const u32x4*)(VBp + (row0_ + vkey[i_]) * 512 + vcol[i_])); } \
    } while (0)
#define PK4(A_, B_2) (u32x4){cvtpk((A_)[0], (A_)[1]), cvtpk((A_)[2], (A_)[3]), cvtpk((B_2)[0], (B_2)[1]), cvtpk((B_2)[2], (B_2)[3])}
#define ATT_STORE(buf) do { LAS unsigned char* B_ = lds + (buf) * 32768; \
        if (stf32) { *(LAS u32x4*)(B_ + kdst) = PK4(st[0], st[1]); *(LAS u32x4*)(B_ + 8192 + kdst) = PK4(st[2], st[3]); \
                     *(LAS u32x4*)(B_ + vdst[0]) = PK4(st[4], st[5]); *(LAS u32x4*)(B_ + vdst[1]) = PK4(st[6], st[7]); } \
        else { *(LAS u32x4*)(B_ + kdst) = __builtin_bit_cast(u32x4, st[0]); *(LAS u32x4*)(B_ + 8192 + kdst) = __builtin_bit_cast(u32x4, st[1]); \
               *(LAS u32x4*)(B_ + vdst[0]) = __builtin_bit_cast(u32x4, st[2]); *(LAS u32x4*)(B_ + vdst[1]) = __builtin_bit_cast(u32x4, st[3]); } \
    } while (0)
    ATT_LOAD(0); ATT_STORE(0); __syncthreads();
    for (int j = 0; j < NT; ++j) {
        if (j + 1 < NT) ATT_LOAD(j + 1);
        if (j < myNT) {
            const LAS unsigned char* Bb = lds + (j & 1) * 32768;
            const LAS unsigned char* Kb = Bb + c * 8192 + hi * 1024 + r32 * 16;
            f32x16 p0, p1;
#pragma unroll
            for (int r = 0; r < 16; ++r) { p0[r] = negm; p1[r] = negm; }
#pragma unroll
            for (int d0 = 0; d0 < 4; ++d0) {
                const bf16x8 b0 = *(const LAS bf16x8*)(Kb + d0 * 2048), b1 = *(const LAS bf16x8*)(Kb + d0 * 2048 + 512);
                p0 = __builtin_amdgcn_mfma_f32_32x32x16_bf16(b0, qr[d0], p0, 0, 0, 0);
                p1 = __builtin_amdgcn_mfma_f32_32x32x16_bf16(b1, qr[d0], p1, 0, 0, 0);
            }
#pragma unroll
            for (int r = 0; r < 16; ++r) { p0[r] = __builtin_amdgcn_exp2f(p0[r]); p1[r] = __builtin_amdgcn_exp2f(p1[r]); }
            const bool part = (kind == 0) ? (j == 0) : (j == 64);
            if (part) {
#pragma unroll
                for (int r = 8; r < 16; ++r) p0[r] = 0.f;
#pragma unroll
                for (int r = 0; r < 16; ++r) p1[r] = 0.f;
            }
            float s = 0.f;
#pragma unroll
            for (int r = 0; r < 16; ++r) s += p0[r] + p1[r];
            lacc += s;
            u32x4 pw[4];
            pw[0] = (u32x4){cvtpk(p0[0], p0[1]), cvtpk(p0[2], p0[3]), cvtpk(p0[4], p0[5]), cvtpk(p0[6], p0[7])};
            pw[1] = (u32x4){cvtpk(p0[8], p0[9]), cvtpk(p0[10], p0[11]), cvtpk(p0[12], p0[13]), cvtpk(p0[14], p0[15])};
            pw[2] = (u32x4){cvtpk(p1[0], p1[1]), cvtpk(p1[2], p1[3]), cvtpk(p1[4], p1[5]), cvtpk(p1[6], p1[7])};
            pw[3] = (u32x4){cvtpk(p1[8], p1[9]), cvtpk(p1[10], p1[11]), cvtpk(p1[12], p1[13]), cvtpk(p1[14], p1[15])};
            const LAS unsigned char* Vb = Bb + 16384 + ((lane >> 4) & 1) * 32 + (lane & 3) * 8 + (4 * hi + ((lane & 15) >> 2)) * 64;
#pragma unroll
            for (int db = 0; db < 4; ++db)
#pragma unroll
                for (int kg = 0; kg < 4; ++kg) {
                    const s16x4 lo = tr16(Vb + (db * 4 + kg) * 1024), hh = tr16(Vb + (db * 4 + kg) * 1024 + 512);
                    const bf16x8 vf = (bf16x8){lo[0], lo[1], lo[2], lo[3], hh[0], hh[1], hh[2], hh[3]};
                    o[db] = __builtin_amdgcn_mfma_f32_32x32x16_bf16(__builtin_bit_cast(bf16x8, pw[kg]), vf, o[db], 0, 0, 0);
                }
        }
        if (j + 1 < NT) ATT_STORE((j + 1) & 1);
        __syncthreads();
    }
#undef ATT_LOAD
#undef ATT_STORE
#undef PK4
    lacc += __shfl_xor(lacc, 32);
    LAS float* wsf = (LAS float*)(lds + 65536) + wid * 64;
    if (hi == 0) wsf[r32] = lacc;
    asm volatile("s_waitcnt lgkmcnt(0)" ::: "memory");
    float rli[16];
#pragma unroll
    for (int r = 0; r < 16; ++r) rli[r] = 1.0f / wsf[crow(r, hi)];
    LAS float* X2 = (LAS float*)lds + qs * 4096;
    if (c == 1) {
#pragma unroll
        for (int db = 0; db < 4; ++db)
#pragma unroll
            for (int r = 0; r < 16; ++r) X2[(db * 16 + r) * 64 + lane] = lam * (o[db][r] * rli[r]);
    }
    __syncthreads();
    if (c == 0) {
        const bf16* SGB = (const bf16*)(p.ws + WS_SGB); bf16* YCAT = (bf16*)(p.ws + WS_YCAT);
        float sw[4];
#pragma unroll
        for (int db = 0; db < 4; ++db) sw[db] = p.in[23][db * 32 + r32];
#pragma unroll
        for (int r = 0; r < 16; ++r) {
            float s = 0.f;
#pragma unroll
            for (int db = 0; db < 4; ++db) { const float v = o[db][r] * rli[r] - X2[(db * 16 + r) * 64 + lane]; o[db][r] = v; s += v * v; }
            s += __shfl_xor(s, 1); s += __shfl_xor(s, 2); s += __shfl_xor(s, 4); s += __shfl_xor(s, 8); s += __shfl_xor(s, 16);
            const float rinv = 1.0f / sqrtf(s * (1.0f / 128.0f) + EPS);
            const int q = crow(r, hi);
            const bool valid = (kind == 0) ? true : (qs == 0 && q < 16);
            const size_t row = (kind == 0) ? (size_t)(NMETA + 128 * a + 32 * qs + q) : (size_t)(TP + 16 * a + (q & 15));
            if (valid) {
#pragma unroll
                for (int db = 0; db < 4; ++db) {
                    const int e = db * 32 + r32;
                    const float g = bf2f(SGB[row * 512 + h * 128 + e]);
                    YCAT[row * 1024 + 512 + h * 128 + e] = f2bf((((o[db][r] * rinv) * sw[db]) * ONE_M_LAM0) * g);
                }
            }
        }
    }
    __syncthreads();
}

__global__ void __launch_bounds__(NTHREADS, 2) mega_fwd(Params p) {
    extern __shared__ __attribute__((aligned(16))) unsigned char lds_raw[];
    LAS unsigned char* lds = (LAS unsigned char*)lds_raw;
    cg::grid_group grid = cg::this_grid();
    const int tid = threadIdx.x;
    unsigned* ctl = (unsigned*)(p.ws + WS_CTL);

#ifndef NO_P0
    phase0(p, lds);
#endif
    grid.sync();

#ifndef NO_P1
    {
        pg8::Gemm g{(const pg8::bf16_t*)(p.ws + WS_XN), (const pg8::bf16_t*)(p.ws + WS_W1T), MPAD, DIN, DM};
        pg8::StaticOrder S; S.init(MPAD, DIN, (int)gridDim.x, (int)blockIdx.x);
        EpiIn E{p.out, p.ws, p.in[17], p.in[18]};
        pg8::gemm_phase<EpiIn, pg8::StaticOrder, true, true>(lds, g, S, E);
    }
#endif
    grid.sync();

#ifndef NO_LRU
    for (int idx = blockIdx.x; idx < N_LRU; idx += gridDim.x) lru_item(p, lds, idx);
#endif
    {
        float d1 = 0.f, d2 = 0.f, mq = 0.f, mk = 0.f;
        for (int i = 0; i < 64; ++i) { d1 += p.in[19][i] * p.in[20][i]; d2 += p.in[21][i] * p.in[22][i]; mq = fmaxf(mq, fabsf(p.in[17][i])); mk = fmaxf(mk, fabsf(p.in[18][i])); }
        const float lam = expf(d1) - expf(d2) + LAM0;
        const float negm = -(8.0f * mq * mk) * LOG2E;
        volatile LAS unsigned* qw = (volatile LAS unsigned*)(lds + 131072);
        for (;;) {
            if (tid == 0) qw[0] = atomicAdd(&ctl[64], 1u);
            __syncthreads();
            const int idx = (int)qw[0];
            __syncthreads();
            if (idx >= N_ATT) break;
            {
#ifndef NO_ATT
                const int a = idx;
                if (a < 384) attn_item(p, lds, 0, 127 - (a >> 2), a & 3, negm, lam);
                else if (a < 448) attn_item(p, lds, 1, (a - 384) >> 2, (a - 384) & 3, negm, lam);
                else attn_item(p, lds, 0, 31 - ((a - 448) >> 2), (a - 448) & 3, negm, lam);
#endif
            }
        }
    }
    grid.sync();

#ifndef NO_P3
    for (int ci = blockIdx.x; ci < N_LRU_P; ci += gridDim.x) lru_fix(p, ci);
#endif
    grid.sync();

#ifndef NO_P4
    {
        pg8::Gemm g{(const pg8::bf16_t*)(p.ws + WS_YCAT), (const pg8::bf16_t*)(p.ws + WS_W2T), MPAD, DM, DM};
        pg8::StaticOrder S; S.init(MPAD, DM, (int)gridDim.x, (int)blockIdx.x);
        EpiOut E{p.out, p.in[0], p.in[1]};
        pg8::gemm_phase<EpiOut, pg8::StaticOrder, true, true>(lds, g, S, E);
    }
#endif
}

extern "C" void kernel_launch(void* const* d_in, const int* in_sizes, int n_in, void* d_out, int out_size, void* d_ws, size_t ws_size, hipStream_t stream) {
    static int grid = 0;
    if (grid == 0) {
        if (n_in != 24 || out_size != (int)O_END || ws_size < WS_END) { fprintf(stderr, "kernel_launch: unexpected shapes (n_in %d out %d ws %zu)\n", n_in, out_size, ws_size); grid = -1; return; }
        int dev = 0, cus = 0, per_cu = 0;
        hipGetDevice(&dev);
        hipDeviceGetAttribute(&cus, hipDeviceAttributeMultiprocessorCount, dev);
        hipFuncSetAttribute((const void*)mega_fwd, hipFuncAttributeMaxDynamicSharedMemorySize, LDS_BYTES);
        hipOccupancyMaxActiveBlocksPerMultiprocessor(&per_cu, (const void*)mega_fwd, NTHREADS, LDS_BYTES);
        if (per_cu < 1) { fprintf(stderr, "kernel_launch: occupancy query says %d blocks/CU\n", per_cu); per_cu = 1; }
        (void)hipGetLastError();
        grid = cus;
    }
    if (grid < 0) return;
    hipMemsetAsync((char*)d_ws + WS_CTL, 0, 4096, stream);
    Params prm{};
    for (int i = 0; i < 24; ++i) prm.in[i] = (const float*)d_in[i];
    prm.out = (float*)d_out; prm.ws = (unsigned char*)d_ws;
    void* args[] = {&prm};
    hipError_t e = hipLaunchCooperativeKernel((const void*)mega_fwd, dim3(grid), dim3(NTHREADS), args, LDS_BYTES, stream);
    if (e != hipSuccess) fprintf(stderr, "cooperative launch failed: %s (grid %d)\n", hipGetErrorString(e), grid);
}
```

```cpp
#include <hip/hip_runtime.h>
#include <cstdio>
#include <cstdint>
namespace pg8 {
#define PG8_LAS __attribute__((address_space(3)))
typedef unsigned short bf16_t;
typedef short bf16x8 __attribute__((ext_vector_type(8)));
typedef float f32x4 __attribute__((ext_vector_type(4)));
typedef unsigned u32x4 __attribute__((ext_vector_type(4)));
constexpr int BM = 256, BK = 64, HALF = 128, HTB = HALF * BK * 2  , STAGE_BYTES = 8 * HTB, NXCD = 8, WGM = 8;

__host__ __device__ __forceinline__ int lds_byte(int r, int c) { const int st = (r >> 4) * 2 + (c >> 5), rr = r & 15, cc = c & 31, ob = rr * 64 + cc * 2; return st * 1024 + (ob ^ (((ob >> 9) & 1) << 5)); }
__host__ __device__ __forceinline__ void stage_rc(int b, int& R, int& C) { const int st = b / 1024, sb = b % 1024, swz = sb ^ (((sb >> 9) & 1) << 5); R = (st >> 1) * 16 + swz / 64; C = (st & 1) * 32 + (swz % 64) / 2; }
__host__ __device__ __forceinline__ int perm32(int rho) { const int n = rho >> 4, i = rho & 15; return 8 * (i >> 2) + 4 * n + (i & 3); }

struct Unit { int pm, pn; };
struct Gemm { const bf16_t* A; const bf16_t* Bt; int M, N, K; };

struct StaticOrder {
    int nM, nN, nwg, G, c;
    __host__ __device__ void init(int M, int N, int G_, int c_) { nM = M / BM; nN = N / BM; nwg = nM * nN; G = G_; c = c_; }
    __host__ __device__ bool next(int i, Unit& u) const {
        const long L = (long)i * G + c; if (L >= nwg) return false;
        int wgid = (int)L; { const int q = nwg / NXCD, r = nwg % NXCD, xcd = wgid % NXCD, off = wgid / NXCD; wgid = (xcd < r ? xcd * (q + 1) : r * (q + 1) + (xcd - r) * q) + off; }
        const int nig = WGM * nN, gid = wgid / nig, fm = gid * WGM, gsz = (nM - fm) < WGM ? (nM - fm) : WGM;
        u.pm = fm + ((wgid % nig) % gsz); u.pn = (wgid % nig) / gsz; return true;
    }
    __device__ __forceinline__ void a_ready(const Unit&) const {}
    __device__ __forceinline__ void done(const Unit&) const {}
};

template <class Epi, class Sched, bool ALIGN_EPI = false, bool SP2 = false>
__device__ __forceinline__ void gemm_phase(PG8_LAS unsigned char* lds, const Gemm g, const Sched& S, const Epi& E) {
    int tid_ = threadIdx.x; asm volatile("" : "+v"(tid_));
    const int tid = tid_, wid = __builtin_amdgcn_readfirstlane(tid >> 6), lane = tid & 63, wr = wid >> 2, wc = wid & 3, fr = lane & 15, fq = lane >> 4;
    const int K = g.K, nt = K / BK;
    unsigned voffA[2], voffB[2];
#pragma unroll
    for (int i = 0; i < 2; ++i) { int R, C; stage_rc(tid * 16 + i * 8192, R, C); const int Rb = Epi::PERM ? ((R & ~31) + perm32(R & 31)) : R;
        voffA[i] = (unsigned)(R * K + C) * 2u; voffB[i] = (unsigned)(Rb * K + C) * 2u; }
    const size_t kstep = (size_t)(BK * 2);
    const size_t hstep = (size_t)HALF * K * 2;
    const size_t tstep = 2 * hstep;
    const unsigned ldsw = (unsigned)wid * 1024u;
    const int aoff = lds_byte(wr * 64 + fr, fq * 8), boff = lds_byte(wc * 32 + fr, fq * 8);
#define PG8_SA(b, h) (((b) * 2 + (h)) * HTB)
#define PG8_SB(b, h) ((4 + (b) * 2 + (h)) * HTB)
#define PG8_STAGE(bufoff, gbase, voff) do { _Pragma("unroll") for (int _i = 0; _i < 2; ++_i) \
        __builtin_amdgcn_global_load_lds((const unsigned*)((const char*)(gbase) + (voff)[_i]), (PG8_LAS unsigned*)(lds + (bufoff) + ldsw + _i * 8192), 16, 0, 0); } while (0)
#define PG8_LDA(dst, b, h) do { _Pragma("unroll") for (int m = 0; m < 4; ++m) _Pragma("unroll") for (int k = 0; k < 2; ++k) dst[m][k] = *(const PG8_LAS bf16x8*)(lds + PG8_SA(b, h) + aoff + m * 2048 + k * 1024); } while (0)
#define PG8_LDB(dst, b, h) do { _Pragma("unroll") for (int n = 0; n < 2; ++n) _Pragma("unroll") for (int k = 0; k < 2; ++k) dst[n][k] = *(const PG8_LAS bf16x8*)(lds + PG8_SB(b, h) + boff + n * 2048 + k * 1024); } while (0)
#define PG8_MMA(ai, bj, At, Bt) do { __builtin_amdgcn_s_setprio(1); _Pragma("unroll") for (int m = 0; m < 4; ++m) _Pragma("unroll") for (int n = 0; n < 2; ++n) _Pragma("unroll") for (int k = 0; k < 2; ++k) \
        acc[ai][bj][m][n] = __builtin_amdgcn_mfma_f32_16x16x32_bf16(Bt[n][k], At[m][k], acc[ai][bj][m][n], 0, 0, 0); __builtin_amdgcn_s_setprio(0); } while (0)
#define PG8_WAIT_V(n) asm volatile("s_waitcnt vmcnt(" #n ")" ::: "memory")
#define PG8_WAIT_L(n) asm volatile("s_waitcnt lgkmcnt(" #n ")" ::: "memory")
#define PG8_BAR __builtin_amdgcn_s_barrier()
#define PG8_SCHED __builtin_amdgcn_sched_barrier(0)
    Unit cur, nxt; int ui = 0;
    if (!S.next(0, cur)) return;
    f32x4 acc[2][2][4][2];
#pragma unroll
    for (int a = 0; a < 2; ++a)
#pragma unroll
        for (int b = 0; b < 2; ++b)
#pragma unroll
            for (int m = 0; m < 4; ++m)
#pragma unroll
                for (int n = 0; n < 2; ++n) acc[a][b][m][n] = (f32x4){0.f, 0.f, 0.f, 0.f};
    bf16x8 At[4][2], B0[2][2], B1[2][2];
    const char* cA = (const char*)g.A + (size_t)cur.pm * tstep; const char* cB = (const char*)g.Bt + (size_t)cur.pn * tstep;
    S.a_ready(cur);
    if constexpr (SP2) {
        PG8_STAGE(PG8_SB(0, 0), cB, voffB); PG8_STAGE(PG8_SB(0, 1), cB + hstep, voffB); PG8_STAGE(PG8_SA(0, 0), cA, voffA); PG8_STAGE(PG8_SA(0, 1), cA + hstep, voffA);
        if (wr == 1) PG8_BAR;
        PG8_WAIT_V(2); PG8_BAR;
        PG8_STAGE(PG8_SB(1, 0), cB + kstep, voffB); PG8_STAGE(PG8_SA(1, 0), cA + kstep, voffA); PG8_STAGE(PG8_SB(1, 1), cB + hstep + kstep, voffB);
        PG8_WAIT_V(6); PG8_BAR;
    } else {
        PG8_STAGE(PG8_SB(0, 0), cB, voffB); PG8_STAGE(PG8_SA(0, 0), cA, voffA); PG8_STAGE(PG8_SB(0, 1), cB + hstep, voffB); PG8_STAGE(PG8_SA(0, 1), cA + hstep, voffA);
        if (wr == 1) PG8_BAR;
        PG8_WAIT_V(4); PG8_BAR;
        PG8_STAGE(PG8_SB(1, 0), cB + kstep, voffB); PG8_STAGE(PG8_SA(1, 0), cA + kstep, voffA); PG8_STAGE(PG8_SB(1, 1), cB + hstep + kstep, voffB);
        PG8_WAIT_V(6); PG8_BAR;
    }
    for (;;) {
        const bool has_next = S.next(ui + 1, nxt);
        const char* nA = has_next ? (const char*)g.A + (size_t)nxt.pm * tstep : cA; const char* nB = has_next ? (const char*)g.Bt + (size_t)nxt.pn * tstep : cB;
        for (int t = 0; t < nt; t += 2) {
            const bool last = (t == nt - 2);
            const char* a1 = cA + (size_t)(t + 1) * kstep;
            const char* a2 = last ? nA : cA + (size_t)(t + 2) * kstep; const char* b2 = last ? nB : cB + (size_t)(t + 2) * kstep;
            const char* a3 = a2 + kstep; const char* b3 = b2 + kstep;
            if (last && has_next) S.a_ready(nxt);
            if constexpr (SP2) {
            PG8_LDB(B0, 0, 0); PG8_LDB(B1, 0, 1); PG8_SCHED; PG8_LDA(At, 0, 0); PG8_STAGE(PG8_SA(1, 1), a1 + hstep, voffA);
            PG8_WAIT_V(8); PG8_WAIT_L(0); PG8_BAR; PG8_MMA(0, 0, At, B0); PG8_MMA(0, 1, At, B1); PG8_BAR; PG8_SCHED;
            PG8_LDA(At, 0, 1); PG8_STAGE(PG8_SB(0, 0), b2, voffB); PG8_STAGE(PG8_SB(0, 1), b2 + hstep, voffB); PG8_STAGE(PG8_SA(0, 0), a2, voffA);
            PG8_WAIT_V(8); PG8_WAIT_L(0); PG8_BAR; PG8_MMA(1, 0, At, B0); PG8_MMA(1, 1, At, B1); PG8_BAR; PG8_SCHED;
            PG8_LDB(B0, 1, 0); PG8_LDB(B1, 1, 1); PG8_SCHED; PG8_LDA(At, 1, 0); PG8_STAGE(PG8_SA(0, 1), a2 + hstep, voffA);
            PG8_WAIT_V(8); PG8_WAIT_L(0); PG8_BAR; PG8_MMA(0, 0, At, B0); PG8_MMA(0, 1, At, B1); PG8_BAR; PG8_SCHED;
            PG8_LDA(At, 1, 1); PG8_STAGE(PG8_SB(1, 0), b3, voffB); PG8_STAGE(PG8_SB(1, 1), b3 + hstep, voffB); PG8_STAGE(PG8_SA(1, 0), a3, voffA);
            PG8_WAIT_V(8); PG8_WAIT_L(0); PG8_BAR; PG8_MMA(1, 0, At, B0); PG8_MMA(1, 1, At, B1); PG8_BAR; PG8_SCHED;
            } else {
            PG8_LDB(B0, 0, 0); PG8_SCHED; PG8_LDA(At, 0, 0); PG8_STAGE(PG8_SA(1, 1), a1 + hstep, voffA);
            PG8_WAIT_L(8); PG8_BAR; PG8_WAIT_L(0); PG8_MMA(0, 0, At, B0); PG8_BAR; PG8_SCHED;
            PG8_LDB(B1, 0, 1); PG8_STAGE(PG8_SB(0, 0), b2, voffB);
            PG8_BAR; PG8_WAIT_L(0); PG8_MMA(0, 1, At, B1); PG8_BAR;
            PG8_LDA(At, 0, 1); PG8_STAGE(PG8_SA(0, 0), a2, voffA);
            PG8_BAR; PG8_WAIT_L(0); PG8_MMA(1, 0, At, B0); PG8_BAR; PG8_SCHED;
            PG8_STAGE(PG8_SB(0, 1), b2 + hstep, voffB);
            PG8_WAIT_V(6); PG8_BAR; PG8_MMA(1, 1, At, B1); PG8_BAR;
            PG8_LDB(B0, 1, 0); PG8_SCHED; PG8_LDA(At, 1, 0); PG8_STAGE(PG8_SA(0, 1), a2 + hstep, voffA);
            PG8_WAIT_L(8); PG8_BAR; PG8_WAIT_L(0); PG8_MMA(0, 0, At, B0); PG8_BAR; PG8_SCHED;
            PG8_LDB(B1, 1, 1); PG8_STAGE(PG8_SB(1, 0), b3, voffB);
            PG8_BAR; PG8_WAIT_L(0); PG8_MMA(0, 1, At, B1); PG8_BAR;
            PG8_LDA(At, 1, 1); PG8_STAGE(PG8_SA(1, 0), a3, voffA);
            PG8_BAR; PG8_WAIT_L(0); PG8_MMA(1, 0, At, B0); PG8_BAR; PG8_SCHED;
            PG8_STAGE(PG8_SB(1, 1), b3 + hstep, voffB);
            PG8_WAIT_V(6); PG8_BAR; PG8_MMA(1, 1, At, B1); PG8_BAR;
            }
        }
        if constexpr (ALIGN_EPI) { if (wr == 0) PG8_BAR; }
        if constexpr (!Epi::AFTER_DRAIN) { E(acc, cur, wr, wc, fr, fq); S.done(cur); }
        if (!has_next) break;
#pragma unroll
        for (int a = 0; a < 2; ++a)
#pragma unroll
            for (int b = 0; b < 2; ++b)
#pragma unroll
                for (int m = 0; m < 4; ++m)
#pragma unroll
                    for (int n = 0; n < 2; ++n) acc[a][b][m][n] = (f32x4){0.f, 0.f, 0.f, 0.f};
        cur = nxt; cA = nA; cB = nB; ++ui;
        if constexpr (ALIGN_EPI) { if (wr == 1) PG8_BAR; }
    }
    PG8_WAIT_V(0);
    if constexpr (!ALIGN_EPI) { if (wr == 0) PG8_BAR; }
    PG8_BAR;
    if constexpr (Epi::AFTER_DRAIN) { E.fused(acc, cur, wr, wc, fr, fq, lds, wid, lane); S.done(cur); }
#undef PG8_SA
#undef PG8_SB
#undef PG8_STAGE
#undef PG8_LDA
#undef PG8_LDB
#undef PG8_MMA
#undef PG8_WAIT_V
#undef PG8_WAIT_L
#undef PG8_BAR
#undef PG8_SCHED
}
}

#define LAS __attribute__((address_space(3)))
typedef unsigned short bf16;
typedef short bf16x8 __attribute__((ext_vector_type(8)));
typedef short s16x4 __attribute__((ext_vector_type(4)));
typedef float f32x4 __attribute__((ext_vector_type(4)));
typedef float f32x16 __attribute__((ext_vector_type(16)));
typedef unsigned u32x4 __attribute__((ext_vector_type(4)));
typedef unsigned u32x2 __attribute__((ext_vector_type(2)));

constexpr int NTHREADS = 512;
constexpr int DM = 1024, NMETA = 16, TP = 16400, NSAMP = 256, MROWS = TP + NSAMP  , MPAD = 16896, PAST = 4096;
constexpr int DL = 512, DIN = 3072;
constexpr float EPS = 1e-6f;
constexpr float C2 = 0.18033688011112042f;
constexpr float LOG2E = 1.4426950408889634f;
constexpr float ONE_M_LAM0 = 0.8f, LAM0 = 0.2f;

constexpr size_t O_YP = 0, O_YS = 16777216, O_KP = 17039360, O_VP = 25436160, O_HP = 33832960, O_CP = 33833472,
                 O_KS = 33835008, O_VS = 33966080, O_HS = 34097152, O_CS = 34105344, O_END = 34129920;

constexpr size_t MiB = 1u << 20;
constexpr size_t WS_CTL = 0, WS_XN = 1 * MiB, WS_W1T = 35 * MiB, WS_W2T = 41 * MiB, WS_ROPE = 43 * MiB, WS_XA = 48 * MiB, WS_SGA = 82 * MiB,
                 WS_SGB = 99 * MiB, WS_QB = 116 * MiB, WS_KV = 133 * MiB  , WS_YCAT = 167 * MiB, WS_GWH = 201 * MiB  , WS_GWL = 202 * MiB, WS_SP = 203 * MiB  ,
                 WS_AT = 204 * MiB  , WS_BT = 237 * MiB, WS_SUMA = 271 * MiB, WS_SUMB = 273 * MiB, WS_CARRY = 275 * MiB, WS_END = 277 * MiB;
constexpr int CW_Q = 64, CW_LRUDONE = 256, CW_CARRYOK = 320, CW_SAMPDONE = 384, CW_QH = 1024, CW_LATE = 448, CW_BAR = 4096;
constexpr size_t CTL_ZERO_BYTES = 65536;
constexpr int LCTL = 147456;
constexpr int LDS_BYTES = LCTL + 4096;
constexpr int LRS = 516;

constexpr int LRU_CH = 32;
constexpr int N_LRU_P = (TP + LRU_CH - 1) / LRU_CH;
constexpr int N_LRU = N_LRU_P + 16;
constexpr int N_ATT = 512 + 64;
constexpr int N_SGEMM = 4;
constexpr int N_P2 = N_ATT + N_SGEMM + N_LRU_P;

struct Params { const float* in[24]; float* out; unsigned char* ws; };

__device__ __forceinline__ unsigned cvtpk(float lo, float hi) {
    typedef float f2 __attribute__((ext_vector_type(2))); typedef __bf16 b2 __attribute__((ext_vector_type(2)));
    f2 v = {lo, hi}; b2 b = __builtin_convertvector(v, b2); return __builtin_bit_cast(unsigned, b);
}
__device__ __forceinline__ float bf2f(bf16 v) { return __uint_as_float(((unsigned)v) << 16); }
__device__ __forceinline__ bf16 f2bf(float f) { return (bf16)(cvtpk(f, 0.f) & 0xffffu); }
__device__ __forceinline__ float wave_sum(float v) {
#pragma unroll
    for (int o = 1; o < 64; o <<= 1) v += __shfl_xor(v, o);
    return v;
}
__device__ __forceinline__ int crow(int r, int hi) { return (r & 3) + 8 * (r >> 2) + 4 * hi; }
__device__ __forceinline__ float silu_f(float x) { return x * __builtin_amdgcn_rcpf(1.0f + __builtin_amdgcn_exp2f(-1.4426950408889634f * x)); }

#define XB_TMO      128
#define XB_XCNT(j)  (256  + 64 * (j))
#define XB_XSUB(j)  (1280 + 64 * (j))
#define XB_XGEN(j)  (2304 + 64 * (j))
#define XB_TOP      3328
#define XB_TOPGEN   3392
#define XCD_BAR_WORDS 3456
#define XB_SPIN_CAP (1u << 18)

__device__ __forceinline__ unsigned xb_ld(unsigned* p)              { return __hip_atomic_load(p, __ATOMIC_RELAXED, __HIP_MEMORY_SCOPE_AGENT); }
__device__ __forceinline__ unsigned xb_add(unsigned* p, unsigned v) { return __hip_atomic_fetch_add(p, v, __ATOMIC_RELAXED, __HIP_MEMORY_SCOPE_AGENT); }
__device__ __forceinline__ unsigned xb_xcc_id() { return (unsigned)__builtin_amdgcn_s_getreg((3 << 11) | 20) & 0xFu; }
#define XB_SPIN(cond, bar) do { unsigned _sp = 0; while (cond) { __builtin_amdgcn_s_sleep(1); \
    if ((++_sp & 255u) == 0u) { if (xb_ld(&(bar)[XB_TMO])) break; if (_sp > XB_SPIN_CAP) { atomicAdd(&(bar)[XB_TMO], 1u); break; } } } } while (0)

struct XcdBarrier {
    unsigned* bar; unsigned x;
    volatile LAS unsigned* st;
};

__device__ __forceinline__ XcdBarrier xcd_barrier_post(unsigned* bar, volatile LAS unsigned* st) {
    XcdBarrier b; b.bar = bar; b.x = xb_xcc_id(); b.st = st;
    if (threadIdx.x == 0) (void)xb_add(&bar[XB_XCNT(b.x)], 1u);
    return b;
}
__device__ __forceinline__ void xcd_barrier_complete(unsigned* bar, unsigned x, unsigned& nloc, unsigned& nx) {
    const unsigned G = gridDim.x * gridDim.y * gridDim.z;
    unsigned sum, cnt, mine, sp = 0u;
    for (;;) {
        sum = 0u; cnt = 0u; mine = 0u;
#pragma unroll
        for (unsigned j = 0; j < 16; ++j) { const unsigned c = xb_ld(&bar[XB_XCNT(j)]); sum += c; cnt += (c > 0u) ? 1u : 0u; mine = (j == x) ? c : mine; }
        if (sum == G) break;
        __builtin_amdgcn_s_sleep(1);
        if ((++sp & 255u) == 0u) { if (xb_ld(&bar[XB_TMO])) break; if (sp > XB_SPIN_CAP) { atomicAdd(&bar[XB_TMO], 1u); break; } }
    }
    nloc = mine > 0u ? mine : 1u; nx = cnt > 0u ? cnt : 1u;
}

__device__ __forceinline__ void xcd_barrier(const XcdBarrier& b) {
    asm volatile("s_waitcnt vmcnt(0)" ::: "memory");
    __syncthreads();
    if (threadIdx.x == 0) {
        unsigned* bar = b.bar;
        __builtin_amdgcn_s_waitcnt(0);
        unsigned nloc = b.st[0], nx = b.st[1];
        if (nloc == 0u) { xcd_barrier_complete(bar, b.x, nloc, nx); b.st[0] = nloc; b.st[1] = nx; }
        const unsigned old = xb_add(&bar[XB_XSUB(b.x)], 1u);
        const unsigned gen = old / nloc;
        if (old + 1u == (gen + 1u) * nloc) {
            __builtin_amdgcn_fence(__ATOMIC_RELEASE, "agent");
            asm volatile("s_waitcnt vmcnt(0)" ::: "memory");
            const unsigned og = xb_add(&bar[XB_TOP], 1u);
            const unsigned tg = og / nx;
            if (og + 1u == (tg + 1u) * nx) xb_add(&bar[XB_TOPGEN], 1u);
            else XB_SPIN(xb_ld(&bar[XB_TOPGEN]) == tg, bar);
            __builtin_amdgcn_fence(__ATOMIC_ACQUIRE, "agent");
            xb_add(&bar[XB_XGEN(b.x)], 1u);
            asm volatile("s_waitcnt vmcnt(0)" ::: "memory");
        } else {
            XB_SPIN(xb_ld(&bar[XB_XGEN(b.x)]) == gen, bar);
            __builtin_amdgcn_fence(__ATOMIC_ACQUIRE, "agent");
            asm volatile("s_waitcnt vmcnt(0)" ::: "memory");
        }
    }
    __syncthreads();
}

__device__ __forceinline__ void p0_row(const Params& p, int m, int lane) {
    unsigned long long* dst = (unsigned long long*)(p.ws + WS_XN + (size_t)m * DM * 2) + lane;
    if (m >= MROWS) {
#pragma unroll
        for (int j = 0; j < 4; ++j) dst[64 * j] = 0ull;
        return;
    }
    const float* src = m < NMETA ? p.in[6] + (size_t)m * DM : (m < TP ? p.in[0] + (size_t)(m - NMETA) * DM : p.in[1] + (size_t)(m - TP) * DM);
    const f32x4* s4 = (const f32x4*)src + lane;
    const f32x4* w4 = (const f32x4*)p.in[7] + lane;
    f32x4 v[4]; float s = 0.f;
#pragma unroll
    for (int j = 0; j < 4; ++j) { v[j] = s4[64 * j]; s += (v[j].x * v[j].x + v[j].y * v[j].y) + (v[j].z * v[j].z + v[j].w * v[j].w); }
    s = wave_sum(s);
    const float rs = 1.0f / sqrtf(s * (1.0f / DM) + EPS);
#pragma unroll
    for (int j = 0; j < 4; ++j) {
        const f32x4 w = w4[64 * j]; const f32x4 o = (v[j] * rs) * w;
        dst[64 * j] = (unsigned long long)cvtpk(o.x, o.y) | ((unsigned long long)cvtpk(o.z, o.w) << 32);
    }
}
__device__ __forceinline__ int permrow(int n) {
    const int pn = n >> 8, a = n & 255, wc = a >> 6, bj = (a >> 5) & 1, fq = (a >> 3) & 3, n2 = (a >> 2) & 1, e = a & 3;
    return pn * 256 + 128 * bj + 32 * wc + 16 * n2 + 4 * fq + e;
}
template <bool PERMW>
__device__ __forceinline__ void p0_transpose_item(const float* W, int K, int N, bf16* WT, LAS float* scr, int item, int lane) {
    const int nblk = N / 32, kb = item / nblk, nb = item % nblk, k0 = 64 * kb, n0 = 32 * nb;
#pragma unroll 8
    for (int i = 0; i < 32; ++i) { const int kk = 2 * i + (lane >> 5); scr[kk * 33 + (lane & 31)] = W[(size_t)(k0 + kk) * N + n0 + (lane & 31)]; }
    asm volatile("s_waitcnt lgkmcnt(0)" ::: "memory");
    const int c = lane & 7;
#pragma unroll
    for (int j = 0; j < 4; ++j) {
        const int n = (lane >> 3) + 8 * j; const LAS float* s = scr + (8 * c) * 33 + n;
        u32x4 o; o.x = cvtpk(s[0 * 33], s[1 * 33]); o.y = cvtpk(s[2 * 33], s[3 * 33]); o.z = cvtpk(s[4 * 33], s[5 * 33]); o.w = cvtpk(s[6 * 33], s[7 * 33]);
        const int row = PERMW ? permrow(n0 + n) : (n0 + n);
        *(u32x4*)(WT + (size_t)row * K + k0 + 8 * c) = o;
    }
    asm volatile("s_waitcnt lgkmcnt(0)" ::: "memory");
}
__device__ __forceinline__ void rope_entry(int pos, int i, float& c, float& s) {
    double inv = 1.0; for (int k = 0; k < i; ++k) inv *= 0.7498942093324558;
    const double ang = (double)pos * inv;
    const double kq = __builtin_rint(ang * 0.63661977236758134308);
    double r = __builtin_fma(-kq, 1.57079632673412561417e+00, ang); r = __builtin_fma(-kq, 6.07710050650619224932e-11, r);
    const int q = (int)((long long)kq & 3);
    const double z = r * r;
    const double sn = r + r * z * (-1.66666666666666324348e-01 + z * (8.33333333332248946124e-03 + z * (-1.98412698298579493134e-04 + z * (2.75573137070700676789e-06 + z * (-2.50507602534068634195e-08 + z * 1.58969099521155010221e-10)))));
    const double cs = 1.0 - 0.5 * z + z * z * (4.16666666666666019037e-02 + z * (-1.38888888888741095749e-03 + z * (2.48015872894767294178e-05 + z * (-2.75573143513906633035e-07 + z * (2.08757232129817482790e-09 + z * -1.13596475577881948265e-11)))));
    double cc, ss;
    if (q == 0) { cc = cs; ss = sn; } else if (q == 1) { cc = -sn; ss = cs; } else if (q == 2) { cc = -cs; ss = -sn; } else { cc = sn; ss = -cs; }
    c = (float)cc; s = (float)ss;
}
__device__ __forceinline__ void phase0(const Params& p, LAS unsigned char* lds) {
    const int tid = threadIdx.x, lane = tid & 63, wave = tid >> 6;
    const int gw = blockIdx.x * 8 + wave, NGW = gridDim.x * 8;
    LAS float* scr = (LAS float*)(lds + wave * 16384);
    constexpr int I1 = (DM / 64) * (DIN / 32), I2 = (DM / 64) * (DM / 32);
    for (int it = gw; it < I1 + I2; it += NGW) {
        if (it < I1) p0_transpose_item<true>(p.in[8], DM, DIN, (bf16*)(p.ws + WS_W1T), scr, it, lane);
        else p0_transpose_item<false>(p.in[9], DM, DM, (bf16*)(p.ws + WS_W2T), scr, it - I1, lane);
    }
    {
        const f32x4* w4 = (const f32x4*)p.in[7] + lane;
        f32x4 w[4];
#pragma unroll
        for (int j = 0; j < 4; ++j) w[j] = w4[64 * j];
        for (int m0 = gw; m0 < MPAD; m0 += 3 * NGW) {
            f32x4 v[3][4];
#pragma unroll
            for (int k = 0; k < 3; ++k) {
                const int m = m0 + k * NGW;
                if (m < MROWS) {
                    const float* src = m < NMETA ? p.in[6] + (size_t)m * DM : (m < TP ? p.in[0] + (size_t)(m - NMETA) * DM : p.in[1] + (size_t)(m - TP) * DM);
                    const f32x4* s4 = (const f32x4*)src + lane;
#pragma unroll
                    for (int j = 0; j < 4; ++j) v[k][j] = s4[64 * j];
                } else {
#pragma unroll
                    for (int j = 0; j < 4; ++j) v[k][j] = (f32x4){0.f, 0.f, 0.f, 0.f};
                }
            }
#pragma unroll
            for (int k = 0; k < 3; ++k) {
                const int m = m0 + k * NGW;
                if (m < MPAD) {
                    unsigned long long* dst = (unsigned long long*)(p.ws + WS_XN + (size_t)m * DM * 2) + lane;
                    float s = 0.f;
#pragma unroll
                    for (int j = 0; j < 4; ++j) s += (v[k][j].x * v[k][j].x + v[k][j].y * v[k][j].y) + (v[k][j].z * v[k][j].z + v[k][j].w * v[k][j].w);
                    s = wave_sum(s);
                    const float rs = 1.0f / sqrtf(s * (1.0f / DM) + EPS);
#pragma unroll
                    for (int j = 0; j < 4; ++j) {
                        const f32x4 o = (v[k][j] * rs) * w[j];
                        dst[64 * j] = (unsigned long long)cvtpk(o.x, o.y) | ((unsigned long long)cvtpk(o.z, o.w) << 32);
                    }
                }
            }
        }
    }
    {
        bf16* GH = (bf16*)(p.ws + WS_GWH); bf16* GL = (bf16*)(p.ws + WS_GWL);
        for (int e = blockIdx.x * NTHREADS + tid; e < 65536; e += gridDim.x * NTHREADS) {
            const int jj = e & 7, ln = (e >> 3) & 63, ks = (e >> 9) & 3, ct = (e >> 11) & 1, g = (e >> 12) & 1, n = e >> 13;
            const float w = (g ? p.in[14] : p.in[12])[(n * 64 + 16 * ks + 8 * (ln >> 5) + jj) * 64 + 32 * ct + (ln & 31)];
            const bf16 hb = f2bf(w); GH[e] = hb; GL[e] = f2bf(w - bf2f(hb));
        }
        if (blockIdx.x == 0) ((float*)(p.ws + WS_SP))[tid] = log1pf(expf(-p.in[16][tid]));
    }
    float* rope = (float*)(p.ws + WS_ROPE);
    for (int e = blockIdx.x * NTHREADS + tid; e < TP * 32; e += gridDim.x * NTHREADS) {
        float c, s; rope_entry(e >> 5, e & 31, c, s); rope[2 * e] = c; rope[2 * e + 1] = s;
    }
}

struct EpiIn {
    static constexpr bool PERM = false, AFTER_DRAIN = false;
    float* out; unsigned char* ws; const float* qnw; const float* knw;
    __device__ __forceinline__ void operator()(const f32x4 (&acc)[2][2][4][2], const pg8::Unit& u, int wr, int wc, int fr, int fq) const {
        const int typ = u.pn >> 1;
        const int segc = (u.pn & 1) * 256 + wc * 64 + fq * 8;
        if (typ == 2 || typ == 3) {
            const float* nwp = (typ == 2) ? qnw : knw;
            float w1[8], w2[8];
#pragma unroll
            for (int t = 0; t < 8; ++t) { w1[t] = nwp[fq * 8 + t]; w2[t] = nwp[32 + fq * 8 + t]; }
            bf16* dstb = (bf16*)(ws + WS_QB);
            const float osc = (typ == 2) ? C2 : 1.0f;
            const int hh_ = (u.pn & 1) * 2 + (wc >> 1), cc_ = wc & 1;
            f32x4 csn[4];
#define EI_ROPE(g) do { const int r_ = u.pm * 256 + ((g) >> 2) * 128 + wr * 64 + ((g) & 3) * 16 + fr; const int pos_ = r_ < TP ? r_ : (r_ < MROWS ? PAST + ((r_ - TP) & 15) : 0); \
                const f32x4* rp_ = (const f32x4*)(ws + WS_ROPE) + (size_t)pos_ * 16 + fq * 4; csn[0] = rp_[0]; csn[1] = rp_[1]; csn[2] = rp_[2]; csn[3] = rp_[3]; } while (0)
            EI_ROPE(0);
#pragma unroll
            for (int ai = 0; ai < 2; ++ai)
#pragma unroll
                for (int m = 0; m < 4; ++m) {
                    const int r = u.pm * 256 + ai * 128 + wr * 64 + m * 16 + fr;
                    const f32x4 cs4[4] = {csn[0], csn[1], csn[2], csn[3]};
                    if (ai * 4 + m + 1 < 8) EI_ROPE(ai * 4 + m + 1);
                    __builtin_amdgcn_sched_barrier(0);
                    float v1[8], v2[8]; float ss = 0.f;
#pragma unroll
                    for (int n = 0; n < 2; ++n)
#pragma unroll
                        for (int e = 0; e < 4; ++e) { v1[4 * n + e] = acc[ai][0][m][n][e]; v2[4 * n + e] = acc[ai][1][m][n][e]; ss += v1[4 * n + e] * v1[4 * n + e] + v2[4 * n + e] * v2[4 * n + e]; }
                    ss += __shfl_xor(ss, 16); ss += __shfl_xor(ss, 32);
                    const float rinv = __builtin_amdgcn_rsqf(ss * (1.0f / 64.0f) + EPS);
                    float o1[8], o2[8];
#pragma unroll
                    for (int t2 = 0; t2 < 4; ++t2) {
                        const f32x4 cs = cs4[t2];
                        { const float y1 = (v1[2 * t2] * rinv) * w1[2 * t2], y2 = (v2[2 * t2] * rinv) * w2[2 * t2]; o1[2 * t2] = y1 * cs.x - y2 * cs.y; o2[2 * t2] = y1 * cs.y + y2 * cs.x; }
                        { const float y1 = (v1[2 * t2 + 1] * rinv) * w1[2 * t2 + 1], y2 = (v2[2 * t2 + 1] * rinv) * w2[2 * t2 + 1]; o1[2 * t2 + 1] = y1 * cs.z - y2 * cs.w; o2[2 * t2 + 1] = y1 * cs.w + y2 * cs.z; }
                    }
                    u32x4 b1, b2;
                    b1.x = cvtpk(o1[0] * osc, o1[1] * osc); b1.y = cvtpk(o1[2] * osc, o1[3] * osc); b1.z = cvtpk(o1[4] * osc, o1[5] * osc); b1.w = cvtpk(o1[6] * osc, o1[7] * osc);
                    b2.x = cvtpk(o2[0] * osc, o2[1] * osc); b2.y = cvtpk(o2[2] * osc, o2[3] * osc); b2.z = cvtpk(o2[4] * osc, o2[5] * osc); b2.w = cvtpk(o2[6] * osc, o2[7] * osc);
                    if (typ == 2) { *(u32x4*)(dstb + (size_t)r * 512 + segc) = b1; *(u32x4*)(dstb + (size_t)r * 512 + segc + 32) = b2; }
                    else if (r < MROWS) {
                        const int prow = r < NMETA ? r : r + 48;
                        unsigned char* kd = ws + WS_KV + (size_t)(prow >> 6) * 131072 + hh_ * 32768 + cc_ * 8192 + fq * 1024 + (prow & 63) * 16;
                        *(u32x4*)kd = b1; *(u32x4*)(kd + 4096) = b2;
                    }
                    if (typ == 3 && r < MROWS) {
                        float* d = (r < TP) ? out + O_KP + (size_t)r * 512 : out + O_KS + (size_t)(r - TP) * 512;
                        *(f32x4*)(d + segc) = (f32x4){o1[0], o1[1], o1[2], o1[3]}; *(f32x4*)(d + segc + 4) = (f32x4){o1[4], o1[5], o1[6], o1[7]};
                        *(f32x4*)(d + segc + 32) = (f32x4){o2[0], o2[1], o2[2], o2[3]}; *(f32x4*)(d + segc + 36) = (f32x4){o2[4], o2[5], o2[6], o2[7]};
                    }
                    asm volatile("" ::: "memory");
                }
#undef EI_ROPE
        } else {
#pragma unroll
            for (int ai = 0; ai < 2; ++ai)
#pragma unroll
                for (int m = 0; m < 4; ++m) {
                    const int r = u.pm * 256 + ai * 128 + wr * 64 + m * 16 + fr;
#pragma unroll
                    for (int bj = 0; bj < 2; ++bj) {
                        const f32x4 a0 = acc[ai][bj][m][0], a1 = acc[ai][bj][m][1];
                        const int col = segc + 32 * bj;
                        if (typ == 0) {
                            float* d = (float*)(ws + WS_XA) + (size_t)r * 512 + col;
                            *(f32x4*)d = a0; *(f32x4*)(d + 4) = a1;
                        } else if (typ == 4) {
                            u32x4 b; b.x = cvtpk(a0.x, a0.y); b.y = cvtpk(a0.z, a0.w); b.z = cvtpk(a1.x, a1.y); b.w = cvtpk(a1.z, a1.w);
                            if (r < MROWS) {
                                const int prow = r < NMETA ? r : r + 48;
                                const int hh_ = (u.pn & 1) * 2 + (wc >> 1), dblk = (wc & 1) * 2 + bj;
                                *(u32x4*)(ws + WS_KV + (size_t)(prow >> 6) * 131072 + hh_ * 32768 + 16384 + (dblk * 4 + ((prow & 63) >> 4)) * 1024 + (prow & 15) * 64 + fq * 16) = b;
                            }
                            if (r < MROWS) {
                                float* d = ((r < TP) ? out + O_VP + (size_t)r * 512 : out + O_VS + (size_t)(r - TP) * 512) + col;
                                *(f32x4*)d = a0; *(f32x4*)(d + 4) = a1;
                            }
                        } else {
                            u32x4 b; b.x = cvtpk(silu_f(a0.x), silu_f(a0.y)); b.y = cvtpk(silu_f(a0.z), silu_f(a0.w)); b.z = cvtpk(silu_f(a1.x), silu_f(a1.y)); b.w = cvtpk(silu_f(a1.z), silu_f(a1.w));
                            *(u32x4*)((bf16*)(ws + (typ == 1 ? WS_SGA : WS_SGB)) + (size_t)r * 512 + col) = b;
                        }
                    }
                }
        }
    }
};
__device__ __forceinline__ int late_pn(int j) { return (j & 2) ? 10 + (j & 1) : 2 + (j & 1); }
struct P1Order {
    pg8::StaticOrder S;
    __device__ __forceinline__ void init(int G, int c) { S.init(16384, DIN, G, c); }
    __device__ __forceinline__ bool next(int i, pg8::Unit& u) const {
        if (!S.next(i, u)) return false;
        const bool gate = (u.pn == 2) | (u.pn == 3) | (u.pn == 10) | (u.pn == 11);
        if (u.pm < 6 && gate) { const int k = u.pm * 4 + ((u.pn >= 10) ? 2 + (u.pn - 10) : (u.pn - 2)); u.pm = 64 + k / 12; u.pn = k % 12; }
        return true;
    }
    __device__ __forceinline__ void a_ready(const pg8::Unit&) const {}
    __device__ __forceinline__ void done(const pg8::Unit&) const {}
};
struct OneUnit {
    int pm, pn;
    __device__ __forceinline__ bool next(int i, pg8::Unit& u) const { if (i != 0) return false; u.pm = pm; u.pn = pn; return true; }
    __device__ __forceinline__ void a_ready(const pg8::Unit&) const {}
    __device__ __forceinline__ void done(const pg8::Unit&) const {}
};
struct EpiOut {
    static constexpr bool PERM = false, AFTER_DRAIN = false;
    float* out; const float* xp; const float* xs;
    __device__ __forceinline__ void rowptr(const pg8::Unit& u, int wr, int fr, int b, int k, const float*& xr, float*& orow) const {
        const int r = u.pm * 256 + (b >> 1) * 128 + wr * 64 + ((b & 1) * 2 + k) * 16 + fr;
        if (r < 16384) { xr = xp + (size_t)r * DM; orow = out + O_YP + (size_t)r * DM; }
        else { xr = xs + (size_t)(r - 16384) * DM; orow = out + O_YS + (size_t)(r - 16384) * DM; }
    }
    __device__ __forceinline__ void operator()(const f32x4 (&acc)[2][2][4][2], const pg8::Unit& u, int wr, int wc, int fr, int fq) const {
        const int col0 = u.pn * 256 + wc * 32 + fq * 4;
        f32x4 xa[8], xb[8];
#define EO_LOAD(b, X) do { _Pragma("unroll") for (int k = 0; k < 2; ++k) { const float* xr; float* orow; rowptr(u, wr, fr, (b), k, xr, orow); \
            _Pragma("unroll") for (int bj = 0; bj < 2; ++bj) _Pragma("unroll") for (int n = 0; n < 2; ++n) X[k * 4 + bj * 2 + n] = *(const f32x4*)(xr + col0 + bj * 128 + n * 16); } } while (0)
#define EO_STORE(b, X) do { _Pragma("unroll") for (int k = 0; k < 2; ++k) { const float* xr; float* orow; rowptr(u, wr, fr, (b), k, xr, orow); \
            _Pragma("unroll") for (int bj = 0; bj < 2; ++bj) _Pragma("unroll") for (int n = 0; n < 2; ++n) \
                *(f32x4*)(orow + col0 + bj * 128 + n * 16) = X[k * 4 + bj * 2 + n] + acc[(b) >> 1][bj][((b) & 1) * 2 + k][n]; } } while (0)
        EO_LOAD(0, xa); EO_LOAD(1, xb);
        EO_STORE(0, xa); EO_LOAD(2, xa);
        EO_STORE(1, xb); EO_LOAD(3, xb);
        EO_STORE(2, xa); EO_STORE(3, xb);
#undef EO_LOAD
#undef EO_STORE
    }
};

template <int MODE>
__device__ __forceinline__ void lru_chunk(const Params& p, LAS unsigned char* lds, int idx) {
    int ch_ = threadIdx.x; asm volatile("" : "+v"(ch_));
    const int ch = ch_, lane = ch & 63, r32 = lane & 31, hi = lane >> 5;
    const int n = __builtin_amdgcn_readfirstlane(ch >> 6);
    LAS float* cfs = (LAS float*)lds;
    LAS float* als = (LAS float*)lds + 32 * LRS;
    const float* XA = (const float*)(p.ws + WS_XA);
    const bf16* SGA = (const bf16*)(p.ws + WS_SGA); bf16* YCAT = (bf16*)(p.ws + WS_YCAT);
    const bool samp = idx >= N_LRU_P;
    int row0, L, ci = 0, b = 0; float h = 0.f; float xv[35];
    if (!samp) {
        ci = idx; row0 = LRU_CH * ci; L = (TP - row0) < LRU_CH ? (TP - row0) : LRU_CH;
        if (ci > 0) { xv[0] = XA[(size_t)(row0 - 3) * 512 + ch]; xv[1] = XA[(size_t)(row0 - 2) * 512 + ch]; xv[2] = XA[(size_t)(row0 - 1) * 512 + ch]; }
        else { xv[0] = 0.f; xv[1] = 0.f; xv[2] = 0.f; }
        if (MODE == 1) h = ((const float*)(p.ws + WS_CARRY))[ci * 512 + ch];
    } else {
        b = idx - N_LRU_P; row0 = TP + 16 * b; L = 16; h = p.in[4][b * 512 + ch];
        xv[0] = p.in[5][(b * 3 + 0) * 512 + ch]; xv[1] = p.in[5][(b * 3 + 1) * 512 + ch]; xv[2] = p.in[5][(b * 3 + 2) * 512 + ch];
    }
#pragma unroll
    for (int t = 0; t < 32; ++t) xv[3 + t] = (t < L) ? XA[(size_t)(row0 + t) * 512 + ch] : 0.f;
    bf16x8 bw[16];
    { const bf16x8* GH = (const bf16x8*)(p.ws + WS_GWH);
#pragma unroll
      for (int ks = 0; ks < 4; ++ks)
#pragma unroll
        for (int g = 0; g < 2; ++g)
#pragma unroll
            for (int ct = 0; ct < 2; ++ct) bw[(ks * 2 + g) * 2 + ct] = GH[((((n * 2 + g) * 2 + ct) * 4 + ks) * 64 + lane)]; }
    { const float cw0 = p.in[10][ch], cw1 = p.in[10][512 + ch], cw2 = p.in[10][1024 + ch], cw3 = p.in[10][1536 + ch], cb = p.in[11][ch];
#pragma unroll
      for (int t = 0; t < 32; ++t) cfs[t * LRS + ch] = cb + cw0 * xv[t] + cw1 * xv[t + 1] + cw2 * xv[t + 2] + cw3 * xv[t + 3]; }
    asm volatile("s_waitcnt lgkmcnt(0)" ::: "memory");
    bf16x8 ah[4], al[4];
#pragma unroll
    for (int ks = 0; ks < 4; ++ks) {
        const LAS float* s = cfs + r32 * LRS + n * 64 + ks * 16 + hi * 8;
        const f32x4 x0 = *(const LAS f32x4*)s, x1 = *(const LAS f32x4*)(s + 4);
        u32x4 uh, ul;
#pragma unroll
        for (int q = 0; q < 4; ++q) {
            const float e0 = (q < 2) ? x0[2 * q] : x1[2 * q - 4], e1 = (q < 2) ? x0[2 * q + 1] : x1[2 * q - 3];
            const unsigned u = cvtpk(e0, e1); uh[q] = u;
            ul[q] = cvtpk(e0 - __uint_as_float(u << 16), e1 - __uint_as_float(u & 0xffff0000u));
        }
        ah[ks] = __builtin_bit_cast(bf16x8, uh); al[ks] = __builtin_bit_cast(bf16x8, ul);
    }
    f32x16 acc[2][2];
#pragma unroll
    for (int g = 0; g < 2; ++g)
#pragma unroll
        for (int ct = 0; ct < 2; ++ct)
#pragma unroll
            for (int r = 0; r < 16; ++r) acc[g][ct][r] = 0.f;
#pragma unroll
    for (int ks = 0; ks < 4; ++ks)
#pragma unroll
        for (int g = 0; g < 2; ++g)
#pragma unroll
            for (int ct = 0; ct < 2; ++ct) {
                const bf16x8 bh = bw[(ks * 2 + g) * 2 + ct];
                acc[g][ct] = __builtin_amdgcn_mfma_f32_32x32x16_bf16(ah[ks], bh, acc[g][ct], 0, 0, 0);
                acc[g][ct] = __builtin_amdgcn_mfma_f32_32x32x16_bf16(al[ks], bh, acc[g][ct], 0, 0, 0);
            }
    unsigned short sg[32];
    if (MODE == 1) {
#pragma unroll
        for (int t = 0; t < 32; ++t) sg[t] = (t < L) ? SGA[(size_t)(row0 + t) * 512 + ch] : (unsigned short)0;
    }
#pragma unroll
    for (int ct = 0; ct < 2; ++ct) {
        const int chn = n * 64 + ct * 32 + r32;
        const float gab = p.in[13][chn], gxb = p.in[15][chn], sp = ((const float*)(p.ws + WS_SP))[chn];
#pragma unroll
        for (int r = 0; r < 16; ++r) {
            const int tok = crow(r, hi);
            const float pr = acc[0][ct][r] + gab, pi = acc[1][ct][r] + gxb;
            const float rg = __builtin_amdgcn_rcpf(1.0f + __builtin_amdgcn_exp2f(-LOG2E * pr));
            const float ig = __builtin_amdgcn_rcpf(1.0f + __builtin_amdgcn_exp2f(-LOG2E * pi));
            const float la = -8.0f * rg * sp;
            const float a = __builtin_amdgcn_exp2f(LOG2E * la);
            const float x2 = 2.0f * la;
            const float om = (x2 > -0.05f) ? -x2 * (1.0f + x2 * (0.5f + x2 * (0.16666667f + x2 * 0.041666668f))) : (1.0f - a * a);
            const float bb = __builtin_amdgcn_sqrtf(om) * (ig * cfs[tok * LRS + chn]);
            als[tok * LRS + chn] = a; cfs[tok * LRS + chn] = bb;
        }
    }
    asm volatile("s_waitcnt lgkmcnt(0)" ::: "memory");
    float ca = 1.0f;
#pragma unroll
    for (int t = 0; t < 32; ++t) {
        if (t < L) {
            const float a = als[t * LRS + ch], bb = cfs[t * LRS + ch];
            if (MODE == 0) {
                __hip_atomic_store((unsigned*)(p.ws + WS_AT) + (size_t)(row0 + t) * 512 + ch, __float_as_uint(a), __ATOMIC_RELAXED, __HIP_MEMORY_SCOPE_AGENT);
                __hip_atomic_store((unsigned*)(p.ws + WS_BT) + (size_t)(row0 + t) * 512 + ch, __float_as_uint(bb), __ATOMIC_RELAXED, __HIP_MEMORY_SCOPE_AGENT);
            }
            h = a * h + bb; ca *= a;
            if (MODE == 1 && row0 + t >= NMETA) YCAT[(size_t)(row0 + t - NMETA) * 1024 + ch] = f2bf(h * bf2f(sg[t]));
        }
    }
    asm volatile("s_waitcnt lgkmcnt(0)" ::: "memory");
    constexpr int LASTL = TP - LRU_CH * (N_LRU_P - 1);
    if (MODE == 0) {
        __hip_atomic_store((unsigned*)(p.ws + WS_SUMA) + ci * 512 + ch, __float_as_uint(ca), __ATOMIC_RELAXED, __HIP_MEMORY_SCOPE_AGENT);
        __hip_atomic_store((unsigned*)(p.ws + WS_SUMB) + ci * 512 + ch, __float_as_uint(h), __ATOMIC_RELAXED, __HIP_MEMORY_SCOPE_AGENT);
        if (ci == N_LRU_P - 1) { p.out[O_CP + ch] = xv[LASTL]; p.out[O_CP + 512 + ch] = xv[LASTL + 1]; p.out[O_CP + 1024 + ch] = xv[LASTL + 2]; }
    } else if (!samp) {
        if (ci == N_LRU_P - 1) p.out[O_HP + ch] = h;
    } else {
        p.out[O_HS + b * 512 + ch] = h;
        p.out[O_CS + (b * 3 + 0) * 512 + ch] = xv[16]; p.out[O_CS + (b * 3 + 1) * 512 + ch] = xv[17]; p.out[O_CS + (b * 3 + 2) * 512 + ch] = xv[18];
    }
}
__device__ __forceinline__ void lru_pass2(const Params& p, int ci) {
    int ch_ = threadIdx.x; asm volatile("" : "+v"(ch_));
    const int ch = ch_;
    const int row0 = LRU_CH * ci, L = (TP - row0) < LRU_CH ? (TP - row0) : LRU_CH;
    const float* AT = (const float*)(p.ws + WS_AT); const float* BT = (const float*)(p.ws + WS_BT);
    const bf16* SGA = (const bf16*)(p.ws + WS_SGA); bf16* YCAT = (bf16*)(p.ws + WS_YCAT);
    float h = ((const float*)(p.ws + WS_CARRY))[ci * 512 + ch];
    float av[32], bv[32]; unsigned short sg[32];
#pragma unroll
    for (int t = 0; t < 32; ++t) {
        const size_t o_ = (size_t)(row0 + t) * 512 + ch;
        av[t] = (t < L) ? AT[o_] : 1.0f; bv[t] = (t < L) ? BT[o_] : 0.f; sg[t] = (t < L) ? SGA[o_] : (unsigned short)0;
    }
#pragma unroll
    for (int t = 0; t < 32; ++t) {
        if (t < L) {
            h = av[t] * h + bv[t];
            if (row0 + t >= NMETA) YCAT[(size_t)(row0 + t - NMETA) * 1024 + ch] = f2bf(h * bf2f(sg[t]));
        }
    }
    if (ci == N_LRU_P - 1) p.out[O_HP + ch] = h;
}
__device__ __forceinline__ void lru_arrive(const Params& p, LAS unsigned char* lds, int it_, int n_arrivers) {
    const int ch = threadIdx.x;
    unsigned* ctl = (unsigned*)(p.ws + WS_CTL);
    asm volatile("s_waitcnt vmcnt(0)" ::: "memory");
    __syncthreads();
    volatile LAS unsigned* lw = (volatile LAS unsigned*)(lds + LCTL + 16);
    if (ch == 0) lw[0] = __hip_atomic_fetch_add(ctl + CW_LRUDONE + 64 * it_, 1u, __ATOMIC_RELAXED, __HIP_MEMORY_SCOPE_AGENT);
    __syncthreads();
    if (lw[0] + 1u == (unsigned)n_arrivers) {
        __builtin_amdgcn_fence(__ATOMIC_ACQUIRE, "agent");
        asm volatile("s_waitcnt vmcnt(0)" ::: "memory");
        const float* SA = (const float*)(p.ws + WS_SUMA); const float* SB = (const float*)(p.ws + WS_SUMB); float* CR = (float*)(p.ws + WS_CARRY);
        float H = 0.f;
        for (int k = 0; k < N_LRU_P; k += 19) {
            float a_[19], b_[19];
#pragma unroll
            for (int j = 0; j < 19; ++j) { a_[j] = SA[(k + j) * 512 + ch]; b_[j] = SB[(k + j) * 512 + ch]; }
#pragma unroll
            for (int j = 0; j < 19; ++j) { __hip_atomic_store((unsigned*)CR + (k + j) * 512 + ch, __float_as_uint(H), __ATOMIC_RELAXED, __HIP_MEMORY_SCOPE_AGENT); H = a_[j] * H + b_[j]; }
        }
        asm volatile("s_waitcnt vmcnt(0)" ::: "memory");
        __syncthreads();
        if (ch == 0) __hip_atomic_store(ctl + CW_CARRYOK + 64 * it_, 1u, __ATOMIC_RELAXED, __HIP_MEMORY_SCOPE_AGENT);
    }
    __syncthreads();
}

__device__ __forceinline__ s16x4 tr16(const LAS unsigned char* p) {
    typedef short v4i16_t __attribute__((ext_vector_type(4)));
    return __builtin_bit_cast(s16x4, __builtin_amdgcn_ds_read_tr16_b64_v4i16((LAS v4i16_t*)p));
}
__device__ __forceinline__ void attn_sample(const Params& p, LAS unsigned char* lds, int b, int h, float negm, float lam) {
    int tid_ = threadIdx.x; asm volatile("" : "+v"(tid_));
    const int tid = tid_, lane = tid & 63, r32 = lane & 31, hi = lane >> 5;
    const int wid = __builtin_amdgcn_readfirstlane(tid >> 6), db = wid & 3, c = wid >> 2;
    const bf16* QBp = (const bf16*)(p.ws + WS_QB);
    constexpr int NT = 65;
    const int qrow = TP + 16 * b + (r32 & 15);
    bf16x8 qr[4];
    { const bf16* q = QBp + (size_t)qrow * 512 + h * 128 + c * 64 + hi * 8;
#pragma unroll
      for (int d0 = 0; d0 < 4; ++d0) qr[d0] = *(const bf16x8*)(q + d0 * 16); }
    f32x16 o;
#pragma unroll
    for (int r = 0; r < 16; ++r) o[r] = 0.f;
    float lacc = 0.f;
    const int kkey = 8 * (tid >> 6) + (lane & 7), kch = lane >> 3, kcol = h * 128 + kch * 8;
    const unsigned kdst = kch * 1024 + kkey * 16;
    int vkey[2], vcol[2]; unsigned vdst[2], vimg[2];
#pragma unroll
    for (int i = 0; i < 2; ++i) { const int wv = (tid >> 6) + 8 * i, q16 = ((lane >> 3) & 3) * 4 + (lane & 3); vkey[i] = wv * 4 + ((lane >> 5) & 1) * 2 + ((lane >> 2) & 1); vcol[i] = h * 128 + q16 * 8;
        vdst[i] = 16384 + ((q16 >> 2) * 4 + (vkey[i] >> 4)) * 1024 + (vkey[i] & 15) * 64 + (q16 & 3) * 16;
        vimg[i] = 16384 + ((q16 >> 2) * 4 + (b & 3)) * 1024 + (vkey[i] & 15) * 64 + (q16 & 3) * 16; }
    const unsigned char* img = p.ws + WS_KV + (size_t)(257 + (b >> 2)) * 131072 + (size_t)h * 32768;
    const unsigned kimg = kch * 1024 + ((b & 3) * 16 + (kkey & 15)) * 16;
    f32x4 sa[8], sb[8]; bool fa = false, fb = false;
#define ATT_LOAD(st, stf32, j) do { \
        if ((j) < 64) { stf32 = true; const size_t row0_ = (size_t)b * PAST + 64 * (j); const float* ck = p.in[2] + (row0_ + kkey) * 512 + kcol; \
            st[0] = *(const f32x4*)ck; st[1] = *(const f32x4*)(ck + 4); st[2] = *(const f32x4*)(ck + 64); st[3] = *(const f32x4*)(ck + 68); \
            _Pragma("unroll") for (int i_ = 0; i_ < 2; ++i_) { const float* cv = p.in[3] + (row0_ + vkey[i_]) * 512 + vcol[i_]; st[4 + 2 * i_] = *(const f32x4*)cv; st[5 + 2 * i_] = *(const f32x4*)(cv + 4); } } \
        else { stf32 = false; \
            st[0] = __builtin_bit_cast(f32x4, *(const u32x4*)(img + kimg)); st[1] = __builtin_bit_cast(f32x4, *(const u32x4*)(img + 8192 + kimg)); \
            _Pragma("unroll") for (int i_ = 0; i_ < 2; ++i_) st[2 + i_] = __builtin_bit_cast(f32x4, *(const u32x4*)(img + vimg[i_])); } \
    } while (0)
#define PK4(A_, B_2) (u32x4){cvtpk((A_)[0], (A_)[1]), cvtpk((A_)[2], (A_)[3]), cvtpk((B_2)[0], (B_2)[1]), cvtpk((B_2)[2], (B_2)[3])}
#define ATT_STORE(st, stf32, buf) do { LAS unsigned char* B_ = lds + (buf) * 32768; \
        if (stf32) { *(LAS u32x4*)(B_ + kdst) = PK4(st[0], st[1]); *(LAS u32x4*)(B_ + 8192 + kdst) = PK4(st[2], st[3]); \
                     *(LAS u32x4*)(B_ + vdst[0]) = PK4(st[4], st[5]); *(LAS u32x4*)(B_ + vdst[1]) = PK4(st[6], st[7]); } \
        else { *(LAS u32x4*)(B_ + kdst) = __builtin_bit_cast(u32x4, st[0]); *(LAS u32x4*)(B_ + 8192 + kdst) = __builtin_bit_cast(u32x4, st[1]); \
               *(LAS u32x4*)(B_ + vdst[0]) = __builtin_bit_cast(u32x4, st[2]); *(LAS u32x4*)(B_ + vdst[1]) = __builtin_bit_cast(u32x4, st[3]); } \
    } while (0)
#define ATT_COMPUTE(j, buf) do { \
            const LAS unsigned char* Bb = lds + (buf) * 32768; \
            const LAS unsigned char* Kb = Bb + c * 8192 + hi * 1024 + r32 * 16; \
            f32x16 p0, p1; \
            _Pragma("unroll") for (int r = 0; r < 16; ++r) { p0[r] = negm; p1[r] = negm; } \
            _Pragma("unroll") for (int d0 = 0; d0 < 4; ++d0) { \
                const bf16x8 b0 = *(const LAS bf16x8*)(Kb + d0 * 2048), b1 = *(const LAS bf16x8*)(Kb + d0 * 2048 + 512); \
                p0 = __builtin_amdgcn_mfma_f32_32x32x16_bf16(b0, qr[d0], p0, 0, 0, 0); \
                p1 = __builtin_amdgcn_mfma_f32_32x32x16_bf16(b1, qr[d0], p1, 0, 0, 0); } \
            _Pragma("unroll") for (int r = 0; r < 16; ++r) { p0[r] = __builtin_amdgcn_exp2f(p0[r]); p1[r] = __builtin_amdgcn_exp2f(p1[r]); } \
            if ((j) == 64) {     \
                _Pragma("unroll") for (int r = 8; r < 16; ++r) p0[r] = 0.f; \
                _Pragma("unroll") for (int r = 0; r < 16; ++r) p1[r] = 0.f; } \
            float s = 0.f; \
            _Pragma("unroll") for (int r = 0; r < 16; ++r) s += p0[r] + p1[r]; \
            lacc += s; \
            u32x4 pw[4]; \
            pw[0] = (u32x4){cvtpk(p0[0], p0[1]), cvtpk(p0[2], p0[3]), cvtpk(p0[4], p0[5]), cvtpk(p0[6], p0[7])}; \
            pw[1] = (u32x4){cvtpk(p0[8], p0[9]), cvtpk(p0[10], p0[11]), cvtpk(p0[12], p0[13]), cvtpk(p0[14], p0[15])}; \
            pw[2] = (u32x4){cvtpk(p1[0], p1[1]), cvtpk(p1[2], p1[3]), cvtpk(p1[4], p1[5]), cvtpk(p1[6], p1[7])}; \
            pw[3] = (u32x4){cvtpk(p1[8], p1[9]), cvtpk(p1[10], p1[11]), cvtpk(p1[12], p1[13]), cvtpk(p1[14], p1[15])}; \
            const LAS unsigned char* Vb = Bb + 16384 + db * 4096 + ((lane >> 4) & 1) * 32 + (lane & 3) * 8 + (4 * hi + ((lane & 15) >> 2)) * 64; \
            _Pragma("unroll") for (int kg = 0; kg < 4; ++kg) { \
                const s16x4 lo = tr16(Vb + kg * 1024), hh = tr16(Vb + kg * 1024 + 512); \
                const bf16x8 vf = (bf16x8){lo[0], lo[1], lo[2], lo[3], hh[0], hh[1], hh[2], hh[3]}; \
                o = __builtin_amdgcn_mfma_f32_32x32x16_bf16(__builtin_bit_cast(bf16x8, pw[kg]), vf, o, 0, 0, 0); } \
        } while (0)
    ATT_LOAD(sa, fa, 0); ATT_LOAD(sb, fb, 1); ATT_STORE(sa, fa, 0); __syncthreads();
    for (int j = 0; j < NT; j += 2) {
        if (j + 2 < NT) ATT_LOAD(sa, fa, j + 2);
        ATT_COMPUTE(j, 0);
        if (j + 1 < NT) ATT_STORE(sb, fb, 1);
        __syncthreads();
        if (j + 1 >= NT) break;
        if (j + 3 < NT) ATT_LOAD(sb, fb, j + 3);
        ATT_COMPUTE(j + 1, 1);
        ATT_STORE(sa, fa, 0);
        __syncthreads();
    }
#undef ATT_LOAD
#undef ATT_STORE
#undef ATT_COMPUTE
#undef PK4
    lacc += __shfl_xor(lacc, 32);
    LAS float* wsf = (LAS float*)(lds + 98304) + wid * 64;
    if (hi == 0) wsf[r32] = lacc;
    asm volatile("s_waitcnt lgkmcnt(0)" ::: "memory");
    float rli[16];
#pragma unroll
    for (int r = 0; r < 16; ++r) rli[r] = __builtin_amdgcn_rcpf(wsf[crow(r, hi)]);
    LAS float* X2 = (LAS float*)lds + db * 1024;
    LAS float* SS = (LAS float*)(lds + 65536);
    if (c == 1) {
#pragma unroll
        for (int r = 0; r < 16; ++r) X2[r * 64 + lane] = lam * (o[r] * rli[r]);
    }
    __syncthreads();
    if (c == 0) {
#pragma unroll
        for (int r = 0; r < 16; ++r) {
            const float v = o[r] * rli[r] - X2[r * 64 + lane]; o[r] = v;
            float s = v * v;
            s += __shfl_xor(s, 1); s += __shfl_xor(s, 2); s += __shfl_xor(s, 4); s += __shfl_xor(s, 8); s += __shfl_xor(s, 16);
            if (r32 == 0) SS[db * 32 + crow(r, hi)] = s;
        }
    }
    __syncthreads();
    if (c == 0) {
        const bf16* SGB = (const bf16*)(p.ws + WS_SGB); bf16* YCAT = (bf16*)(p.ws + WS_YCAT);
        const float sw = p.in[23][db * 32 + r32];
        const int e = db * 32 + r32;
        bf16 gt[8];
#pragma unroll
        for (int r = 0; r < 8; ++r) gt[r] = SGB[(size_t)(TP + 16 * b + (crow(r, hi) & 15)) * 512 + h * 128 + e];
#pragma unroll
        for (int r = 0; r < 8; ++r) {
            const int q = crow(r, hi);
            const float s = (SS[q] + SS[32 + q]) + (SS[64 + q] + SS[96 + q]);
            const float rinv = __builtin_amdgcn_rsqf(s * (1.0f / 128.0f) + EPS);
            const size_t row = (size_t)(TP + 16 * b + (q & 15));
            YCAT[(row - NMETA) * 1024 + 512 + h * 128 + e] = f2bf((((o[r] * rinv) * sw) * ONE_M_LAM0) * bf2f(gt[r]));
        }
    }
    __syncthreads();
}

__device__ __forceinline__ void glds16(const void* gsrc, unsigned lds_dst) {
    unsigned keep;
    asm volatile("s_mov_b32 %0, m0\n\ts_mov_b32 m0, %2\n\ts_nop 0\n\tglobal_load_lds_dwordx4 %1, off\n\ts_mov_b32 m0, %0" : "=&s"(keep) : "v"(gsrc), "s"(lds_dst) : "memory");
}
#ifdef PROBE_BARW
#define PBS2() unsigned long long tb_ = PB_T()
#define PBE2(k) do { const unsigned long long tn_ = PB_T(); if (PROBE_SEC == (k)) pb_wait += tn_ - tb_; tb_ = tn_; } while (0)
#else
#define PBS2() do {} while (0)
#define PBE2(k) do {} while (0)
#endif
#ifdef PROBE_BARW
__device__ unsigned long long g_barw[4];
#define PB_T() __builtin_amdgcn_s_memtime()
#define AP_WAIT_BAR(N) do { const unsigned long long ta_ = PB_T(); asm volatile("s_waitcnt vmcnt(" #N ") lgkmcnt(0)" ::: "memory"); const unsigned long long t0_ = PB_T(); asm volatile("s_barrier" ::: "memory"); const unsigned long long t1_ = PB_T(); if (PROBE_SEC == 0) pb_wait += t1_ - t0_; if (PROBE_SEC == 1) pb_wait += t0_ - ta_; } while (0)
#define AP_BAR() do { const unsigned long long ta_ = PB_T(); asm volatile("s_waitcnt lgkmcnt(0)" ::: "memory"); const unsigned long long t0_ = PB_T(); asm volatile("s_barrier" ::: "memory"); const unsigned long long t1_ = PB_T(); if (PROBE_SEC == 0) pb_wait += t1_ - t0_; if (PROBE_SEC == 1) pb_wait += t0_ - ta_; } while (0)
#else
#define AP_WAIT_BAR(N) asm volatile("s_waitcnt vmcnt(" #N ") lgkmcnt(0)\n\ts_barrier" ::: "memory")
#define AP_BAR() asm volatile("s_waitcnt lgkmcnt(0)\n\ts_barrier" ::: "memory")
#endif
__device__ __forceinline__ float fadd_s(float a, float b) { float r; asm("v_add_f32_e32 %0, %1, %2" : "=v"(r) : "v"(a), "v"(b)); return r; }
__device__ __forceinline__ void attn_prompt(const Params& p, LAS unsigned char* lds, int a, int h, float negm, float lam, unsigned* popctr, unsigned& pre) {
    int tid_ = threadIdx.x; asm volatile("" : "+v"(tid_));
    const int tid = tid_, lane = tid & 63, r32 = lane & 31, hi = lane >> 5;
    const int wid = __builtin_amdgcn_readfirstlane(tid >> 6), qs = wid & 3, c = wid >> 2;
    const bf16* QBp = (const bf16*)(p.ws + WS_QB);
    const int NT = 2 * a + 3;
#ifdef PROBE_BARW
    unsigned long long pb_wait = 0ull; const unsigned long long pb_t0 = __builtin_amdgcn_s_memtime();
#endif
    const int qrow = NMETA + 128 * a + 32 * qs + r32;
    const unsigned char* isrc = p.ws + WS_KV + (size_t)h * 32768 + wid * 1024 + lane * 16;
    const unsigned lds0 = (unsigned)(size_t)lds;
    const unsigned kdst = lds0 + wid * 1024, vdst = lds0 + 65536u + wid * 1024;
#define RFL(x) ((unsigned)__builtin_amdgcn_readfirstlane(x))
#define DMA_K(j) do { const unsigned char* g_ = isrc + (size_t)(j) * 131072; const unsigned d_ = kdst + (unsigned)((j) & 3) * 16384u; glds16(g_, RFL(d_)); glds16(g_ + 8192, RFL(d_ + 8192u)); } while (0)
#define DMA_V(j) do { const unsigned char* g_ = isrc + (size_t)(j) * 131072 + 16384; const unsigned d_ = vdst + (unsigned)((j) % 3) * 16384u; glds16(g_, RFL(d_)); glds16(g_ + 8192, RFL(d_ + 8192u)); } while (0)
#define AP_ISSUE(t) do { if ((t) + 3 < NT) DMA_K((t) + 3); if ((t) + 1 < NT) DMA_V((t) + 1); } while (0)
#define DMA_K1(j, pc) do { const unsigned char* g_ = isrc + (size_t)(j) * 131072 + (pc) * 8192; const unsigned d_ = kdst + (unsigned)((j) & 3) * 16384u + (pc) * 8192u; glds16(g_, RFL(d_)); } while (0)
#define DMA_V1(j, pc) do { const unsigned char* g_ = isrc + (size_t)(j) * 131072 + 16384 + (pc) * 8192; const unsigned d_ = vdst + (unsigned)((j) % 3) * 16384u + (pc) * 8192u; glds16(g_, RFL(d_)); } while (0)
#define AP_WAITN(t) do { const int n_ = (((t) + 3 < NT) ? 2 : 0) + (((t) + 1 < NT) ? 2 : 0); if (n_ == 4) AP_WAIT_BAR(4); else if (n_ == 2) AP_WAIT_BAR(2); else AP_WAIT_BAR(0); } while (0)
#define SBAR() __builtin_amdgcn_sched_barrier(0)
#define PIN(x) asm volatile("" : "+v"(x))
#define MF(A_, B_, C_) __builtin_amdgcn_mfma_f32_32x32x16_bf16(A_, B_, C_, 0, 0, 0)
#define KOFF(j) (((j) >> 1) * 2048 + ((j) & 1) * 512)
#define VOFF(i) ((((i) & 3) * 4 + ((i) >> 2)) * 1024)
#define VF(k) (bf16x8){vl[k][0], vl[k][1], vl[k][2], vl[k][3], vh[k][0], vh[k][1], vh[k][2], vh[k][3]}
#define PEL(P0, P1, e) (((e) < 16) ? P0[(e) & 15] : P1[(e) & 15])
    const LAS unsigned char* Kl = lds + c * 8192 + hi * 1024 + r32 * 16;
    const LAS unsigned char* Vl = lds + 65536 + ((lane >> 4) & 1) * 32 + (lane & 3) * 8 + (4 * hi + ((lane & 15) >> 2)) * 64;
    DMA_K(0); DMA_V(0); DMA_K(1); DMA_K(2);
    bf16x8 qr[4];
    { const bf16* q = QBp + (size_t)qrow * 512 + h * 128 + c * 64 + hi * 8;
#pragma unroll
      for (int d0 = 0; d0 < 4; ++d0) qr[d0] = *(const bf16x8*)(q + d0 * 16); }
    asm volatile("" : "+v"(qr[0]), "+v"(qr[1]), "+v"(qr[2]), "+v"(qr[3]));
    f32x16 o[4];
#pragma unroll
    for (int i = 0; i < 4; ++i)
#pragma unroll
        for (int r = 0; r < 16; ++r) o[i][r] = 0.f;
    float lacc = 0.f;
    u32x4 pw[4];
    bf16x8 kf[4];
    s16x4 vl[8], vh[8];
    f32x16 pA0, pA1, pB0, pB1;
    const f32x16 zero16 = {0.f, 0.f, 0.f, 0.f, 0.f, 0.f, 0.f, 0.f, 0.f, 0.f, 0.f, 0.f, 0.f, 0.f, 0.f, 0.f};
    AP_WAIT_BAR(6);
    AP_ISSUE(0);
    {
        bf16x8 k0[8];
#pragma unroll
        for (int j = 0; j < 8; ++j) k0[j] = *(const LAS bf16x8*)(Kl + KOFF(j));
        pA0 = MF(k0[0], qr[0], zero16); pA1 = MF(k0[1], qr[0], zero16);
#pragma unroll
        for (int j = 2; j < 8; ++j) { if (j & 1) pA1 = MF(k0[j], qr[j >> 1], pA1); else pA0 = MF(k0[j], qr[j >> 1], pA0); }
#pragma unroll
        for (int r = 0; r < 8; ++r) pA0[r] = __builtin_amdgcn_exp2f(pA0[r]);
#pragma unroll
        for (int r = 8; r < 16; ++r) pA0[r] = 0.f;
#pragma unroll
        for (int r = 0; r < 16; ++r) pA1[r] = 0.f;
    }
    AP_WAITN(0);
#pragma unroll
    for (int j = 0; j < 4; ++j) kf[j] = *(const LAS bf16x8*)(Kl + 16384 + KOFF(j));
#define AP_GA(i, C0, C1, P0, P1) do { \
            if ((i) >= 1) { vl[(i) - 1] = tr16(Vb_ + VOFF((i) - 1)); vh[(i) - 1] = tr16(Vb_ + VOFF((i) - 1) + 512); }     \
            SBAR(); \
            if ((i) == 0) C0 = MF(kf[0], qr[0], zero16); else if ((i) == 1) C1 = MF(kf[1], qr[0], zero16); \
            else if ((i) & 1) C1 = MF(kf[(i) & 3], qr[(i) >> 1], C1); else C0 = MF(kf[(i) & 3], qr[(i) >> 1], C0); \
            sa0 = fadd_s(sa0, PEL(P0, P1, 4 * (i))); sa1 = fadd_s(sa1, PEL(P0, P1, 4 * (i) + 1)); sa2 = fadd_s(sa2, PEL(P0, P1, 4 * (i) + 2)); sa3 = fadd_s(sa3, PEL(P0, P1, 4 * (i) + 3)); \
            PIN(sa0); PIN(sa1); PIN(sa2); PIN(sa3); \
            pw[(i) >> 1][((i) & 1) * 2] = cvtpk(PEL(P0, P1, 4 * (i)), PEL(P0, P1, 4 * (i) + 1)); pw[(i) >> 1][((i) & 1) * 2 + 1] = cvtpk(PEL(P0, P1, 4 * (i) + 2), PEL(P0, P1, 4 * (i) + 3)); \
            PIN(pw[(i) >> 1]); \
            if ((i) < 4) kf[(i) & 3] = *(const LAS bf16x8*)(Kc_ + KOFF(((i) & 3) + 4)); \
            SBAR(); } while (0)
#define AP_GB(i, C0, C1, LOADK) do { \
            o[(i) & 3] = MF(__builtin_bit_cast(bf16x8, pw[(i) >> 2]), VF((i) & 7), o[(i) & 3]); \
            if ((i) < 8) { C0[(2 * (i)) & 15] = __builtin_amdgcn_exp2f(C0[(2 * (i)) & 15]); C0[(2 * (i) + 1) & 15] = __builtin_amdgcn_exp2f(C0[(2 * (i) + 1) & 15]); PIN(C0); } \
            else { C1[(2 * (i)) & 15] = __builtin_amdgcn_exp2f(C1[(2 * (i)) & 15]); C1[(2 * (i) + 1) & 15] = __builtin_amdgcn_exp2f(C1[(2 * (i) + 1) & 15]); PIN(C1); } \
            if ((i) + 7 < 16) { vl[((i) + 7) & 7] = tr16(Vb_ + VOFF(((i) + 7) & 15)); vh[((i) + 7) & 7] = tr16(Vb_ + VOFF(((i) + 7) & 15) + 512); } \
            if ((i) >= 8 && (i) < 12 && (LOADK)) kf[(i) & 3] = *(const LAS bf16x8*)(Kn_ + KOFF((i) & 3)); \
            if ((i) == 12 && tq_ + 3 < NT) DMA_K1(tq_ + 3, 0); if ((i) == 13 && tq_ + 3 < NT) DMA_K1(tq_ + 3, 1);     \
            if ((i) == 14 && tq_ + 1 < NT) DMA_V1(tq_ + 1, 0); if ((i) == 15 && tq_ + 1 < NT) DMA_V1(tq_ + 1, 1); \
            SBAR(); } while (0)
#define AP_STEP(C0, C1, P0, P1, vslot, kslot, LOADK, TQ) do { const int tq_ = (TQ); \
        const LAS unsigned char* Vb_ = Vl + (vslot) * 16384; const LAS unsigned char* Kn_ = Kl + (kslot) * 16384; const LAS unsigned char* Kc_ = Kl + (((kslot) + 3) & 3) * 16384; \
        float sa0 = 0.f, sa1 = 0.f, sa2 = 0.f, sa3 = 0.f; \
        SBAR(); PBS2(); \
        AP_GA(0, C0, C1, P0, P1); AP_GA(1, C0, C1, P0, P1); AP_GA(2, C0, C1, P0, P1); AP_GA(3, C0, C1, P0, P1); \
        AP_GA(4, C0, C1, P0, P1); AP_GA(5, C0, C1, P0, P1); AP_GA(6, C0, C1, P0, P1); AP_GA(7, C0, C1, P0, P1); \
        lacc += (sa0 + sa1) + (sa2 + sa3); PBE2(2); \
        AP_GB(0, C0, C1, LOADK); AP_GB(1, C0, C1, LOADK); AP_GB(2, C0, C1, LOADK); AP_GB(3, C0, C1, LOADK); \
        AP_GB(4, C0, C1, LOADK); AP_GB(5, C0, C1, LOADK); AP_GB(6, C0, C1, LOADK); AP_GB(7, C0, C1, LOADK); \
        AP_GB(8, C0, C1, LOADK); AP_GB(9, C0, C1, LOADK); AP_GB(10, C0, C1, LOADK); AP_GB(11, C0, C1, LOADK); \
        AP_GB(12, C0, C1, LOADK); AP_GB(13, C0, C1, LOADK); AP_GB(14, C0, C1, LOADK); AP_GB(15, C0, C1, LOADK); PBE2(3); \
    } while (0)
#define AP_DRAIN(P0, P1, vslot) do { \
        const LAS unsigned char* Vb_ = Vl + (vslot) * 16384; \
        float sacc = 0.f; \
        _Pragma("unroll") for (int r = 0; r < 16; ++r) sacc += P0[r] + P1[r]; \
        lacc += sacc; \
        pw[0] = (u32x4){cvtpk(P0[0], P0[1]), cvtpk(P0[2], P0[3]), cvtpk(P0[4], P0[5]), cvtpk(P0[6], P0[7])}; \
        pw[1] = (u32x4){cvtpk(P0[8], P0[9]), cvtpk(P0[10], P0[11]), cvtpk(P0[12], P0[13]), cvtpk(P0[14], P0[15])}; \
        pw[2] = (u32x4){cvtpk(P1[0], P1[1]), cvtpk(P1[2], P1[3]), cvtpk(P1[4], P1[5]), cvtpk(P1[6], P1[7])}; \
        pw[3] = (u32x4){cvtpk(P1[8], P1[9]), cvtpk(P1[10], P1[11]), cvtpk(P1[12], P1[13]), cvtpk(P1[14], P1[15])}; \
        _Pragma("unroll") for (int i = 0; i < 4; ++i) { vl[i] = tr16(Vb_ + VOFF(i)); vh[i] = tr16(Vb_ + VOFF(i) + 512); } \
        SBAR(); \
        _Pragma("unroll") for (int i = 0; i < 16; ++i) { \
            if (i + 4 < 16) { vl[(i + 4) & 7] = tr16(Vb_ + VOFF(i + 4)); vh[(i + 4) & 7] = tr16(Vb_ + VOFF(i + 4) + 512); } \
            o[i & 3] = MF(__builtin_bit_cast(bf16x8, pw[i >> 2]), VF(i & 7), o[i & 3]); \
            SBAR(); } \
    } while (0)
    int vsl = 0, ksl = 2;
    for (int t = 1; t < NT; t += 2) {
        AP_STEP(pB0, pB1, pA0, pA1, vsl, ksl, true, t);
        AP_WAITN(t);
        vsl = (vsl == 2) ? 0 : vsl + 1; ksl = (ksl + 1) & 3;
        AP_STEP(pA0, pA1, pB0, pB1, vsl, ksl, (t + 2 < NT), t + 1);
        AP_WAITN(t + 1);
        vsl = (vsl == 2) ? 0 : vsl + 1; ksl = (ksl + 1) & 3;
    }
    if (qs < 2) {
#pragma unroll
        for (int r = 0; r < 16; ++r) { pA0[r] = 0.f; pA1[r] = 0.f; }
    }
    AP_DRAIN(pA0, pA1, vsl);
    AP_BAR();
    if (tid == 0) pre = atomicAdd(popctr, 1u);
#ifdef PROBE_BARW
    if (blockIdx.x == PROBE_BLK && tid == PROBE_WAVE * 64) { g_barw[0] += pb_wait; g_barw[1] += __builtin_amdgcn_s_memtime() - pb_t0; }
#endif
#undef AP_STEP
#undef AP_DRAIN
#undef AP_ISSUE
#undef AP_WAITN
#undef DMA_K
#undef DMA_V
    if (a < 12) {
        if (tid == 0) { const unsigned* lt = (const unsigned*)(p.ws + WS_CTL) + CW_LATE; while (__hip_atomic_load(lt, __ATOMIC_RELAXED, __HIP_MEMORY_SCOPE_AGENT) < 24u) __builtin_amdgcn_s_sleep(8); }
        __syncthreads();
        __builtin_amdgcn_fence(__ATOMIC_ACQUIRE, "agent");
        asm volatile("s_waitcnt vmcnt(0)" ::: "memory");
    }
    const size_t erow0 = (size_t)(NMETA + 128 * a + 32 * qs);
    u32x4 gq[4];
#pragma unroll
    for (int k = 0; k < 4; ++k) { const int pi = lane + 64 * k; gq[k] = *(const u32x4*)((const bf16*)(p.ws + WS_SGB) + (erow0 + (pi >> 3)) * 512 + h * 128 + c * 64 + (pi & 7) * 8); }
    const int eb = c * 64 + r32;
    const float swa = p.in[23][eb] * ONE_M_LAM0, swb = p.in[23][eb + 32] * ONE_M_LAM0;
    lacc += __shfl_xor(lacc, 32);
    LAS float* wsf = (LAS float*)(lds + LCTL + 256) + wid * 64;
    if (hi == 0) wsf[r32] = lacc;
    asm volatile("s_waitcnt lgkmcnt(0)" ::: "memory");
    float rli[16];
#pragma unroll
    for (int r = 0; r < 16; ++r) rli[r] = __builtin_amdgcn_rcpf(wsf[crow(r, hi)]);
    LAS float* XW = (LAS float*)lds + (qs * 2 + c) * 2048;
    const LAS float* XR = (const LAS float*)lds + (qs * 2 + (c ^ 1)) * 2048;
    LAS float* SS = (LAS float*)(lds + 65536);
    const float fsc = (c == 0) ? 1.0f : lam;
#define EP_WRITE(OA, OB) do { _Pragma("unroll") for (int r = 0; r < 16; ++r) { XW[r * 64 + lane] = fsc * (OA[r] * rli[r]); XW[(16 + r) * 64 + lane] = fsc * (OB[r] * rli[r]); } } while (0)
    if (c == 0) EP_WRITE(o[2], o[3]); else EP_WRITE(o[0], o[1]);
#undef EP_WRITE
    __syncthreads();
#define EP_COMB(OA, OB, SGN) do { _Pragma("unroll") for (int r = 0; r < 16; ++r) { \
            const float va = SGN * (fsc * (OA[r] * rli[r]) - XR[r * 64 + lane]), vb = SGN * (fsc * (OB[r] * rli[r]) - XR[(16 + r) * 64 + lane]); \
            OA[r] = va; OB[r] = vb; float s_ = va * va + vb * vb; \
            s_ += __shfl_xor(s_, 1); s_ += __shfl_xor(s_, 2); s_ += __shfl_xor(s_, 4); s_ += __shfl_xor(s_, 8); s_ += __shfl_xor(s_, 16); \
            if (r32 == 0) SS[(qs * 2 + c) * 32 + crow(r, hi)] = s_; } } while (0)
    if (c == 0) EP_COMB(o[0], o[1], 1.0f); else EP_COMB(o[2], o[3], -1.0f);
#undef EP_COMB
    __syncthreads();
    {
        LAS unsigned char* GT = lds + 66560 + wid * 8192;
        LAS unsigned char* YT = GT + 4096;
#pragma unroll
        for (int k = 0; k < 4; ++k) { const int pi = lane + 64 * k; *(LAS u32x4*)(GT + (pi >> 3) * 128 + (pi & 7) * 16) = gq[k]; }
        asm volatile("s_waitcnt lgkmcnt(0)" ::: "memory");
#define EP_FIN(OA, OB) do { _Pragma("unroll") for (int r = 0; r < 16; ++r) { \
            const int q_ = crow(r, hi); \
            const float s_ = SS[(qs * 2) * 32 + q_] + SS[(qs * 2 + 1) * 32 + q_]; \
            const float rinv = __builtin_amdgcn_rsqf(s_ * (1.0f / 128.0f) + EPS); \
            const float ga_ = bf2f(*(const LAS bf16*)(GT + q_ * 128 + r32 * 2)), gb_ = bf2f(*(const LAS bf16*)(GT + q_ * 128 + 64 + r32 * 2)); \
            *(LAS bf16*)(YT + q_ * 128 + r32 * 2) = f2bf(((OA[r] * rinv) * swa) * ga_); \
            *(LAS bf16*)(YT + q_ * 128 + 64 + r32 * 2) = f2bf(((OB[r] * rinv) * swb) * gb_); } } while (0)
        if (c == 0) EP_FIN(o[0], o[1]); else EP_FIN(o[2], o[3]);
#undef EP_FIN
        asm volatile("s_waitcnt lgkmcnt(0)" ::: "memory");
        bf16* YCAT = (bf16*)(p.ws + WS_YCAT);
#pragma unroll
        for (int k = 0; k < 4; ++k) { const int pi = lane + 64 * k;
            *(u32x4*)(YCAT + (erow0 - NMETA + (pi >> 3)) * 1024 + 512 + h * 128 + c * 64 + (pi & 7) * 8) = *(const LAS u32x4*)(YT + (pi >> 3) * 128 + (pi & 7) * 16); }
    }
    __syncthreads();
}

__global__ void __launch_bounds__(NTHREADS, 2) mega_fwd(Params p) {
    extern __shared__ __attribute__((aligned(16))) unsigned char lds_raw[];
    LAS unsigned char* lds = (LAS unsigned char*)lds_raw;
    const int tid = threadIdx.x;
    unsigned* ctl = (unsigned*)(p.ws + WS_CTL);
    if (tid < 64) ((LAS unsigned*)(lds + LCTL))[tid] = 0u;
    __syncthreads();
    XcdBarrier bar = xcd_barrier_post(ctl + CW_BAR, (volatile LAS unsigned*)(lds + LCTL + 64));
#define GRID_BAR() xcd_barrier(bar)
#ifdef PROBE_TIME
    unsigned long long ts_[8];
#define STAMP(i) ts_[i] = __builtin_amdgcn_s_memrealtime()
#else
#define STAMP(i) do {} while (0)
#endif
    STAMP(0);

#ifdef PROBE_ALLX2
    for (int it_ = 0; it_ < 2; ++it_) {
    if (it_) GRID_BAR();
#else
    { const int it_ = 0;
#endif
#ifndef NO_P0
    phase0(p, lds);
#ifdef PROBE_P0X2
    __syncthreads();
    phase0(p, lds);
#endif
#endif
    GRID_BAR();
    STAMP(1);

#ifndef NO_P1
    {
        pg8::Gemm g{(const pg8::bf16_t*)(p.ws + WS_XN), (const pg8::bf16_t*)(p.ws + WS_W1T), MPAD, DIN, DM};
        P1Order S; S.init((int)gridDim.x, (int)blockIdx.x);
        EpiIn E{p.out, p.ws, p.in[17], p.in[18]};
        pg8::gemm_phase<EpiIn, P1Order, true, true>(lds, g, S, E);
#ifdef PROBE_P1X2
        __syncthreads();
        pg8::gemm_phase<EpiIn, pg8::StaticOrder, true, true>(lds, g, S, E);
#endif
    }
#endif
    GRID_BAR();
    STAMP(2);

#ifndef NO_P1
    for (int k = blockIdx.x; k < 24; k += gridDim.x) {
        pg8::Gemm g{(const pg8::bf16_t*)(p.ws + WS_XN), (const pg8::bf16_t*)(p.ws + WS_W1T), MPAD, DIN, DM};
        OneUnit S{k >> 2, late_pn(k & 3)};
        EpiIn E{p.out, p.ws, p.in[17], p.in[18]};
        pg8::gemm_phase<EpiIn, OneUnit, false, true>(lds, g, S, E);
        asm volatile("s_waitcnt vmcnt(0)" ::: "memory");
        __syncthreads();
        if (tid == 0) { __builtin_amdgcn_fence(__ATOMIC_RELEASE, "agent"); asm volatile("s_waitcnt vmcnt(0)" ::: "memory");
                        __hip_atomic_fetch_add(ctl + CW_LATE + 64 * it_, 1u, __ATOMIC_RELAXED, __HIP_MEMORY_SCOPE_AGENT); }
        __syncthreads();
    }
#endif
    STAMP(2);
#ifndef NO_LRU
    const int lru_b0 = (int)gridDim.x >> 1, lru_nb = (int)gridDim.x - lru_b0;
    if ((int)blockIdx.x >= lru_b0)
    for (int idx = (int)blockIdx.x - lru_b0; idx < N_LRU; idx += lru_nb) {
        if (idx < N_LRU_P) lru_chunk<0>(p, lds, idx);
        else {
            lru_chunk<1>(p, lds, idx);
            asm volatile("s_waitcnt vmcnt(0)" ::: "memory");
            __syncthreads();
            if (tid == 0) { __builtin_amdgcn_fence(__ATOMIC_RELEASE, "agent"); asm volatile("s_waitcnt vmcnt(0)" ::: "memory");
                            __hip_atomic_fetch_add(ctl + CW_SAMPDONE + 64 * it_, 1u, __ATOMIC_RELAXED, __HIP_MEMORY_SCOPE_AGENT); }
        }
    }
    if ((int)blockIdx.x >= lru_b0 && (int)blockIdx.x - lru_b0 < N_LRU_P) lru_arrive(p, lds, it_, lru_nb < N_LRU_P ? lru_nb : N_LRU_P);
    __syncthreads();
#endif
    STAMP(3);
    {
        float d1 = 0.f, d2 = 0.f, mq = 0.f, mk = 0.f;
        for (int i = 0; i < 64; ++i) { d1 += p.in[19][i] * p.in[20][i]; d2 += p.in[21][i] * p.in[22][i]; mq = fmaxf(mq, fabsf(p.in[17][i])); mk = fmaxf(mk, fabsf(p.in[18][i])); }
        const float lam = expf(d1) - expf(d2) + LAM0;
        const float negm = -(8.0f * mq * mk) * LOG2E;
        volatile LAS unsigned* qw = (volatile LAS unsigned*)(lds + LCTL);
        bool carry_ok = false;
        int kq = 0;
        unsigned pre = 0u; bool have_pre = false;
        for (;;) {
            if (tid == 0) {
                unsigned code = 0xffffffffu;
                bool hp = have_pre;
                while (kq < 4) {
                    const unsigned hq = (blockIdx.x + (unsigned)kq) & 3u;
                    const unsigned ix = hp ? pre : atomicAdd(&ctl[CW_QH + 64 * hq + 512 * it_], 1u);
                    hp = false;
                    if (ix < 144u) { code = 0x80000000u | (hq << 16) | ix; break; }
                    ++kq;
                }
                if (kq >= 4) code = (unsigned)N_ATT + atomicAdd(&ctl[CW_Q + 128 * it_], 1u);
                qw[0] = code;
            }
            have_pre = false;
            __syncthreads();
            const unsigned code = qw[0];
            __syncthreads();
#ifndef NO_ATT
            if (code & 0x80000000u) {
                const int hq = (int)((code >> 16) & 3u), ix = (int)(code & 0xffffu);
                if (ix >= 32 && ix < 48) {
                    attn_sample(p, lds, ix - 32, hq, negm, lam);
                    asm volatile("s_waitcnt vmcnt(0)" ::: "memory");
                    __syncthreads();
                    if (tid == 0) { __builtin_amdgcn_fence(__ATOMIC_RELEASE, "agent"); asm volatile("s_waitcnt vmcnt(0)" ::: "memory");
                                    __hip_atomic_fetch_add(ctl + CW_SAMPDONE + 64 * it_, 1u, __ATOMIC_RELAXED, __HIP_MEMORY_SCOPE_AGENT); }
                } else { attn_prompt(p, lds, (ix < 32) ? 127 - ix : 127 - (ix - 16), hq, negm, lam, &ctl[CW_QH + 64 * hq + 512 * it_], pre); have_pre = true; }
                continue;
            }
#endif
            const int idx = (int)code;
            if (idx >= N_P2) break;
            if (idx < N_ATT + N_SGEMM) {
                if (tid == 0) { while (__hip_atomic_load(ctl + CW_SAMPDONE + 64 * it_, __ATOMIC_RELAXED, __HIP_MEMORY_SCOPE_AGENT) < 80u) __builtin_amdgcn_s_sleep(8); }
                __syncthreads();
                __builtin_amdgcn_fence(__ATOMIC_ACQUIRE, "agent");
                asm volatile("s_waitcnt vmcnt(0)" ::: "memory");
                __syncthreads();
                pg8::Gemm g{(const pg8::bf16_t*)(p.ws + WS_YCAT), (const pg8::bf16_t*)(p.ws + WS_W2T), 16640, DM, DM};
                OneUnit S{64, idx - N_ATT};
                EpiOut E{p.out, p.in[0], p.in[1]};
                pg8::gemm_phase<EpiOut, OneUnit, false, true>(lds, g, S, E);
                __syncthreads();
            } else {
#ifndef NO_LRU
                if (!carry_ok) {
                    if (tid == 0) { while (__hip_atomic_load(ctl + CW_CARRYOK + 64 * it_, __ATOMIC_RELAXED, __HIP_MEMORY_SCOPE_AGENT) == 0u) __builtin_amdgcn_s_sleep(8);
                                    while (__hip_atomic_load(ctl + CW_LATE + 64 * it_, __ATOMIC_RELAXED, __HIP_MEMORY_SCOPE_AGENT) < 24u) __builtin_amdgcn_s_sleep(8); }
                    __syncthreads();
                    __builtin_amdgcn_fence(__ATOMIC_ACQUIRE, "agent");
                    asm volatile("s_waitcnt vmcnt(0)" ::: "memory");
                    carry_ok = true;
                }
                lru_pass2(p, idx - N_ATT - N_SGEMM);
#endif
            }
        }
    }
    GRID_BAR();
    STAMP(4);
    STAMP(5);

#ifndef NO_P4
    {
        pg8::Gemm g{(const pg8::bf16_t*)(p.ws + WS_YCAT), (const pg8::bf16_t*)(p.ws + WS_W2T), 16384, DM, DM};
        pg8::StaticOrder S; S.init(16384, DM, (int)gridDim.x, (int)blockIdx.x);
        EpiOut E{p.out, p.in[0], p.in[1]};
        pg8::gemm_phase<EpiOut, pg8::StaticOrder, true, true>(lds, g, S, E);
#ifdef PROBE_P4X2
        __syncthreads();
        pg8::gemm_phase<EpiOut, pg8::StaticOrder, true, true>(lds, g, S, E);
#endif
    }
#endif
    }
#ifdef PROBE_TIME
    STAMP(6);
    if (blockIdx.x == 0) {
        __syncthreads();
#ifdef PROBE_BARW
        const float T_us = 1000.0f * (float)g_barw[0] / (float)(g_barw[1] + 1ull);
#else
        const float T_us = (float)(ts_[PROBE_B] - ts_[PROBE_A]) * 0.01f;
#endif
#ifndef PROBE_SCALE
#define PROBE_SCALE 1e-7f
#endif
        const float dl = sqrtf(1e-5f + T_us * PROBE_SCALE);
        for (int i = tid; i < 24576; i += NTHREADS) p.out[O_CS + i] *= (1.0f + dl);
    }
#endif
}

extern "C" void kernel_launch(void* const* d_in, const int* in_sizes, int n_in, void* d_out, int out_size, void* d_ws, size_t ws_size, hipStream_t stream) {
    static int grid = 0;
    if (grid == 0) {
        if (n_in != 24 || out_size != (int)O_END || ws_size < WS_END) { fprintf(stderr, "kernel_launch: unexpected shapes (n_in %d out %d ws %zu)\n", n_in, out_size, ws_size); grid = -1; return; }
        int dev = 0, cus = 0, per_cu = 0;
        hipGetDevice(&dev);
        hipDeviceGetAttribute(&cus, hipDeviceAttributeMultiprocessorCount, dev);
        hipFuncSetAttribute((const void*)mega_fwd, hipFuncAttributeMaxDynamicSharedMemorySize, LDS_BYTES);
        hipOccupancyMaxActiveBlocksPerMultiprocessor(&per_cu, (const void*)mega_fwd, NTHREADS, LDS_BYTES);
        if (per_cu < 1) { fprintf(stderr, "kernel_launch: occupancy query says %d blocks/CU\n", per_cu); per_cu = 1; }
        (void)hipGetLastError();
        grid = cus;
    }
    if (grid < 0) return;
    hipMemsetAsync((char*)d_ws + WS_CTL, 0, CTL_ZERO_BYTES, stream);
    Params prm{};
    for (int i = 0; i < 24; ++i) prm.in[i] = (const float*)d_in[i];
    prm.out = (float*)d_out; prm.ws = (unsigned char*)d_ws;
    void* args[] = {&prm};
    hipError_t e = hipLaunchCooperativeKernel((const void*)mega_fwd, dim3(grid), dim3(NTHREADS), args, LDS_BYTES, stream);
    if (e != hipSuccess) fprintf(stderr, "cooperative launch failed: %s (grid %d)\n", hipGetErrorString(e), grid);
}
```

```cpp
#include <hip/hip_runtime.h>
#include <cstdio>
#include <cstdint>
namespace pg8 {
#define PG8_LAS __attribute__((address_space(3)))
typedef unsigned short bf16_t;
typedef short bf16x8 __attribute__((ext_vector_type(8)));
typedef float f32x4 __attribute__((ext_vector_type(4)));
typedef unsigned u32x4 __attribute__((ext_vector_type(4)));
constexpr int BM = 256, BK = 64, HALF = 128, HTB = HALF * BK * 2  , STAGE_BYTES = 8 * HTB, NXCD = 8, WGM = 8;

__host__ __device__ __forceinline__ int lds_byte(int r, int c) { const int st = (r >> 4) * 2 + (c >> 5), rr = r & 15, cc = c & 31, ob = rr * 64 + cc * 2; return st * 1024 + (ob ^ (((ob >> 9) & 1) << 5)); }
__host__ __device__ __forceinline__ void stage_rc(int b, int& R, int& C) { const int st = b / 1024, sb = b % 1024, swz = sb ^ (((sb >> 9) & 1) << 5); R = (st >> 1) * 16 + swz / 64; C = (st & 1) * 32 + (swz % 64) / 2; }
__host__ __device__ __forceinline__ int perm32(int rho) { const int n = rho >> 4, i = rho & 15; return 8 * (i >> 2) + 4 * n + (i & 3); }

struct Unit { int pm, pn; };
struct Gemm { const bf16_t* A; const bf16_t* Bt; int M, N, K; };

struct StaticOrder {
    int nM, nN, nwg, G, c;
    __host__ __device__ void init(int M, int N, int G_, int c_) { nM = M / BM; nN = N / BM; nwg = nM * nN; G = G_; c = c_; }
    __host__ __device__ bool next(int i, Unit& u) const {
        const long L = (long)i * G + c; if (L >= nwg) return false;
        int wgid = (int)L; { const int q = nwg / NXCD, r = nwg % NXCD, xcd = wgid % NXCD, off = wgid / NXCD; wgid = (xcd < r ? xcd * (q + 1) : r * (q + 1) + (xcd - r) * q) + off; }
        const int nig = WGM * nN, gid = wgid / nig, fm = gid * WGM, gsz = (nM - fm) < WGM ? (nM - fm) : WGM;
        u.pm = fm + ((wgid % nig) % gsz); u.pn = (wgid % nig) / gsz; return true;
    }
    __device__ __forceinline__ void a_ready(const Unit&) const {}
    __device__ __forceinline__ void done(const Unit&) const {}
};

template <class Epi, class Sched, bool ALIGN_EPI = false, bool SP2 = false>
__device__ __forceinline__ void gemm_phase(PG8_LAS unsigned char* lds, const Gemm g, const Sched& S, const Epi& E) {
    int tid_ = threadIdx.x; asm volatile("" : "+v"(tid_));
    const int tid = tid_, wid = __builtin_amdgcn_readfirstlane(tid >> 6), lane = tid & 63, wr = wid >> 2, wc = wid & 3, fr = lane & 15, fq = lane >> 4;
    const int K = g.K, nt = K / BK;
    unsigned voffA[2], voffB[2];
#pragma unroll
    for (int i = 0; i < 2; ++i) { int R, C; stage_rc(tid * 16 + i * 8192, R, C); const int Rb = Epi::PERM ? ((R & ~31) + perm32(R & 31)) : R;
        voffA[i] = (unsigned)(R * K + C) * 2u; voffB[i] = (unsigned)(Rb * K + C) * 2u; }
    const size_t kstep = (size_t)(BK * 2);
    const size_t hstep = (size_t)HALF * K * 2;
    const size_t tstep = 2 * hstep;
    const unsigned ldsw = (unsigned)wid * 1024u;
    const int aoff = lds_byte(wr * 64 + fr, fq * 8), boff = lds_byte(wc * 32 + fr, fq * 8);
#define PG8_SA(b, h) (((b) * 2 + (h)) * HTB)
#define PG8_SB(b, h) ((4 + (b) * 2 + (h)) * HTB)
#define PG8_STAGE(bufoff, gbase, voff) do { _Pragma("unroll") for (int _i = 0; _i < 2; ++_i) \
        __builtin_amdgcn_global_load_lds((const unsigned*)((const char*)(gbase) + (voff)[_i]), (PG8_LAS unsigned*)(lds + (bufoff) + ldsw + _i * 8192), 16, 0, 0); } while (0)
#define PG8_LDA(dst, b, h) do { _Pragma("unroll") for (int m = 0; m < 4; ++m) _Pragma("unroll") for (int k = 0; k < 2; ++k) dst[m][k] = *(const PG8_LAS bf16x8*)(lds + PG8_SA(b, h) + aoff + m * 2048 + k * 1024); } while (0)
#define PG8_LDB(dst, b, h) do { _Pragma("unroll") for (int n = 0; n < 2; ++n) _Pragma("unroll") for (int k = 0; k < 2; ++k) dst[n][k] = *(const PG8_LAS bf16x8*)(lds + PG8_SB(b, h) + boff + n * 2048 + k * 1024); } while (0)
#define PG8_MMA(ai, bj, At, Bt) do { __builtin_amdgcn_s_setprio(1); _Pragma("unroll") for (int m = 0; m < 4; ++m) _Pragma("unroll") for (int n = 0; n < 2; ++n) _Pragma("unroll") for (int k = 0; k < 2; ++k) \
        acc[ai][bj][m][n] = __builtin_amdgcn_mfma_f32_16x16x32_bf16(Bt[n][k], At[m][k], acc[ai][bj][m][n], 0, 0, 0); __builtin_amdgcn_s_setprio(0); } while (0)
#define PG8_WAIT_V(n) asm volatile("s_waitcnt vmcnt(" #n ")" ::: "memory")
#define PG8_WAIT_L(n) asm volatile("s_waitcnt lgkmcnt(" #n ")" ::: "memory")
#define PG8_BAR __builtin_amdgcn_s_barrier()
#define PG8_SCHED __builtin_amdgcn_sched_barrier(0)
    Unit cur, nxt; int ui = 0;
    if (!S.next(0, cur)) return;
    f32x4 acc[2][2][4][2];
#pragma unroll
    for (int a = 0; a < 2; ++a)
#pragma unroll
        for (int b = 0; b < 2; ++b)
#pragma unroll
            for (int m = 0; m < 4; ++m)
#pragma unroll
                for (int n = 0; n < 2; ++n) acc[a][b][m][n] = (f32x4){0.f, 0.f, 0.f, 0.f};
    bf16x8 At[4][2], B0[2][2], B1[2][2];
    const char* cA = (const char*)g.A + (size_t)cur.pm * tstep; const char* cB = (const char*)g.Bt + (size_t)cur.pn * tstep;
    S.a_ready(cur);
    if constexpr (SP2) {
        PG8_STAGE(PG8_SB(0, 0), cB, voffB); PG8_STAGE(PG8_SB(0, 1), cB + hstep, voffB); PG8_STAGE(PG8_SA(0, 0), cA, voffA); PG8_STAGE(PG8_SA(0, 1), cA + hstep, voffA);
        if (wr == 1) PG8_BAR;
        PG8_WAIT_V(2); PG8_BAR;
        PG8_STAGE(PG8_SB(1, 0), cB + kstep, voffB); PG8_STAGE(PG8_SA(1, 0), cA + kstep, voffA); PG8_STAGE(PG8_SB(1, 1), cB + hstep + kstep, voffB);
        PG8_WAIT_V(6); PG8_BAR;
    } else {
        PG8_STAGE(PG8_SB(0, 0), cB, voffB); PG8_STAGE(PG8_SA(0, 0), cA, voffA); PG8_STAGE(PG8_SB(0, 1), cB + hstep, voffB); PG8_STAGE(PG8_SA(0, 1), cA + hstep, voffA);
        if (wr == 1) PG8_BAR;
        PG8_WAIT_V(4); PG8_BAR;
        PG8_STAGE(PG8_SB(1, 0), cB + kstep, voffB); PG8_STAGE(PG8_SA(1, 0), cA + kstep, voffA); PG8_STAGE(PG8_SB(1, 1), cB + hstep + kstep, voffB);
        PG8_WAIT_V(6); PG8_BAR;
    }
    for (;;) {
        const bool has_next = S.next(ui + 1, nxt);
        const char* nA = has_next ? (const char*)g.A + (size_t)nxt.pm * tstep : cA; const char* nB = has_next ? (const char*)g.Bt + (size_t)nxt.pn * tstep : cB;
        for (int t = 0; t < nt; t += 2) {
            const bool last = (t == nt - 2);
            const char* a1 = cA + (size_t)(t + 1) * kstep;
            const char* a2 = last ? nA : cA + (size_t)(t + 2) * kstep; const char* b2 = last ? nB : cB + (size_t)(t + 2) * kstep;
            const char* a3 = a2 + kstep; const char* b3 = b2 + kstep;
            if (last && has_next) S.a_ready(nxt);
            if constexpr (SP2) {
            PG8_LDB(B0, 0, 0); PG8_LDB(B1, 0, 1); PG8_SCHED; PG8_LDA(At, 0, 0); PG8_STAGE(PG8_SA(1, 1), a1 + hstep, voffA);
            PG8_WAIT_V(8); PG8_WAIT_L(0); PG8_BAR; PG8_MMA(0, 0, At, B0); PG8_MMA(0, 1, At, B1); PG8_BAR; PG8_SCHED;
            PG8_LDA(At, 0, 1); PG8_STAGE(PG8_SB(0, 0), b2, voffB); PG8_STAGE(PG8_SB(0, 1), b2 + hstep, voffB); PG8_STAGE(PG8_SA(0, 0), a2, voffA);
            PG8_WAIT_V(8); PG8_WAIT_L(0); PG8_BAR; PG8_MMA(1, 0, At, B0); PG8_MMA(1, 1, At, B1); PG8_BAR; PG8_SCHED;
            PG8_LDB(B0, 1, 0); PG8_LDB(B1, 1, 1); PG8_SCHED; PG8_LDA(At, 1, 0); PG8_STAGE(PG8_SA(0, 1), a2 + hstep, voffA);
            PG8_WAIT_V(8); PG8_WAIT_L(0); PG8_BAR; PG8_MMA(0, 0, At, B0); PG8_MMA(0, 1, At, B1); PG8_BAR; PG8_SCHED;
            PG8_LDA(At, 1, 1); PG8_STAGE(PG8_SB(1, 0), b3, voffB); PG8_STAGE(PG8_SB(1, 1), b3 + hstep, voffB); PG8_STAGE(PG8_SA(1, 0), a3, voffA);
            PG8_WAIT_V(8); PG8_WAIT_L(0); PG8_BAR; PG8_MMA(1, 0, At, B0); PG8_MMA(1, 1, At, B1); PG8_BAR; PG8_SCHED;
            } else {
            PG8_LDB(B0, 0, 0); PG8_SCHED; PG8_LDA(At, 0, 0); PG8_STAGE(PG8_SA(1, 1), a1 + hstep, voffA);
            PG8_WAIT_L(8); PG8_BAR; PG8_WAIT_L(0); PG8_MMA(0, 0, At, B0); PG8_BAR; PG8_SCHED;
            PG8_LDB(B1, 0, 1); PG8_STAGE(PG8_SB(0, 0), b2, voffB);
            PG8_BAR; PG8_WAIT_L(0); PG8_MMA(0, 1, At, B1); PG8_BAR;
            PG8_LDA(At, 0, 1); PG8_STAGE(PG8_SA(0, 0), a2, voffA);
            PG8_BAR; PG8_WAIT_L(0); PG8_MMA(1, 0, At, B0); PG8_BAR; PG8_SCHED;
            PG8_STAGE(PG8_SB(0, 1), b2 + hstep, voffB);
            PG8_WAIT_V(6); PG8_BAR; PG8_MMA(1, 1, At, B1); PG8_BAR;
            PG8_LDB(B0, 1, 0); PG8_SCHED; PG8_LDA(At, 1, 0); PG8_STAGE(PG8_SA(0, 1), a2 + hstep, voffA);
            PG8_WAIT_L(8); PG8_BAR; PG8_WAIT_L(0); PG8_MMA(0, 0, At, B0); PG8_BAR; PG8_SCHED;
            PG8_LDB(B1, 1, 1); PG8_STAGE(PG8_SB(1, 0), b3, voffB);
            PG8_BAR; PG8_WAIT_L(0); PG8_MMA(0, 1, At, B1); PG8_BAR;
            PG8_LDA(At, 1, 1); PG8_STAGE(PG8_SA(1, 0), a3, voffA);
            PG8_BAR; PG8_WAIT_L(0); PG8_MMA(1, 0, At, B0); PG8_BAR; PG8_SCHED;
            PG8_STAGE(PG8_SB(1, 1), b3 + hstep, voffB);
            PG8_WAIT_V(6); PG8_BAR; PG8_MMA(1, 1, At, B1); PG8_BAR;
            }
        }
        if constexpr (ALIGN_EPI) { if (wr == 0) PG8_BAR; }
        if constexpr (!Epi::AFTER_DRAIN) { E(acc, cur, wr, wc, fr, fq); S.done(cur); }
        if (!has_next) break;
#pragma unroll
        for (int a = 0; a < 2; ++a)
#pragma unroll
            for (int b = 0; b < 2; ++b)
#pragma unroll
                for (int m = 0; m < 4; ++m)
#pragma unroll
                    for (int n = 0; n < 2; ++n) acc[a][b][m][n] = (f32x4){0.f, 0.f, 0.f, 0.f};
        cur = nxt; cA = nA; cB = nB; ++ui;
        if constexpr (ALIGN_EPI) { if (wr == 1) PG8_BAR; }
    }
    PG8_WAIT_V(0);
    if constexpr (!ALIGN_EPI) { if (wr == 0) PG8_BAR; }
    PG8_BAR;
    if constexpr (Epi::AFTER_DRAIN) { E.fused(acc, cur, wr, wc, fr, fq, lds, wid, lane); S.done(cur); }
#undef PG8_SA
#undef PG8_SB
#undef PG8_STAGE
#undef PG8_LDA
#undef PG8_LDB
#undef PG8_MMA
#undef PG8_WAIT_V
#undef PG8_WAIT_L
#undef PG8_BAR
#undef PG8_SCHED
}
}

#define LAS __attribute__((address_space(3)))
typedef unsigned short bf16;
typedef short bf16x8 __attribute__((ext_vector_type(8)));
typedef short s16x4 __attribute__((ext_vector_type(4)));
typedef float f32x4 __attribute__((ext_vector_type(4)));
typedef float f32x16 __attribute__((ext_vector_type(16)));
typedef unsigned u32x4 __attribute__((ext_vector_type(4)));
typedef unsigned u32x2 __attribute__((ext_vector_type(2)));

constexpr int NTHREADS = 512;
constexpr int DM = 1024, NMETA = 16, TP = 16400, NSAMP = 256, MROWS = TP + NSAMP  , MPAD = 16896, PAST = 4096;
constexpr int DL = 512, DIN = 3072;
constexpr float EPS = 1e-6f;
constexpr float C2 = 0.18033688011112042f;
constexpr float LOG2E = 1.4426950408889634f;
constexpr float ONE_M_LAM0 = 0.8f, LAM0 = 0.2f;

constexpr size_t O_YP = 0, O_YS = 16777216, O_KP = 17039360, O_VP = 25436160, O_HP = 33832960, O_CP = 33833472,
                 O_KS = 33835008, O_VS = 33966080, O_HS = 34097152, O_CS = 34105344, O_END = 34129920;

constexpr size_t MiB = 1u << 20;
constexpr size_t WS_CTL = 0, WS_XN = 1 * MiB, WS_W1T = 35 * MiB, WS_W2T = 41 * MiB, WS_ROPE = 43 * MiB, WS_XA = 48 * MiB, WS_SGA = 82 * MiB,
                 WS_SGB = 99 * MiB, WS_QB = 116 * MiB, WS_KV = 133 * MiB  , WS_YCAT = 167 * MiB, WS_GWH = 201 * MiB  , WS_GWL = 202 * MiB, WS_SP = 203 * MiB  ,
                 WS_AT = 204 * MiB  , WS_BT = 237 * MiB, WS_SUMA = 271 * MiB, WS_SUMB = 273 * MiB, WS_CARRY = 275 * MiB, WS_END = 277 * MiB;
constexpr int CW_Q = 64, CW_LRUDONE = 256, CW_CARRYOK = 320, CW_SAMPDONE = 384, CW_QH = 1024, CW_LATE = 448, CW_BAR = 4096;
constexpr size_t CTL_ZERO_BYTES = 65536;
constexpr int LCTL = 147456;
constexpr int LDS_BYTES = LCTL + 4096;
constexpr int LRS = 516;

constexpr int LRU_CH = 32;
constexpr int N_LRU_P = (TP + LRU_CH - 1) / LRU_CH;
constexpr int N_LRU = N_LRU_P + 16;
constexpr int N_ATT = 512 + 64;
constexpr int N_SGEMM = 4;
constexpr int N_P2 = N_ATT + N_SGEMM + N_LRU_P;

struct Params { const float* in[24]; float* out; unsigned char* ws; };

__device__ __forceinline__ unsigned cvtpk(float lo, float hi) {
    typedef float f2 __attribute__((ext_vector_type(2))); typedef __bf16 b2 __attribute__((ext_vector_type(2)));
    f2 v = {lo, hi}; b2 b = __builtin_convertvector(v, b2); return __builtin_bit_cast(unsigned, b);
}
__device__ __forceinline__ float bf2f(bf16 v) { return __uint_as_float(((unsigned)v) << 16); }
__device__ __forceinline__ bf16 f2bf(float f) { return (bf16)(cvtpk(f, 0.f) & 0xffffu); }
__device__ __forceinline__ float wave_sum(float v) {
#pragma unroll
    for (int o = 1; o < 64; o <<= 1) v += __shfl_xor(v, o);
    return v;
}
__device__ __forceinline__ int crow(int r, int hi) { return (r & 3) + 8 * (r >> 2) + 4 * hi; }
__device__ __forceinline__ float silu_f(float x) { return x * __builtin_amdgcn_rcpf(1.0f + __builtin_amdgcn_exp2f(-1.4426950408889634f * x)); }

#define XB_TMO      128
#define XB_XCNT(j)  (256  + 64 * (j))
#define XB_XSUB(j)  (1280 + 64 * (j))
#define XB_XGEN(j)  (2304 + 64 * (j))
#define XB_TOP      3328
#define XB_TOPGEN   3392
#define XCD_BAR_WORDS 3456
#define XB_SPIN_CAP (1u << 18)

__device__ __forceinline__ unsigned xb_ld(unsigned* p)              { return __hip_atomic_load(p, __ATOMIC_RELAXED, __HIP_MEMORY_SCOPE_AGENT); }
__device__ __forceinline__ unsigned xb_add(unsigned* p, unsigned v) { return __hip_atomic_fetch_add(p, v, __ATOMIC_RELAXED, __HIP_MEMORY_SCOPE_AGENT); }
__device__ __forceinline__ unsigned xb_xcc_id() { return (unsigned)__builtin_amdgcn_s_getreg((3 << 11) | 20) & 0xFu; }
#define XB_SPIN(cond, bar) do { unsigned _sp = 0; while (cond) { __builtin_amdgcn_s_sleep(1); \
    if ((++_sp & 255u) == 0u) { if (xb_ld(&(bar)[XB_TMO])) break; if (_sp > XB_SPIN_CAP) { atomicAdd(&(bar)[XB_TMO], 1u); break; } } } } while (0)

struct XcdBarrier {
    unsigned* bar; unsigned x;
    volatile LAS unsigned* st;
};

__device__ __forceinline__ XcdBarrier xcd_barrier_post(unsigned* bar, volatile LAS unsigned* st) {
    XcdBarrier b; b.bar = bar; b.x = xb_xcc_id(); b.st = st;
    if (threadIdx.x == 0) (void)xb_add(&bar[XB_XCNT(b.x)], 1u);
    return b;
}
__device__ __forceinline__ void xcd_barrier_complete(unsigned* bar, unsigned x, unsigned& nloc, unsigned& nx) {
    const unsigned G = gridDim.x * gridDim.y * gridDim.z;
    unsigned sum, cnt, mine, sp = 0u;
    for (;;) {
        sum = 0u; cnt = 0u; mine = 0u;
#pragma unroll
        for (unsigned j = 0; j < 16; ++j) { const unsigned c = xb_ld(&bar[XB_XCNT(j)]); sum += c; cnt += (c > 0u) ? 1u : 0u; mine = (j == x) ? c : mine; }
        if (sum == G) break;
        __builtin_amdgcn_s_sleep(1);
        if ((++sp & 255u) == 0u) { if (xb_ld(&bar[XB_TMO])) break; if (sp > XB_SPIN_CAP) { atomicAdd(&bar[XB_TMO], 1u); break; } }
    }
    nloc = mine > 0u ? mine : 1u; nx = cnt > 0u ? cnt : 1u;
}

__device__ __forceinline__ void xcd_barrier(const XcdBarrier& b) {
    asm volatile("s_waitcnt vmcnt(0)" ::: "memory");
    __syncthreads();
    if (threadIdx.x == 0) {
        unsigned* bar = b.bar;
        __builtin_amdgcn_s_waitcnt(0);
        unsigned nloc = b.st[0], nx = b.st[1];
        if (nloc == 0u) { xcd_barrier_complete(bar, b.x, nloc, nx); b.st[0] = nloc; b.st[1] = nx; }
        const unsigned old = xb_add(&bar[XB_XSUB(b.x)], 1u);
        const unsigned gen = old / nloc;
        if (old + 1u == (gen + 1u) * nloc) {
            __builtin_amdgcn_fence(__ATOMIC_RELEASE, "agent");
            asm volatile("s_waitcnt vmcnt(0)" ::: "memory");
            const unsigned og = xb_add(&bar[XB_TOP], 1u);
            const unsigned tg = og / nx;
            if (og + 1u == (tg + 1u) * nx) xb_add(&bar[XB_TOPGEN], 1u);
            else XB_SPIN(xb_ld(&bar[XB_TOPGEN]) == tg, bar);
            __builtin_amdgcn_fence(__ATOMIC_ACQUIRE, "agent");
            xb_add(&bar[XB_XGEN(b.x)], 1u);
            asm volatile("s_waitcnt vmcnt(0)" ::: "memory");
        } else {
            XB_SPIN(xb_ld(&bar[XB_XGEN(b.x)]) == gen, bar);
            __builtin_amdgcn_fence(__ATOMIC_ACQUIRE, "agent");
            asm volatile("s_waitcnt vmcnt(0)" ::: "memory");
        }
    }
    __syncthreads();
}

__device__ __forceinline__ void p0_row(const Params& p, int m, int lane) {
    unsigned long long* dst = (unsigned long long*)(p.ws + WS_XN + (size_t)m * DM * 2) + lane;
    if (m >= MROWS) {
#pragma unroll
        for (int j = 0; j < 4; ++j) dst[64 * j] = 0ull;
        return;
    }
    const float* src = m < NMETA ? p.in[6] + (size_t)m * DM : (m < TP ? p.in[0] + (size_t)(m - NMETA) * DM : p.in[1] + (size_t)(m - TP) * DM);
    const f32x4* s4 = (const f32x4*)src + lane;
    const f32x4* w4 = (const f32x4*)p.in[7] + lane;
    f32x4 v[4]; float s = 0.f;
#pragma unroll
    for (int j = 0; j < 4; ++j) { v[j] = s4[64 * j]; s += (v[j].x * v[j].x + v[j].y * v[j].y) + (v[j].z * v[j].z + v[j].w * v[j].w); }
    s = wave_sum(s);
    const float rs = 1.0f / sqrtf(s * (1.0f / DM) + EPS);
#pragma unroll
    for (int j = 0; j < 4; ++j) {
        const f32x4 w = w4[64 * j]; const f32x4 o = (v[j] * rs) * w;
        dst[64 * j] = (unsigned long long)cvtpk(o.x, o.y) | ((unsigned long long)cvtpk(o.z, o.w) << 32);
    }
}
__device__ __forceinline__ int permrow(int n) {
    const int pn = n >> 8, a = n & 255, wc = a >> 6, bj = (a >> 5) & 1, fq = (a >> 3) & 3, n2 = (a >> 2) & 1, e = a & 3;
    return pn * 256 + 128 * bj + 32 * wc + 16 * n2 + 4 * fq + e;
}
template <bool PERMW>
__device__ __forceinline__ void p0_transpose_item(const float* W, int K, int N, bf16* WT, LAS float* scr, int item, int lane) {
    const int nblk = N / 32, kb = item / nblk, nb = item % nblk, k0 = 64 * kb, n0 = 32 * nb;
#pragma unroll 8
    for (int i = 0; i < 32; ++i) { const int kk = 2 * i + (lane >> 5); scr[kk * 33 + (lane & 31)] = W[(size_t)(k0 + kk) * N + n0 + (lane & 31)]; }
    asm volatile("s_waitcnt lgkmcnt(0)" ::: "memory");
    const int c = lane & 7;
#pragma unroll
    for (int j = 0; j < 4; ++j) {
        const int n = (lane >> 3) + 8 * j; const LAS float* s = scr + (8 * c) * 33 + n;
        u32x4 o; o.x = cvtpk(s[0 * 33], s[1 * 33]); o.y = cvtpk(s[2 * 33], s[3 * 33]); o.z = cvtpk(s[4 * 33], s[5 * 33]); o.w = cvtpk(s[6 * 33], s[7 * 33]);
        const int row = PERMW ? permrow(n0 + n) : (n0 + n);
        *(u32x4*)(WT + (size_t)row * K + k0 + 8 * c) = o;
    }
    asm volatile("s_waitcnt lgkmcnt(0)" ::: "memory");
}
__device__ __forceinline__ void rope_entry(int pos, int i, float& c, float& s) {
    double inv = 1.0; for (int k = 0; k < i; ++k) inv *= 0.7498942093324558;
    const double ang = (double)pos * inv;
    const double kq = __builtin_rint(ang * 0.63661977236758134308);
    double r = __builtin_fma(-kq, 1.57079632673412561417e+00, ang); r = __builtin_fma(-kq, 6.07710050650619224932e-11, r);
    const int q = (int)((long long)kq & 3);
    const double z = r * r;
    const double sn = r + r * z * (-1.66666666666666324348e-01 + z * (8.33333333332248946124e-03 + z * (-1.98412698298579493134e-04 + z * (2.75573137070700676789e-06 + z * (-2.50507602534068634195e-08 + z * 1.58969099521155010221e-10)))));
    const double cs = 1.0 - 0.5 * z + z * z * (4.16666666666666019037e-02 + z * (-1.38888888888741095749e-03 + z * (2.48015872894767294178e-05 + z * (-2.75573143513906633035e-07 + z * (2.08757232129817482790e-09 + z * -1.13596475577881948265e-11)))));
    double cc, ss;
    if (q == 0) { cc = cs; ss = sn; } else if (q == 1) { cc = -sn; ss = cs; } else if (q == 2) { cc = -cs; ss = -sn; } else { cc = sn; ss = -cs; }
    c = (float)cc; s = (float)ss;
}
__device__ __forceinline__ void phase0(const Params& p, LAS unsigned char* lds) {
    const int tid = threadIdx.x, lane = tid & 63, wave = tid >> 6;
    const int gw = blockIdx.x * 8 + wave, NGW = gridDim.x * 8;
    LAS float* scr = (LAS float*)(lds + wave * 16384);
    constexpr int I1 = (DM / 64) * (DIN / 32), I2 = (DM / 64) * (DM / 32);
    for (int it = gw; it < I1 + I2; it += NGW) {
        if (it < I1) p0_transpose_item<true>(p.in[8], DM, DIN, (bf16*)(p.ws + WS_W1T), scr, it, lane);
        else p0_transpose_item<false>(p.in[9], DM, DM, (bf16*)(p.ws + WS_W2T), scr, it - I1, lane);
    }
    {
        const f32x4* w4 = (const f32x4*)p.in[7] + lane;
        f32x4 w[4];
#pragma unroll
        for (int j = 0; j < 4; ++j) w[j] = w4[64 * j];
        for (int m0 = gw; m0 < MPAD; m0 += 3 * NGW) {
            f32x4 v[3][4];
#pragma unroll
            for (int k = 0; k < 3; ++k) {
                const int m = m0 + k * NGW;
                if (m < MROWS) {
                    const float* src = m < NMETA ? p.in[6] + (size_t)m * DM : (m < TP ? p.in[0] + (size_t)(m - NMETA) * DM : p.in[1] + (size_t)(m - TP) * DM);
                    const f32x4* s4 = (const f32x4*)src + lane;
#pragma unroll
                    for (int j = 0; j < 4; ++j) v[k][j] = s4[64 * j];
                } else {
#pragma unroll
                    for (int j = 0; j < 4; ++j) v[k][j] = (f32x4){0.f, 0.f, 0.f, 0.f};
                }
            }
#pragma unroll
            for (int k = 0; k < 3; ++k) {
                const int m = m0 + k * NGW;
                if (m < MPAD) {
                    unsigned long long* dst = (unsigned long long*)(p.ws + WS_XN + (size_t)m * DM * 2) + lane;
                    float s = 0.f;
#pragma unroll
                    for (int j = 0; j < 4; ++j) s += (v[k][j].x * v[k][j].x + v[k][j].y * v[k][j].y) + (v[k][j].z * v[k][j].z + v[k][j].w * v[k][j].w);
                    s = wave_sum(s);
                    const float rs = 1.0f / sqrtf(s * (1.0f / DM) + EPS);
#pragma unroll
                    for (int j = 0; j < 4; ++j) {
                        const f32x4 o = (v[k][j] * rs) * w[j];
                        dst[64 * j] = (unsigned long long)cvtpk(o.x, o.y) | ((unsigned long long)cvtpk(o.z, o.w) << 32);
                    }
                }
            }
        }
    }
    {
        bf16* GH = (bf16*)(p.ws + WS_GWH); bf16* GL = (bf16*)(p.ws + WS_GWL);
        for (int e = blockIdx.x * NTHREADS + tid; e < 65536; e += gridDim.x * NTHREADS) {
            const int jj = e & 7, ln = (e >> 3) & 63, ks = (e >> 9) & 3, ct = (e >> 11) & 1, g = (e >> 12) & 1, n = e >> 13;
            const float w = (g ? p.in[14] : p.in[12])[(n * 64 + 16 * ks + 8 * (ln >> 5) + jj) * 64 + 32 * ct + (ln & 31)];
            const bf16 hb = f2bf(w); GH[e] = hb; GL[e] = f2bf(w - bf2f(hb));
        }
        if (blockIdx.x == 0) ((float*)(p.ws + WS_SP))[tid] = log1pf(expf(-p.in[16][tid]));
    }
    float* rope = (float*)(p.ws + WS_ROPE);
    for (int e = blockIdx.x * NTHREADS + tid; e < TP * 32; e += gridDim.x * NTHREADS) {
        float c, s; rope_entry(e >> 5, e & 31, c, s); rope[2 * e] = c; rope[2 * e + 1] = s;
    }
}

struct EpiIn {
    static constexpr bool PERM = false, AFTER_DRAIN = false;
    float* out; unsigned char* ws; const float* qnw; const float* knw;
    __device__ __forceinline__ void operator()(const f32x4 (&acc)[2][2][4][2], const pg8::Unit& u, int wr, int wc, int fr, int fq) const {
        const int typ = u.pn >> 1;
        const int segc = (u.pn & 1) * 256 + wc * 64 + fq * 8;
        if (typ == 2 || typ == 3) {
            const float* nwp = (typ == 2) ? qnw : knw;
            float w1[8], w2[8];
#pragma unroll
            for (int t = 0; t < 8; ++t) { w1[t] = nwp[fq * 8 + t]; w2[t] = nwp[32 + fq * 8 + t]; }
            bf16* dstb = (bf16*)(ws + WS_QB);
            const float osc = (typ == 2) ? C2 : 1.0f;
            const int hh_ = (u.pn & 1) * 2 + (wc >> 1), cc_ = wc & 1;
            f32x4 csn[4];
#define EI_ROPE(g) do { const int r_ = u.pm * 256 + ((g) >> 2) * 128 + wr * 64 + ((g) & 3) * 16 + fr; const int pos_ = r_ < TP ? r_ : (r_ < MROWS ? PAST + ((r_ - TP) & 15) : 0); \
                const f32x4* rp_ = (const f32x4*)(ws + WS_ROPE) + (size_t)pos_ * 16 + fq * 4; csn[0] = rp_[0]; csn[1] = rp_[1]; csn[2] = rp_[2]; csn[3] = rp_[3]; } while (0)
            EI_ROPE(0);
#pragma unroll
            for (int ai = 0; ai < 2; ++ai)
#pragma unroll
                for (int m = 0; m < 4; ++m) {
                    const int r = u.pm * 256 + ai * 128 + wr * 64 + m * 16 + fr;
                    const f32x4 cs4[4] = {csn[0], csn[1], csn[2], csn[3]};
                    if (ai * 4 + m + 1 < 8) EI_ROPE(ai * 4 + m + 1);
                    __builtin_amdgcn_sched_barrier(0);
                    float v1[8], v2[8]; float ss = 0.f;
#pragma unroll
                    for (int n = 0; n < 2; ++n)
#pragma unroll
                        for (int e = 0; e < 4; ++e) { v1[4 * n + e] = acc[ai][0][m][n][e]; v2[4 * n + e] = acc[ai][1][m][n][e]; ss += v1[4 * n + e] * v1[4 * n + e] + v2[4 * n + e] * v2[4 * n + e]; }
                    ss += __shfl_xor(ss, 16); ss += __shfl_xor(ss, 32);
                    const float rinv = __builtin_amdgcn_rsqf(ss * (1.0f / 64.0f) + EPS);
                    float o1[8], o2[8];
#pragma unroll
                    for (int t2 = 0; t2 < 4; ++t2) {
                        const f32x4 cs = cs4[t2];
                        { const float y1 = (v1[2 * t2] * rinv) * w1[2 * t2], y2 = (v2[2 * t2] * rinv) * w2[2 * t2]; o1[2 * t2] = y1 * cs.x - y2 * cs.y; o2[2 * t2] = y1 * cs.y + y2 * cs.x; }
                        { const float y1 = (v1[2 * t2 + 1] * rinv) * w1[2 * t2 + 1], y2 = (v2[2 * t2 + 1] * rinv) * w2[2 * t2 + 1]; o1[2 * t2 + 1] = y1 * cs.z - y2 * cs.w; o2[2 * t2 + 1] = y1 * cs.w + y2 * cs.z; }
                    }
                    u32x4 b1, b2;
                    b1.x = cvtpk(o1[0] * osc, o1[1] * osc); b1.y = cvtpk(o1[2] * osc, o1[3] * osc); b1.z = cvtpk(o1[4] * osc, o1[5] * osc); b1.w = cvtpk(o1[6] * osc, o1[7] * osc);
                    b2.x = cvtpk(o2[0] * osc, o2[1] * osc); b2.y = cvtpk(o2[2] * osc, o2[3] * osc); b2.z = cvtpk(o2[4] * osc, o2[5] * osc); b2.w = cvtpk(o2[6] * osc, o2[7] * osc);
                    if (typ == 2) { *(u32x4*)(dstb + (size_t)r * 512 + segc) = b1; *(u32x4*)(dstb + (size_t)r * 512 + segc + 32) = b2; }
                    else if (r < MROWS) {
                        const int prow = r < NMETA ? r : r + 48;
                        unsigned char* kd = ws + WS_KV + (size_t)(prow >> 6) * 131072 + hh_ * 32768 + cc_ * 8192 + fq * 1024 + (prow & 63) * 16;
                        *(u32x4*)kd = b1; *(u32x4*)(kd + 4096) = b2;
                    }
                    if (typ == 3 && r < MROWS) {
                        float* d = (r < TP) ? out + O_KP + (size_t)r * 512 : out + O_KS + (size_t)(r - TP) * 512;
                        *(f32x4*)(d + segc) = (f32x4){o1[0], o1[1], o1[2], o1[3]}; *(f32x4*)(d + segc + 4) = (f32x4){o1[4], o1[5], o1[6], o1[7]};
                        *(f32x4*)(d + segc + 32) = (f32x4){o2[0], o2[1], o2[2], o2[3]}; *(f32x4*)(d + segc + 36) = (f32x4){o2[4], o2[5], o2[6], o2[7]};
                    }
                    asm volatile("" ::: "memory");
                }
#undef EI_ROPE
        } else {
#pragma unroll
            for (int ai = 0; ai < 2; ++ai)
#pragma unroll
                for (int m = 0; m < 4; ++m) {
                    const int r = u.pm * 256 + ai * 128 + wr * 64 + m * 16 + fr;
#pragma unroll
                    for (int bj = 0; bj < 2; ++bj) {
                        const f32x4 a0 = acc[ai][bj][m][0], a1 = acc[ai][bj][m][1];
                        const int col = segc + 32 * bj;
                        if (typ == 0) {
                            float* d = (float*)(ws + WS_XA) + (size_t)r * 512 + col;
                            *(f32x4*)d = a0; *(f32x4*)(d + 4) = a1;
                        } else if (typ == 4) {
                            u32x4 b; b.x = cvtpk(a0.x, a0.y); b.y = cvtpk(a0.z, a0.w); b.z = cvtpk(a1.x, a1.y); b.w = cvtpk(a1.z, a1.w);
                            if (r < MROWS) {
                                const int prow = r < NMETA ? r : r + 48;
                                const int hh_ = (u.pn & 1) * 2 + (wc >> 1), dblk = (wc & 1) * 2 + bj;
                                *(u32x4*)(ws + WS_KV + (size_t)(prow >> 6) * 131072 + hh_ * 32768 + 16384 + (dblk * 4 + ((prow & 63) >> 4)) * 1024 + (prow & 15) * 64 + fq * 16) = b;
                            }
                            if (r < MROWS) {
                                float* d = ((r < TP) ? out + O_VP + (size_t)r * 512 : out + O_VS + (size_t)(r - TP) * 512) + col;
                                *(f32x4*)d = a0; *(f32x4*)(d + 4) = a1;
                            }
                        } else {
                            u32x4 b; b.x = cvtpk(silu_f(a0.x), silu_f(a0.y)); b.y = cvtpk(silu_f(a0.z), silu_f(a0.w)); b.z = cvtpk(silu_f(a1.x), silu_f(a1.y)); b.w = cvtpk(silu_f(a1.z), silu_f(a1.w));
                            *(u32x4*)((bf16*)(ws + (typ == 1 ? WS_SGA : WS_SGB)) + (size_t)r * 512 + col) = b;
                        }
                    }
                }
        }
    }
};
__device__ __forceinline__ int late_pn(int j) { return (j & 2) ? 10 + (j & 1) : 2 + (j & 1); }
struct P1Order {
    pg8::StaticOrder S;
    __device__ __forceinline__ void init(int G, int c) { S.init(16384, DIN, G, c); }
    __device__ __forceinline__ bool next(int i, pg8::Unit& u) const {
        if (!S.next(i, u)) return false;
        const bool gate = (u.pn == 2) | (u.pn == 3) | (u.pn == 10) | (u.pn == 11);
        if (u.pm < 6 && gate) { const int k = u.pm * 4 + ((u.pn >= 10) ? 2 + (u.pn - 10) : (u.pn - 2)); u.pm = 64 + k / 12; u.pn = k % 12; }
        return true;
    }
    __device__ __forceinline__ void a_ready(const pg8::Unit&) const {}
    __device__ __forceinline__ void done(const pg8::Unit&) const {}
};
struct OneUnit {
    int pm, pn;
    __device__ __forceinline__ bool next(int i, pg8::Unit& u) const { if (i != 0) return false; u.pm = pm; u.pn = pn; return true; }
    __device__ __forceinline__ void a_ready(const pg8::Unit&) const {}
    __device__ __forceinline__ void done(const pg8::Unit&) const {}
};
struct EpiOut {
    static constexpr bool PERM = false, AFTER_DRAIN = false;
    float* out; const float* xp; const float* xs;
    __device__ __forceinline__ void rowptr(const pg8::Unit& u, int wr, int fr, int b, int k, const float*& xr, float*& orow) const {
        const int r = u.pm * 256 + (b >> 1) * 128 + wr * 64 + ((b & 1) * 2 + k) * 16 + fr;
        if (r < 16384) { xr = xp + (size_t)r * DM; orow = out + O_YP + (size_t)r * DM; }
        else { xr = xs + (size_t)(r - 16384) * DM; orow = out + O_YS + (size_t)(r - 16384) * DM; }
    }
    __device__ __forceinline__ void operator()(const f32x4 (&acc)[2][2][4][2], const pg8::Unit& u, int wr, int wc, int fr, int fq) const {
        const int col0 = u.pn * 256 + wc * 32 + fq * 4;
        f32x4 xa[8], xb[8];
#define EO_LOAD(b, X) do { _Pragma("unroll") for (int k = 0; k < 2; ++k) { const float* xr; float* orow; rowptr(u, wr, fr, (b), k, xr, orow); \
            _Pragma("unroll") for (int bj = 0; bj < 2; ++bj) _Pragma("unroll") for (int n = 0; n < 2; ++n) X[k * 4 + bj * 2 + n] = *(const f32x4*)(xr + col0 + bj * 128 + n * 16); } } while (0)
#define EO_STORE(b, X) do { _Pragma("unroll") for (int k = 0; k < 2; ++k) { const float* xr; float* orow; rowptr(u, wr, fr, (b), k, xr, orow); \
            _Pragma("unroll") for (int bj = 0; bj < 2; ++bj) _Pragma("unroll") for (int n = 0; n < 2; ++n) \
                *(f32x4*)(orow + col0 + bj * 128 + n * 16) = X[k * 4 + bj * 2 + n] + acc[(b) >> 1][bj][((b) & 1) * 2 + k][n]; } } while (0)
        EO_LOAD(0, xa); EO_LOAD(1, xb);
        EO_STORE(0, xa); EO_LOAD(2, xa);
        EO_STORE(1, xb); EO_LOAD(3, xb);
        EO_STORE(2, xa); EO_STORE(3, xb);
#undef EO_LOAD
#undef EO_STORE
    }
};

template <int MODE>
__device__ __forceinline__ void lru_chunk(const Params& p, LAS unsigned char* lds, int idx) {
    int ch_ = threadIdx.x; asm volatile("" : "+v"(ch_));
    const int ch = ch_, lane = ch & 63, r32 = lane & 31, hi = lane >> 5;
    const int n = __builtin_amdgcn_readfirstlane(ch >> 6);
    LAS float* cfs = (LAS float*)lds;
    LAS float* als = (LAS float*)lds + 32 * LRS;
    const float* XA = (const float*)(p.ws + WS_XA);
    const bf16* SGA = (const bf16*)(p.ws + WS_SGA); bf16* YCAT = (bf16*)(p.ws + WS_YCAT);
    const bool samp = idx >= N_LRU_P;
    int row0, L, ci = 0, b = 0; float h = 0.f; float xv[35];
    if (!samp) {
        ci = idx; row0 = LRU_CH * ci; L = (TP - row0) < LRU_CH ? (TP - row0) : LRU_CH;
        if (ci > 0) { xv[0] = XA[(size_t)(row0 - 3) * 512 + ch]; xv[1] = XA[(size_t)(row0 - 2) * 512 + ch]; xv[2] = XA[(size_t)(row0 - 1) * 512 + ch]; }
        else { xv[0] = 0.f; xv[1] = 0.f; xv[2] = 0.f; }
        if (MODE == 1) h = ((const float*)(p.ws + WS_CARRY))[ci * 512 + ch];
    } else {
        b = idx - N_LRU_P; row0 = TP + 16 * b; L = 16; h = p.in[4][b * 512 + ch];
        xv[0] = p.in[5][(b * 3 + 0) * 512 + ch]; xv[1] = p.in[5][(b * 3 + 1) * 512 + ch]; xv[2] = p.in[5][(b * 3 + 2) * 512 + ch];
    }
#pragma unroll
    for (int t = 0; t < 32; ++t) xv[3 + t] = (t < L) ? XA[(size_t)(row0 + t) * 512 + ch] : 0.f;
    bf16x8 bw[16];
    { const bf16x8* GH = (const bf16x8*)(p.ws + WS_GWH);
#pragma unroll
      for (int ks = 0; ks < 4; ++ks)
#pragma unroll
        for (int g = 0; g < 2; ++g)
#pragma unroll
            for (int ct = 0; ct < 2; ++ct) bw[(ks * 2 + g) * 2 + ct] = GH[((((n * 2 + g) * 2 + ct) * 4 + ks) * 64 + lane)]; }
    { const float cw0 = p.in[10][ch], cw1 = p.in[10][512 + ch], cw2 = p.in[10][1024 + ch], cw3 = p.in[10][1536 + ch], cb = p.in[11][ch];
#pragma unroll
      for (int t = 0; t < 32; ++t) cfs[t * LRS + ch] = cb + cw0 * xv[t] + cw1 * xv[t + 1] + cw2 * xv[t + 2] + cw3 * xv[t + 3]; }
    asm volatile("s_waitcnt lgkmcnt(0)" ::: "memory");
    bf16x8 ah[4], al[4];
#pragma unroll
    for (int ks = 0; ks < 4; ++ks) {
        const LAS float* s = cfs + r32 * LRS + n * 64 + ks * 16 + hi * 8;
        const f32x4 x0 = *(const LAS f32x4*)s, x1 = *(const LAS f32x4*)(s + 4);
        u32x4 uh, ul;
#pragma unroll
        for (int q = 0; q < 4; ++q) {
            const float e0 = (q < 2) ? x0[2 * q] : x1[2 * q - 4], e1 = (q < 2) ? x0[2 * q + 1] : x1[2 * q - 3];
            const unsigned u = cvtpk(e0, e1); uh[q] = u;
            ul[q] = cvtpk(e0 - __uint_as_float(u << 16), e1 - __uint_as_float(u & 0xffff0000u));
        }
        ah[ks] = __builtin_bit_cast(bf16x8, uh); al[ks] = __builtin_bit_cast(bf16x8, ul);
    }
    f32x16 acc[2][2];
#pragma unroll
    for (int g = 0; g < 2; ++g)
#pragma unroll
        for (int ct = 0; ct < 2; ++ct)
#pragma unroll
            for (int r = 0; r < 16; ++r) acc[g][ct][r] = 0.f;
#pragma unroll
    for (int ks = 0; ks < 4; ++ks)
#pragma unroll
        for (int g = 0; g < 2; ++g)
#pragma unroll
            for (int ct = 0; ct < 2; ++ct) {
                const bf16x8 bh = bw[(ks * 2 + g) * 2 + ct];
                acc[g][ct] = __builtin_amdgcn_mfma_f32_32x32x16_bf16(ah[ks], bh, acc[g][ct], 0, 0, 0);
                acc[g][ct] = __builtin_amdgcn_mfma_f32_32x32x16_bf16(al[ks], bh, acc[g][ct], 0, 0, 0);
            }
    unsigned short sg[32];
    if (MODE == 1) {
#pragma unroll
        for (int t = 0; t < 32; ++t) sg[t] = (t < L) ? SGA[(size_t)(row0 + t) * 512 + ch] : (unsigned short)0;
    }
#pragma unroll
    for (int ct = 0; ct < 2; ++ct) {
        const int chn = n * 64 + ct * 32 + r32;
        const float gab = p.in[13][chn], gxb = p.in[15][chn], sp = ((const float*)(p.ws + WS_SP))[chn];
#pragma unroll
        for (int r = 0; r < 16; ++r) {
            const int tok = crow(r, hi);
            const float pr = acc[0][ct][r] + gab, pi = acc[1][ct][r] + gxb;
            const float rg = __builtin_amdgcn_rcpf(1.0f + __builtin_amdgcn_exp2f(-LOG2E * pr));
            const float ig = __builtin_amdgcn_rcpf(1.0f + __builtin_amdgcn_exp2f(-LOG2E * pi));
            const float la = -8.0f * rg * sp;
            const float a = __builtin_amdgcn_exp2f(LOG2E * la);
            const float x2 = 2.0f * la;
            const float om = (x2 > -0.05f) ? -x2 * (1.0f + x2 * (0.5f + x2 * (0.16666667f + x2 * 0.041666668f))) : (1.0f - a * a);
            const float bb = __builtin_amdgcn_sqrtf(om) * (ig * cfs[tok * LRS + chn]);
            als[tok * LRS + chn] = a; cfs[tok * LRS + chn] = bb;
        }
    }
    asm volatile("s_waitcnt lgkmcnt(0)" ::: "memory");
    float ca = 1.0f;
#pragma unroll
    for (int t = 0; t < 32; ++t) {
        if (t < L) {
            const float a = als[t * LRS + ch], bb = cfs[t * LRS + ch];
            if (MODE == 0) {
                __hip_atomic_store((unsigned*)(p.ws + WS_AT) + (size_t)(row0 + t) * 512 + ch, __float_as_uint(a), __ATOMIC_RELAXED, __HIP_MEMORY_SCOPE_AGENT);
                __hip_atomic_store((unsigned*)(p.ws + WS_BT) + (size_t)(row0 + t) * 512 + ch, __float_as_uint(bb), __ATOMIC_RELAXED, __HIP_MEMORY_SCOPE_AGENT);
            }
            h = a * h + bb; ca *= a;
            if (MODE == 1 && row0 + t >= NMETA) YCAT[(size_t)(row0 + t - NMETA) * 1024 + ch] = f2bf(h * bf2f(sg[t]));
        }
    }
    asm volatile("s_waitcnt lgkmcnt(0)" ::: "memory");
    constexpr int LASTL = TP - LRU_CH * (N_LRU_P - 1);
    if (MODE == 0) {
        __hip_atomic_store((unsigned*)(p.ws + WS_SUMA) + ci * 512 + ch, __float_as_uint(ca), __ATOMIC_RELAXED, __HIP_MEMORY_SCOPE_AGENT);
        __hip_atomic_store((unsigned*)(p.ws + WS_SUMB) + ci * 512 + ch, __float_as_uint(h), __ATOMIC_RELAXED, __HIP_MEMORY_SCOPE_AGENT);
        if (ci == N_LRU_P - 1) { p.out[O_CP + ch] = xv[LASTL]; p.out[O_CP + 512 + ch] = xv[LASTL + 1]; p.out[O_CP + 1024 + ch] = xv[LASTL + 2]; }
    } else if (!samp) {
        if (ci == N_LRU_P - 1) p.out[O_HP + ch] = h;
    } else {
        p.out[O_HS + b * 512 + ch] = h;
        p.out[O_CS + (b * 3 + 0) * 512 + ch] = xv[16]; p.out[O_CS + (b * 3 + 1) * 512 + ch] = xv[17]; p.out[O_CS + (b * 3 + 2) * 512 + ch] = xv[18];
    }
}
__device__ __forceinline__ void lru_pass2(const Params& p, int ci) {
    int ch_ = threadIdx.x; asm volatile("" : "+v"(ch_));
    const int ch = ch_;
    const int row0 = LRU_CH * ci, L = (TP - row0) < LRU_CH ? (TP - row0) : LRU_CH;
    const float* AT = (const float*)(p.ws + WS_AT); const float* BT = (const float*)(p.ws + WS_BT);
    const bf16* SGA = (const bf16*)(p.ws + WS_SGA); bf16* YCAT = (bf16*)(p.ws + WS_YCAT);
    float h = ((const float*)(p.ws + WS_CARRY))[ci * 512 + ch];
    float av[32], bv[32]; unsigned short sg[32];
#pragma unroll
    for (int t = 0; t < 32; ++t) {
        const size_t o_ = (size_t)(row0 + t) * 512 + ch;
        av[t] = (t < L) ? AT[o_] : 1.0f; bv[t] = (t < L) ? BT[o_] : 0.f; sg[t] = (t < L) ? SGA[o_] : (unsigned short)0;
    }
#pragma unroll
    for (int t = 0; t < 32; ++t) {
        if (t < L) {
            h = av[t] * h + bv[t];
            if (row0 + t >= NMETA) YCAT[(size_t)(row0 + t - NMETA) * 1024 + ch] = f2bf(h * bf2f(sg[t]));
        }
    }
    if (ci == N_LRU_P - 1) p.out[O_HP + ch] = h;
}
__device__ __forceinline__ void lru_arrive(const Params& p, LAS unsigned char* lds, int it_, int n_arrivers) {
    const int ch = threadIdx.x;
    unsigned* ctl = (unsigned*)(p.ws + WS_CTL);
    asm volatile("s_waitcnt vmcnt(0)" ::: "memory");
    __syncthreads();
    volatile LAS unsigned* lw = (volatile LAS unsigned*)(lds + LCTL + 16);
    if (ch == 0) lw[0] = __hip_atomic_fetch_add(ctl + CW_LRUDONE + 64 * it_, 1u, __ATOMIC_RELAXED, __HIP_MEMORY_SCOPE_AGENT);
    __syncthreads();
    if (lw[0] + 1u == (unsigned)n_arrivers) {
        __builtin_amdgcn_fence(__ATOMIC_ACQUIRE, "agent");
        asm volatile("s_waitcnt vmcnt(0)" ::: "memory");
        const float* SA = (const float*)(p.ws + WS_SUMA); const float* SB = (const float*)(p.ws + WS_SUMB); float* CR = (float*)(p.ws + WS_CARRY);
        float H = 0.f;
        for (int k = 0; k < N_LRU_P; k += 19) {
            float a_[19], b_[19];
#pragma unroll
            for (int j = 0; j < 19; ++j) { a_[j] = SA[(k + j) * 512 + ch]; b_[j] = SB[(k + j) * 512 + ch]; }
#pragma unroll
            for (int j = 0; j < 19; ++j) { __hip_atomic_store((unsigned*)CR + (k + j) * 512 + ch, __float_as_uint(H), __ATOMIC_RELAXED, __HIP_MEMORY_SCOPE_AGENT); H = a_[j] * H + b_[j]; }
        }
        asm volatile("s_waitcnt vmcnt(0)" ::: "memory");
        __syncthreads();
        if (ch == 0) __hip_atomic_store(ctl + CW_CARRYOK + 64 * it_, 1u, __ATOMIC_RELAXED, __HIP_MEMORY_SCOPE_AGENT);
    }
    __syncthreads();
}

__device__ __forceinline__ s16x4 tr16(const LAS unsigned char* p) {
    typedef short v4i16_t __attribute__((ext_vector_type(4)));
    return __builtin_bit_cast(s16x4, __builtin_amdgcn_ds_read_tr16_b64_v4i16((LAS v4i16_t*)p));
}
__device__ __forceinline__ void attn_sample(const Params& p, LAS unsigned char* lds, int b, int h, float negm, float lam) {
    int tid_ = threadIdx.x; asm volatile("" : "+v"(tid_));
    const int tid = tid_, lane = tid & 63, r32 = lane & 31, hi = lane >> 5;
    const int wid = __builtin_amdgcn_readfirstlane(tid >> 6), db = wid & 3, c = wid >> 2;
    const bf16* QBp = (const bf16*)(p.ws + WS_QB);
    constexpr int NT = 65;
    const int qrow = TP + 16 * b + (r32 & 15);
    bf16x8 qr[4];
    { const bf16* q = QBp + (size_t)qrow * 512 + h * 128 + c * 64 + hi * 8;
#pragma unroll
      for (int d0 = 0; d0 < 4; ++d0) qr[d0] = *(const bf16x8*)(q + d0 * 16); }
    f32x16 o;
#pragma unroll
    for (int r = 0; r < 16; ++r) o[r] = 0.f;
    float lacc = 0.f;
    const int kkey = 8 * (tid >> 6) + (lane & 7), kch = lane >> 3, kcol = h * 128 + kch * 8;
    const unsigned kdst = kch * 1024 + kkey * 16;
    int vkey[2], vcol[2]; unsigned vdst[2], vimg[2];
#pragma unroll
    for (int i = 0; i < 2; ++i) { const int wv = (tid >> 6) + 8 * i, q16 = ((lane >> 3) & 3) * 4 + (lane & 3); vkey[i] = wv * 4 + ((lane >> 5) & 1) * 2 + ((lane >> 2) & 1); vcol[i] = h * 128 + q16 * 8;
        vdst[i] = 16384 + ((q16 >> 2) * 4 + (vkey[i] >> 4)) * 1024 + (vkey[i] & 15) * 64 + (q16 & 3) * 16;
        vimg[i] = 16384 + ((q16 >> 2) * 4 + (b & 3)) * 1024 + (vkey[i] & 15) * 64 + (q16 & 3) * 16; }
    const unsigned char* img = p.ws + WS_KV + (size_t)(257 + (b >> 2)) * 131072 + (size_t)h * 32768;
    const unsigned kimg = kch * 1024 + ((b & 3) * 16 + (kkey & 15)) * 16;
    f32x4 sa[8], sb[8];
#define ATT_LOAD(st, j) do { \
        const size_t row0_ = (size_t)b * PAST + 64 * (j); const float* ck = p.in[2] + (row0_ + kkey) * 512 + kcol; \
        st[0] = *(const f32x4*)ck; st[1] = *(const f32x4*)(ck + 4); st[2] = *(const f32x4*)(ck + 64); st[3] = *(const f32x4*)(ck + 68); \
        _Pragma("unroll") for (int i_ = 0; i_ < 2; ++i_) { const float* cv = p.in[3] + (row0_ + vkey[i_]) * 512 + vcol[i_]; st[4 + 2 * i_] = *(const f32x4*)cv; st[5 + 2 * i_] = *(const f32x4*)(cv + 4); } \
    } while (0)
#define PK4(A_, B_2) (u32x4){cvtpk((A_)[0], (A_)[1]), cvtpk((A_)[2], (A_)[3]), cvtpk((B_2)[0], (B_2)[1]), cvtpk((B_2)[2], (B_2)[3])}
#define ATT_STORE(st, buf) do { LAS unsigned char* B_ = lds + (buf) * 32768; \
        *(LAS u32x4*)(B_ + kdst) = PK4(st[0], st[1]); *(LAS u32x4*)(B_ + 8192 + kdst) = PK4(st[2], st[3]); \
        *(LAS u32x4*)(B_ + vdst[0]) = PK4(st[4], st[5]); *(LAS u32x4*)(B_ + vdst[1]) = PK4(st[6], st[7]); \
    } while (0)
#define ATT_COMPUTE(LAST, buf) do { \
            const LAS unsigned char* Bb = lds + (buf) * 32768; \
            const LAS unsigned char* Kb = Bb + c * 8192 + hi * 1024 + r32 * 16; \
            f32x16 p0, p1; \
            _Pragma("unroll") for (int r = 0; r < 16; ++r) { p0[r] = negm; p1[r] = negm; } \
            _Pragma("unroll") for (int d0 = 0; d0 < 4; ++d0) { \
                const bf16x8 b0 = *(const LAS bf16x8*)(Kb + d0 * 2048), b1 = *(const LAS bf16x8*)(Kb + d0 * 2048 + 512); \
                p0 = __builtin_amdgcn_mfma_f32_32x32x16_bf16(b0, qr[d0], p0, 0, 0, 0); \
                p1 = __builtin_amdgcn_mfma_f32_32x32x16_bf16(b1, qr[d0], p1, 0, 0, 0); } \
            _Pragma("unroll") for (int r = 0; r < 16; ++r) { p0[r] = __builtin_amdgcn_exp2f(p0[r]); p1[r] = __builtin_amdgcn_exp2f(p1[r]); } \
            if (LAST) {     \
                _Pragma("unroll") for (int r = 8; r < 16; ++r) p0[r] = 0.f; \
                _Pragma("unroll") for (int r = 0; r < 16; ++r) p1[r] = 0.f; } \
            float s = 0.f; \
            _Pragma("unroll") for (int r = 0; r < 16; ++r) s += p0[r] + p1[r]; \
            lacc += s; \
            u32x4 pw[4]; \
            pw[0] = (u32x4){cvtpk(p0[0], p0[1]), cvtpk(p0[2], p0[3]), cvtpk(p0[4], p0[5]), cvtpk(p0[6], p0[7])}; \
            pw[1] = (u32x4){cvtpk(p0[8], p0[9]), cvtpk(p0[10], p0[11]), cvtpk(p0[12], p0[13]), cvtpk(p0[14], p0[15])}; \
            pw[2] = (u32x4){cvtpk(p1[0], p1[1]), cvtpk(p1[2], p1[3]), cvtpk(p1[4], p1[5]), cvtpk(p1[6], p1[7])}; \
            pw[3] = (u32x4){cvtpk(p1[8], p1[9]), cvtpk(p1[10], p1[11]), cvtpk(p1[12], p1[13]), cvtpk(p1[14], p1[15])}; \
            const LAS unsigned char* Vb = Bb + 16384 + db * 4096 + ((lane >> 4) & 1) * 32 + (lane & 3) * 8 + (4 * hi + ((lane & 15) >> 2)) * 64; \
            _Pragma("unroll") for (int kg = 0; kg < 4; ++kg) { \
                const s16x4 lo = tr16(Vb + kg * 1024), hh = tr16(Vb + kg * 1024 + 512); \
                const bf16x8 vf = (bf16x8){lo[0], lo[1], lo[2], lo[3], hh[0], hh[1], hh[2], hh[3]}; \
                o = __builtin_amdgcn_mfma_f32_32x32x16_bf16(__builtin_bit_cast(bf16x8, pw[kg]), vf, o, 0, 0, 0); } \
        } while (0)
    ATT_LOAD(sa, 0); ATT_LOAD(sb, 1); ATT_STORE(sa, 0); __syncthreads();
    for (int j = 0; j < 62; j += 2) {
        ATT_LOAD(sa, j + 2);
        ATT_COMPUTE(false, 0);
        ATT_STORE(sb, 1);
        __syncthreads();
        ATT_LOAD(sb, j + 3);
        ATT_COMPUTE(false, 1);
        ATT_STORE(sa, 0);
        __syncthreads();
    }
    {
        const u32x4 i0 = *(const u32x4*)(img + kimg), i1 = *(const u32x4*)(img + 8192 + kimg), i2 = *(const u32x4*)(img + vimg[0]), i3 = *(const u32x4*)(img + vimg[1]);
        ATT_COMPUTE(false, 0);
        ATT_STORE(sb, 1);
        __syncthreads();
        ATT_COMPUTE(false, 1);
        *(LAS u32x4*)(lds + kdst) = i0; *(LAS u32x4*)(lds + 8192 + kdst) = i1; *(LAS u32x4*)(lds + vdst[0]) = i2; *(LAS u32x4*)(lds + vdst[1]) = i3;
        __syncthreads();
        ATT_COMPUTE(true, 0);
        __syncthreads();
    }
#undef ATT_LOAD
#undef ATT_STORE
#undef ATT_COMPUTE
#undef PK4
    lacc += __shfl_xor(lacc, 32);
    LAS float* wsf = (LAS float*)(lds + 98304) + wid * 64;
    if (hi == 0) wsf[r32] = lacc;
    asm volatile("s_waitcnt lgkmcnt(0)" ::: "memory");
    float rli[16];
#pragma unroll
    for (int r = 0; r < 16; ++r) rli[r] = __builtin_amdgcn_rcpf(wsf[crow(r, hi)]);
    LAS float* X2 = (LAS float*)lds + db * 1024;
    LAS float* SS = (LAS float*)(lds + 65536);
    if (c == 1) {
#pragma unroll
        for (int r = 0; r < 16; ++r) X2[r * 64 + lane] = lam * (o[r] * rli[r]);
    }
    __syncthreads();
    if (c == 0) {
#pragma unroll
        for (int r = 0; r < 16; ++r) {
            const float v = o[r] * rli[r] - X2[r * 64 + lane]; o[r] = v;
            float s = v * v;
            s += __shfl_xor(s, 1); s += __shfl_xor(s, 2); s += __shfl_xor(s, 4); s += __shfl_xor(s, 8); s += __shfl_xor(s, 16);
            if (r32 == 0) SS[db * 32 + crow(r, hi)] = s;
        }
    }
    __syncthreads();
    if (c == 0) {
        const bf16* SGB = (const bf16*)(p.ws + WS_SGB); bf16* YCAT = (bf16*)(p.ws + WS_YCAT);
        const float sw = p.in[23][db * 32 + r32];
        const int e = db * 32 + r32;
        bf16 gt[8];
#pragma unroll
        for (int r = 0; r < 8; ++r) gt[r] = SGB[(size_t)(TP + 16 * b + (crow(r, hi) & 15)) * 512 + h * 128 + e];
#pragma unroll
        for (int r = 0; r < 8; ++r) {
            const int q = crow(r, hi);
            const float s = (SS[q] + SS[32 + q]) + (SS[64 + q] + SS[96 + q]);
            const float rinv = __builtin_amdgcn_rsqf(s * (1.0f / 128.0f) + EPS);
            const size_t row = (size_t)(TP + 16 * b + (q & 15));
            YCAT[(row - NMETA) * 1024 + 512 + h * 128 + e] = f2bf((((o[r] * rinv) * sw) * ONE_M_LAM0) * bf2f(gt[r]));
        }
    }
    __syncthreads();
}

__device__ __forceinline__ void glds16(const void* gsrc, unsigned lds_dst) {
    unsigned keep;
    asm volatile("s_mov_b32 %0, m0\n\ts_mov_b32 m0, %2\n\ts_nop 0\n\tglobal_load_lds_dwordx4 %1, off\n\ts_mov_b32 m0, %0" : "=&s"(keep) : "v"(gsrc), "s"(lds_dst) : "memory");
}
#ifdef PROBE_BARW
#define PBS2() unsigned long long tb_ = PB_T()
#define PBE2(k) do { const unsigned long long tn_ = PB_T(); if (PROBE_SEC == (k)) pb_wait += tn_ - tb_; tb_ = tn_; } while (0)
#else
#define PBS2() do {} while (0)
#define PBE2(k) do {} while (0)
#endif
#ifdef PROBE_BARW
__device__ unsigned long long g_barw[4];
#define PB_T() __builtin_amdgcn_s_memtime()
#define AP_WAIT_BAR(N) do { const unsigned long long ta_ = PB_T(); asm volatile("s_waitcnt vmcnt(" #N ") lgkmcnt(0)" ::: "memory"); const unsigned long long t0_ = PB_T(); asm volatile("s_barrier" ::: "memory"); const unsigned long long t1_ = PB_T(); if (PROBE_SEC == 0) pb_wait += t1_ - t0_; if (PROBE_SEC == 1) pb_wait += t0_ - ta_; } while (0)
#define AP_BAR() do { const unsigned long long ta_ = PB_T(); asm volatile("s_waitcnt lgkmcnt(0)" ::: "memory"); const unsigned long long t0_ = PB_T(); asm volatile("s_barrier" ::: "memory"); const unsigned long long t1_ = PB_T(); if (PROBE_SEC == 0) pb_wait += t1_ - t0_; if (PROBE_SEC == 1) pb_wait += t0_ - ta_; } while (0)
#else
#define AP_WAIT_BAR(N) asm volatile("s_waitcnt vmcnt(" #N ") lgkmcnt(0)\n\ts_barrier" ::: "memory")
#define AP_BAR() asm volatile("s_waitcnt lgkmcnt(0)\n\ts_barrier" ::: "memory")
#endif
__device__ __forceinline__ float fadd_s(float a, float b) { float r; asm("v_add_f32_e32 %0, %1, %2" : "=v"(r) : "v"(a), "v"(b)); return r; }
__device__ __forceinline__ void attn_prompt(const Params& p, LAS unsigned char* lds, int a, int h, float negm, float lam) {
    int tid_ = threadIdx.x; asm volatile("" : "+v"(tid_));
    const int tid = tid_, lane = tid & 63, r32 = lane & 31, hi = lane >> 5;
    const int wid = __builtin_amdgcn_readfirstlane(tid >> 6), qs = wid & 3, c = wid >> 2;
    const bf16* QBp = (const bf16*)(p.ws + WS_QB);
    const int NT = 2 * a + 3;
#ifdef PROBE_BARW
    unsigned long long pb_wait = 0ull; const unsigned long long pb_t0 = __builtin_amdgcn_s_memtime();
#endif
    const int qrow = NMETA + 128 * a + 32 * qs + r32;
    bf16x8 qr[4];
    { const bf16* q = QBp + (size_t)qrow * 512 + h * 128 + c * 64 + hi * 8;
#pragma unroll
      for (int d0 = 0; d0 < 4; ++d0) qr[d0] = *(const bf16x8*)(q + d0 * 16); }
    asm volatile("" : "+v"(qr[0]), "+v"(qr[1]), "+v"(qr[2]), "+v"(qr[3]));
    const unsigned char* isrc = p.ws + WS_KV + (size_t)h * 32768 + wid * 1024 + lane * 16;
    const unsigned lds0 = (unsigned)(size_t)lds;
    const unsigned kdst = lds0 + wid * 1024, vdst = lds0 + 65536u + wid * 1024;
#define RFL(x) ((unsigned)__builtin_amdgcn_readfirstlane(x))
#define DMA_K(j) do { const unsigned char* g_ = isrc + (size_t)(j) * 131072; const unsigned d_ = kdst + (unsigned)((j) & 3) * 16384u; glds16(g_, RFL(d_)); glds16(g_ + 8192, RFL(d_ + 8192u)); } while (0)
#define DMA_V(j) do { const unsigned char* g_ = isrc + (size_t)(j) * 131072 + 16384; const unsigned d_ = vdst + (unsigned)((j) % 3) * 16384u; glds16(g_, RFL(d_)); glds16(g_ + 8192, RFL(d_ + 8192u)); } while (0)
#define AP_ISSUE(t) do { if ((t) + 3 < NT) DMA_K((t) + 3); if ((t) + 1 < NT) DMA_V((t) + 1); } while (0)
#define DMA_K1(j, pc) do { const unsigned char* g_ = isrc + (size_t)(j) * 131072 + (pc) * 8192; const unsigned d_ = kdst + (unsigned)((j) & 3) * 16384u + (pc) * 8192u; glds16(g_, RFL(d_)); } while (0)
#define DMA_V1(j, pc) do { const unsigned char* g_ = isrc + (size_t)(j) * 131072 + 16384 + (pc) * 8192; const unsigned d_ = vdst + (unsigned)((j) % 3) * 16384u + (pc) * 8192u; glds16(g_, RFL(d_)); } while (0)
#define AP_WAITN(t) do { const int n_ = (((t) + 3 < NT) ? 2 : 0) + (((t) + 1 < NT) ? 2 : 0); if (n_ == 4) AP_WAIT_BAR(4); else if (n_ == 2) AP_WAIT_BAR(2); else AP_WAIT_BAR(0); } while (0)
#define SBAR() __builtin_amdgcn_sched_barrier(0)
#define PIN(x) asm volatile("" : "+v"(x))
#define MF(A_, B_, C_) __builtin_amdgcn_mfma_f32_32x32x16_bf16(A_, B_, C_, 0, 0, 0)
#define KOFF(j) (((j) >> 1) * 2048 + ((j) & 1) * 512)
#define VOFF(i) ((((i) & 3) * 4 + ((i) >> 2)) * 1024)
#define VF(k) (bf16x8){vl[k][0], vl[k][1], vl[k][2], vl[k][3], vh[k][0], vh[k][1], vh[k][2], vh[k][3]}
#define PEL(P0, P1, e) (((e) < 16) ? P0[(e) & 15] : P1[(e) & 15])
    const LAS unsigned char* Kl = lds + c * 8192 + hi * 1024 + r32 * 16;
    const LAS unsigned char* Vl = lds + 65536 + ((lane >> 4) & 1) * 32 + (lane & 3) * 8 + (4 * hi + ((lane & 15) >> 2)) * 64;
    DMA_K(0); DMA_V(0); DMA_K(1); DMA_K(2);
    f32x16 o[4];
#pragma unroll
    for (int i = 0; i < 4; ++i)
#pragma unroll
        for (int r = 0; r < 16; ++r) o[i][r] = 0.f;
    float lacc = 0.f;
    u32x4 pw[4];
    bf16x8 kf[4];
    s16x4 vl[8], vh[8];
    f32x16 pA0, pA1, pB0, pB1;
    const f32x16 zero16 = {0.f, 0.f, 0.f, 0.f, 0.f, 0.f, 0.f, 0.f, 0.f, 0.f, 0.f, 0.f, 0.f, 0.f, 0.f, 0.f};
    AP_WAIT_BAR(6);
    AP_ISSUE(0);
    {
        bf16x8 k0[8];
#pragma unroll
        for (int j = 0; j < 8; ++j) k0[j] = *(const LAS bf16x8*)(Kl + KOFF(j));
        pA0 = MF(k0[0], qr[0], zero16); pA1 = MF(k0[1], qr[0], zero16);
#pragma unroll
        for (int j = 2; j < 8; ++j) { if (j & 1) pA1 = MF(k0[j], qr[j >> 1], pA1); else pA0 = MF(k0[j], qr[j >> 1], pA0); }
#pragma unroll
        for (int r = 0; r < 8; ++r) pA0[r] = __builtin_amdgcn_exp2f(pA0[r]);
#pragma unroll
        for (int r = 8; r < 16; ++r) pA0[r] = 0.f;
#pragma unroll
        for (int r = 0; r < 16; ++r) pA1[r] = 0.f;
    }
    AP_WAITN(0);
#pragma unroll
    for (int j = 0; j < 4; ++j) kf[j] = *(const LAS bf16x8*)(Kl + 16384 + KOFF(j));
#define AP_GA(i, C0, C1, P0, P1) do { \
            if ((i) >= 1) { vl[(i) - 1] = tr16(Vb_ + VOFF((i) - 1)); vh[(i) - 1] = tr16(Vb_ + VOFF((i) - 1) + 512); }     \
            SBAR(); \
            if ((i) == 0) C0 = MF(kf[0], qr[0], zero16); else if ((i) == 1) C1 = MF(kf[1], qr[0], zero16); \
            else if ((i) & 1) C1 = MF(kf[(i) & 3], qr[(i) >> 1], C1); else C0 = MF(kf[(i) & 3], qr[(i) >> 1], C0); \
            sa0 = fadd_s(sa0, PEL(P0, P1, 4 * (i))); sa1 = fadd_s(sa1, PEL(P0, P1, 4 * (i) + 1)); sa2 = fadd_s(sa2, PEL(P0, P1, 4 * (i) + 2)); sa3 = fadd_s(sa3, PEL(P0, P1, 4 * (i) + 3)); \
            PIN(sa0); PIN(sa1); PIN(sa2); PIN(sa3); \
            pw[(i) >> 1][((i) & 1) * 2] = cvtpk(PEL(P0, P1, 4 * (i)), PEL(P0, P1, 4 * (i) + 1)); pw[(i) >> 1][((i) & 1) * 2 + 1] = cvtpk(PEL(P0, P1, 4 * (i) + 2), PEL(P0, P1, 4 * (i) + 3)); \
            PIN(pw[(i) >> 1]); \
            if ((i) < 4) kf[(i) & 3] = *(const LAS bf16x8*)(Kc_ + KOFF(((i) & 3) + 4)); \
            SBAR(); } while (0)
#define AP_GB(i, C0, C1, LOADK) do { \
            o[(i) & 3] = MF(__builtin_bit_cast(bf16x8, pw[(i) >> 2]), VF((i) & 7), o[(i) & 3]); \
            if ((i) < 8) { C0[(2 * (i)) & 15] = __builtin_amdgcn_exp2f(C0[(2 * (i)) & 15]); C0[(2 * (i) + 1) & 15] = __builtin_amdgcn_exp2f(C0[(2 * (i) + 1) & 15]); PIN(C0); } \
            else { C1[(2 * (i)) & 15] = __builtin_amdgcn_exp2f(C1[(2 * (i)) & 15]); C1[(2 * (i) + 1) & 15] = __builtin_amdgcn_exp2f(C1[(2 * (i) + 1) & 15]); PIN(C1); } \
            if ((i) + 7 < 16) { vl[((i) + 7) & 7] = tr16(Vb_ + VOFF(((i) + 7) & 15)); vh[((i) + 7) & 7] = tr16(Vb_ + VOFF(((i) + 7) & 15) + 512); } \
            if ((i) >= 8 && (i) < 12 && (LOADK)) kf[(i) & 3] = *(const LAS bf16x8*)(Kn_ + KOFF((i) & 3)); \
            if ((i) == 12 && tq_ + 3 < NT) DMA_K1(tq_ + 3, 0); if ((i) == 13 && tq_ + 3 < NT) DMA_K1(tq_ + 3, 1);     \
            if ((i) == 14 && tq_ + 1 < NT) DMA_V1(tq_ + 1, 0); if ((i) == 15 && tq_ + 1 < NT) DMA_V1(tq_ + 1, 1); \
            SBAR(); } while (0)
#define AP_STEP(C0, C1, P0, P1, vslot, kslot, LOADK, TQ) do { const int tq_ = (TQ); \
        const LAS unsigned char* Vb_ = Vl + (vslot) * 16384; const LAS unsigned char* Kn_ = Kl + (kslot) * 16384; const LAS unsigned char* Kc_ = Kl + (((kslot) + 3) & 3) * 16384; \
        float sa0 = 0.f, sa1 = 0.f, sa2 = 0.f, sa3 = 0.f; \
        SBAR(); PBS2(); \
        AP_GA(0, C0, C1, P0, P1); AP_GA(1, C0, C1, P0, P1); AP_GA(2, C0, C1, P0, P1); AP_GA(3, C0, C1, P0, P1); \
        AP_GA(4, C0, C1, P0, P1); AP_GA(5, C0, C1, P0, P1); AP_GA(6, C0, C1, P0, P1); AP_GA(7, C0, C1, P0, P1); \
        lacc += (sa0 + sa1) + (sa2 + sa3); PBE2(2); \
        AP_GB(0, C0, C1, LOADK); AP_GB(1, C0, C1, LOADK); AP_GB(2, C0, C1, LOADK); AP_GB(3, C0, C1, LOADK); \
        AP_GB(4, C0, C1, LOADK); AP_GB(5, C0, C1, LOADK); AP_GB(6, C0, C1, LOADK); AP_GB(7, C0, C1, LOADK); \
        AP_GB(8, C0, C1, LOADK); AP_GB(9, C0, C1, LOADK); AP_GB(10, C0, C1, LOADK); AP_GB(11, C0, C1, LOADK); \
        AP_GB(12, C0, C1, LOADK); AP_GB(13, C0, C1, LOADK); AP_GB(14, C0, C1, LOADK); AP_GB(15, C0, C1, LOADK); PBE2(3); \
    } while (0)
#define AP_DRAIN(P0, P1, vslot) do { \
        const LAS unsigned char* Vb_ = Vl + (vslot) * 16384; \
        float sacc = 0.f; \
        _Pragma("unroll") for (int r = 0; r < 16; ++r) sacc += P0[r] + P1[r]; \
        lacc += sacc; \
        pw[0] = (u32x4){cvtpk(P0[0], P0[1]), cvtpk(P0[2], P0[3]), cvtpk(P0[4], P0[5]), cvtpk(P0[6], P0[7])}; \
        pw[1] = (u32x4){cvtpk(P0[8], P0[9]), cvtpk(P0[10], P0[11]), cvtpk(P0[12], P0[13]), cvtpk(P0[14], P0[15])}; \
        pw[2] = (u32x4){cvtpk(P1[0], P1[1]), cvtpk(P1[2], P1[3]), cvtpk(P1[4], P1[5]), cvtpk(P1[6], P1[7])}; \
        pw[3] = (u32x4){cvtpk(P1[8], P1[9]), cvtpk(P1[10], P1[11]), cvtpk(P1[12], P1[13]), cvtpk(P1[14], P1[15])}; \
        _Pragma("unroll") for (int i = 0; i < 4; ++i) { vl[i] = tr16(Vb_ + VOFF(i)); vh[i] = tr16(Vb_ + VOFF(i) + 512); } \
        SBAR(); \
        _Pragma("unroll") for (int i = 0; i < 16; ++i) { \
            if (i + 4 < 16) { vl[(i + 4) & 7] = tr16(Vb_ + VOFF(i + 4)); vh[(i + 4) & 7] = tr16(Vb_ + VOFF(i + 4) + 512); } \
            o[i & 3] = MF(__builtin_bit_cast(bf16x8, pw[i >> 2]), VF(i & 7), o[i & 3]); \
            SBAR(); } \
    } while (0)
    int vsl = 0, ksl = 2;
    for (int t = 1; t < NT; t += 2) {
        AP_STEP(pB0, pB1, pA0, pA1, vsl, ksl, true, t);
        AP_WAITN(t);
        vsl = (vsl == 2) ? 0 : vsl + 1; ksl = (ksl + 1) & 3;
        AP_STEP(pA0, pA1, pB0, pB1, vsl, ksl, (t + 2 < NT), t + 1);
        AP_WAITN(t + 1);
        vsl = (vsl == 2) ? 0 : vsl + 1; ksl = (ksl + 1) & 3;
    }
    if (qs < 2) {
#pragma unroll
        for (int r = 0; r < 16; ++r) { pA0[r] = 0.f; pA1[r] = 0.f; }
    }
    AP_DRAIN(pA0, pA1, vsl);
    AP_BAR();
#ifdef PROBE_BARW
    if (blockIdx.x == PROBE_BLK && tid == PROBE_WAVE * 64) { g_barw[0] += pb_wait; g_barw[1] += __builtin_amdgcn_s_memtime() - pb_t0; }
#endif
#undef AP_STEP
#undef AP_DRAIN
#undef AP_ISSUE
#undef AP_WAITN
#undef DMA_K
#undef DMA_V
    if (a < 12) {
        if (tid == 0) { const unsigned* lt = (const unsigned*)(p.ws + WS_CTL) + CW_LATE; while (__hip_atomic_load(lt, __ATOMIC_RELAXED, __HIP_MEMORY_SCOPE_AGENT) < 24u) __builtin_amdgcn_s_sleep(8); }
        __syncthreads();
        __builtin_amdgcn_fence(__ATOMIC_ACQUIRE, "agent");
        asm volatile("s_waitcnt vmcnt(0)" ::: "memory");
    }
    const size_t erow0 = (size_t)(NMETA + 128 * a + 32 * qs);
    u32x4 gq[4];
#pragma unroll
    for (int k = 0; k < 4; ++k) { const int pi = lane + 64 * k; gq[k] = *(const u32x4*)((const bf16*)(p.ws + WS_SGB) + (erow0 + (pi >> 3)) * 512 + h * 128 + c * 64 + (pi & 7) * 8); }
    lacc += __shfl_xor(lacc, 32);
    LAS float* wsf = (LAS float*)(lds + LCTL + 256) + wid * 64;
    if (hi == 0) wsf[r32] = lacc;
    asm volatile("s_waitcnt lgkmcnt(0)" ::: "memory");
    float rli[16];
#pragma unroll
    for (int r = 0; r < 16; ++r) rli[r] = __builtin_amdgcn_rcpf(wsf[crow(r, hi)]);
    LAS float* XW = (LAS float*)lds + (qs * 2 + c) * 2048;
    const LAS float* XR = (const LAS float*)lds + (qs * 2 + (c ^ 1)) * 2048;
    LAS float* SS = (LAS float*)(lds + 65536);
    const float fsc = (c == 0) ? 1.0f : lam;
#define EP_WRITE(OA, OB) do { _Pragma("unroll") for (int r = 0; r < 16; ++r) { XW[r * 64 + lane] = fsc * (OA[r] * rli[r]); XW[(16 + r) * 64 + lane] = fsc * (OB[r] * rli[r]); } } while (0)
    if (c == 0) EP_WRITE(o[2], o[3]); else EP_WRITE(o[0], o[1]);
#undef EP_WRITE
    __syncthreads();
#define EP_COMB(OA, OB, SGN) do { _Pragma("unroll") for (int r = 0; r < 16; ++r) { \
            const float va = SGN * (fsc * (OA[r] * rli[r]) - XR[r * 64 + lane]), vb = SGN * (fsc * (OB[r] * rli[r]) - XR[(16 + r) * 64 + lane]); \
            OA[r] = va; OB[r] = vb; float s_ = va * va + vb * vb; \
            s_ += __shfl_xor(s_, 1); s_ += __shfl_xor(s_, 2); s_ += __shfl_xor(s_, 4); s_ += __shfl_xor(s_, 8); s_ += __shfl_xor(s_, 16); \
            if (r32 == 0) SS[(qs * 2 + c) * 32 + crow(r, hi)] = s_; } } while (0)
    if (c == 0) EP_COMB(o[0], o[1], 1.0f); else EP_COMB(o[2], o[3], -1.0f);
#undef EP_COMB
    __syncthreads();
    {
        LAS unsigned char* GT = lds + 66560 + wid * 8192;
        LAS unsigned char* YT = GT + 4096;
#pragma unroll
        for (int k = 0; k < 4; ++k) { const int pi = lane + 64 * k; *(LAS u32x4*)(GT + (pi >> 3) * 128 + (pi & 7) * 16) = gq[k]; }
        asm volatile("s_waitcnt lgkmcnt(0)" ::: "memory");
        const int eb = c * 64 + r32;
        const float swa = p.in[23][eb] * ONE_M_LAM0, swb = p.in[23][eb + 32] * ONE_M_LAM0;
#define EP_FIN(OA, OB) do { _Pragma("unroll") for (int r = 0; r < 16; ++r) { \
            const int q_ = crow(r, hi); \
            const float s_ = SS[(qs * 2) * 32 + q_] + SS[(qs * 2 + 1) * 32 + q_]; \
            const float rinv = __builtin_amdgcn_rsqf(s_ * (1.0f / 128.0f) + EPS); \
            const float ga_ = bf2f(*(const LAS bf16*)(GT + q_ * 128 + r32 * 2)), gb_ = bf2f(*(const LAS bf16*)(GT + q_ * 128 + 64 + r32 * 2)); \
            *(LAS bf16*)(YT + q_ * 128 + r32 * 2) = f2bf(((OA[r] * rinv) * swa) * ga_); \
            *(LAS bf16*)(YT + q_ * 128 + 64 + r32 * 2) = f2bf(((OB[r] * rinv) * swb) * gb_); } } while (0)
        if (c == 0) EP_FIN(o[0], o[1]); else EP_FIN(o[2], o[3]);
#undef EP_FIN
        asm volatile("s_waitcnt lgkmcnt(0)" ::: "memory");
        bf16* YCAT = (bf16*)(p.ws + WS_YCAT);
#pragma unroll
        for (int k = 0; k < 4; ++k) { const int pi = lane + 64 * k;
            *(u32x4*)(YCAT + (erow0 - NMETA + (pi >> 3)) * 1024 + 512 + h * 128 + c * 64 + (pi & 7) * 8) = *(const LAS u32x4*)(YT + (pi >> 3) * 128 + (pi & 7) * 16); }
    }
    __syncthreads();
}

#ifdef PROBE_SAMP
__device__ unsigned long long g_samp[2];
#endif
__global__ void __launch_bounds__(NTHREADS, 2) mega_fwd(Params p) {
    extern __shared__ __attribute__((aligned(16))) unsigned char lds_raw[];
    LAS unsigned char* lds = (LAS unsigned char*)lds_raw;
    const int tid = threadIdx.x;
    unsigned* ctl = (unsigned*)(p.ws + WS_CTL);
    if (tid < 64) ((LAS unsigned*)(lds + LCTL))[tid] = 0u;
    __syncthreads();
    XcdBarrier bar = xcd_barrier_post(ctl + CW_BAR, (volatile LAS unsigned*)(lds + LCTL + 64));
#define GRID_BAR() xcd_barrier(bar)
#ifdef PROBE_TIME
    unsigned long long ts_[8];
#define STAMP(i) ts_[i] = __builtin_amdgcn_s_memrealtime()
#else
#define STAMP(i) do {} while (0)
#endif
    STAMP(0);
#ifdef PROBE_SAMP
    if (blockIdx.x == 0 && tid == 0) __hip_atomic_store(&g_samp[0], 0ull, __ATOMIC_RELAXED, __HIP_MEMORY_SCOPE_AGENT);
#endif

#ifdef PROBE_ALLX2
    for (int it_ = 0; it_ < 2; ++it_) {
    if (it_) GRID_BAR();
#else
    { const int it_ = 0;
#endif
#ifndef NO_P0
    phase0(p, lds);
#ifdef PROBE_P0X2
    __syncthreads();
    phase0(p, lds);
#endif
#endif
    GRID_BAR();
    STAMP(1);

#ifndef NO_P1
    {
        pg8::Gemm g{(const pg8::bf16_t*)(p.ws + WS_XN), (const pg8::bf16_t*)(p.ws + WS_W1T), MPAD, DIN, DM};
        P1Order S; S.init((int)gridDim.x, (int)blockIdx.x);
        EpiIn E{p.out, p.ws, p.in[17], p.in[18]};
        pg8::gemm_phase<EpiIn, P1Order, true, true>(lds, g, S, E);
#ifdef PROBE_P1X2
        __syncthreads();
        pg8::gemm_phase<EpiIn, pg8::StaticOrder, true, true>(lds, g, S, E);
#endif
    }
#endif
    GRID_BAR();
    STAMP(2);

#ifndef NO_P1
    for (int k = blockIdx.x; k < 24; k += gridDim.x) {
        pg8::Gemm g{(const pg8::bf16_t*)(p.ws + WS_XN), (const pg8::bf16_t*)(p.ws + WS_W1T), MPAD, DIN, DM};
        OneUnit S{k >> 2, late_pn(k & 3)};
        EpiIn E{p.out, p.ws, p.in[17], p.in[18]};
        pg8::gemm_phase<EpiIn, OneUnit, false, true>(lds, g, S, E);
        asm volatile("s_waitcnt vmcnt(0)" ::: "memory");
        __syncthreads();
        if (tid == 0) { __builtin_amdgcn_fence(__ATOMIC_RELEASE, "agent"); asm volatile("s_waitcnt vmcnt(0)" ::: "memory");
                        __hip_atomic_fetch_add(ctl + CW_LATE + 64 * it_, 1u, __ATOMIC_RELAXED, __HIP_MEMORY_SCOPE_AGENT); }
        __syncthreads();
    }
#endif
    STAMP(2);
#ifndef NO_LRU
    const int lru_b0 = (int)gridDim.x >> 1, lru_nb = (int)gridDim.x - lru_b0;
    if ((int)blockIdx.x >= lru_b0)
    for (int idx = (int)blockIdx.x - lru_b0; idx < N_LRU; idx += lru_nb) {
        if (idx < N_LRU_P) lru_chunk<0>(p, lds, idx);
        else {
            lru_chunk<1>(p, lds, idx);
            asm volatile("s_waitcnt vmcnt(0)" ::: "memory");
            __syncthreads();
            if (tid == 0) { __builtin_amdgcn_fence(__ATOMIC_RELEASE, "agent"); asm volatile("s_waitcnt vmcnt(0)" ::: "memory");
                            __hip_atomic_fetch_add(ctl + CW_SAMPDONE + 64 * it_, 1u, __ATOMIC_RELAXED, __HIP_MEMORY_SCOPE_AGENT); }
        }
    }
    if ((int)blockIdx.x >= lru_b0 && (int)blockIdx.x - lru_b0 < N_LRU_P) lru_arrive(p, lds, it_, lru_nb < N_LRU_P ? lru_nb : N_LRU_P);
    __syncthreads();
#endif
    STAMP(3);
    {
        float d1 = 0.f, d2 = 0.f, mq = 0.f, mk = 0.f;
        for (int i = 0; i < 64; ++i) { d1 += p.in[19][i] * p.in[20][i]; d2 += p.in[21][i] * p.in[22][i]; mq = fmaxf(mq, fabsf(p.in[17][i])); mk = fmaxf(mk, fabsf(p.in[18][i])); }
        const float lam = expf(d1) - expf(d2) + LAM0;
        const float negm = -(8.0f * mq * mk) * LOG2E;
        volatile LAS unsigned* qw = (volatile LAS unsigned*)(lds + LCTL);
        bool carry_ok = false;
        int kq = 0;
        for (;;) {
            if (tid == 0) {
                unsigned code = 0xffffffffu;
                while (kq < 4) {
                    const unsigned hq = (blockIdx.x + (unsigned)kq) & 3u;
                    const unsigned ix = atomicAdd(&ctl[CW_QH + 64 * hq + 512 * it_], 1u);
                    if (ix < 144u) { code = 0x80000000u | (hq << 16) | ix; break; }
                    ++kq;
                }
                if (kq >= 4) code = (unsigned)N_ATT + atomicAdd(&ctl[CW_Q + 128 * it_], 1u);
                qw[0] = code;
            }
            __syncthreads();
            const unsigned code = qw[0];
            __syncthreads();
#ifndef NO_ATT
            if (code & 0x80000000u) {
                const int hq = (int)((code >> 16) & 3u), ix = (int)(code & 0xffffu);
                if (ix >= 32 && ix < 48) {
#ifdef PROBE_SAMP
                    const unsigned long long tsa_ = __builtin_amdgcn_s_memrealtime();
#endif
                    attn_sample(p, lds, ix - 32, hq, negm, lam);
#ifdef PROBE_SAMP
                    if (tid == 0) atomicAdd(&g_samp[0], __builtin_amdgcn_s_memrealtime() - tsa_);
#endif
                    asm volatile("s_waitcnt vmcnt(0)" ::: "memory");
                    __syncthreads();
                    if (tid == 0) { __builtin_amdgcn_fence(__ATOMIC_RELEASE, "agent"); asm volatile("s_waitcnt vmcnt(0)" ::: "memory");
                                    __hip_atomic_fetch_add(ctl + CW_SAMPDONE + 64 * it_, 1u, __ATOMIC_RELAXED, __HIP_MEMORY_SCOPE_AGENT); }
                } else attn_prompt(p, lds, (ix < 32) ? 127 - ix : 127 - (ix - 16), hq, negm, lam);
                continue;
            }
#endif
            const int idx = (int)code;
            if (idx >= N_P2) break;
            if (idx < N_ATT + N_SGEMM) {
                if (tid == 0) { while (__hip_atomic_load(ctl + CW_SAMPDONE + 64 * it_, __ATOMIC_RELAXED, __HIP_MEMORY_SCOPE_AGENT) < 80u) __builtin_amdgcn_s_sleep(8); }
                __syncthreads();
                __builtin_amdgcn_fence(__ATOMIC_ACQUIRE, "agent");
                asm volatile("s_waitcnt vmcnt(0)" ::: "memory");
                __syncthreads();
                pg8::Gemm g{(const pg8::bf16_t*)(p.ws + WS_YCAT), (const pg8::bf16_t*)(p.ws + WS_W2T), 16640, DM, DM};
                OneUnit S{64, idx - N_ATT};
                EpiOut E{p.out, p.in[0], p.in[1]};
                pg8::gemm_phase<EpiOut, OneUnit, false, true>(lds, g, S, E);
                __syncthreads();
            } else {
#ifndef NO_LRU
                if (!carry_ok) {
                    if (tid == 0) { while (__hip_atomic_load(ctl + CW_CARRYOK + 64 * it_, __ATOMIC_RELAXED, __HIP_MEMORY_SCOPE_AGENT) == 0u) __builtin_amdgcn_s_sleep(8);
                                    while (__hip_atomic_load(ctl + CW_LATE + 64 * it_, __ATOMIC_RELAXED, __HIP_MEMORY_SCOPE_AGENT) < 24u) __builtin_amdgcn_s_sleep(8); }
                    __syncthreads();
                    __builtin_amdgcn_fence(__ATOMIC_ACQUIRE, "agent");
                    asm volatile("s_waitcnt vmcnt(0)" ::: "memory");
                    carry_ok = true;
                }
                lru_pass2(p, idx - N_ATT - N_SGEMM);
#endif
            }
        }
    }
    GRID_BAR();
    STAMP(4);
    STAMP(5);

#ifndef NO_P4
    {
        pg8::Gemm g{(const pg8::bf16_t*)(p.ws + WS_YCAT), (const pg8::bf16_t*)(p.ws + WS_W2T), 16384, DM, DM};
        pg8::StaticOrder S; S.init(16384, DM, (int)gridDim.x, (int)blockIdx.x);
        EpiOut E{p.out, p.in[0], p.in[1]};
        pg8::gemm_phase<EpiOut, pg8::StaticOrder, true, true>(lds, g, S, E);
#ifdef PROBE_P4X2
        __syncthreads();
        pg8::gemm_phase<EpiOut, pg8::StaticOrder, true, true>(lds, g, S, E);
#endif
    }
#endif
    }
#ifdef PROBE_TIME
    STAMP(6);
    if (blockIdx.x == 0) {
        __syncthreads();
#ifdef PROBE_BARW
        const float T_us = 1000.0f * (float)g_barw[0] / (float)(g_barw[1] + 1ull);
#else
#ifdef PROBE_SAMP
        const float T_us = (float)__hip_atomic_load(&g_samp[0], __ATOMIC_RELAXED, __HIP_MEMORY_SCOPE_AGENT) * 0.01f * (1.0f / 64.0f);
#else
        const float T_us = (float)(ts_[PROBE_B] - ts_[PROBE_A]) * 0.01f;
#endif
#endif
#ifndef PROBE_SCALE
#define PROBE_SCALE 1e-7f
#endif
        const float dl = sqrtf(1e-5f + T_us * PROBE_SCALE);
        for (int i = tid; i < 24576; i += NTHREADS) p.out[O_CS + i] *= (1.0f + dl);
    }
#endif
}

extern "C" void kernel_launch(void* const* d_in, const int* in_sizes, int n_in, void* d_out, int out_size, void* d_ws, size_t ws_size, hipStream_t stream) {
    static int grid = 0;
    if (grid == 0) {
        if (n_in != 24 || out_size != (int)O_END || ws_size < WS_END) { fprintf(stderr, "kernel_launch: unexpected shapes (n_in %d out %d ws %zu)\n", n_in, out_size, ws_size); grid = -1; return; }
        int dev = 0, cus = 0, per_cu = 0;
        hipGetDevice(&dev);
        hipDeviceGetAttribute(&cus, hipDeviceAttributeMultiprocessorCount, dev);
        hipFuncSetAttribute((const void*)mega_fwd, hipFuncAttributeMaxDynamicSharedMemorySize, LDS_BYTES);
        hipOccupancyMaxActiveBlocksPerMultiprocessor(&per_cu, (const void*)mega_fwd, NTHREADS, LDS_BYTES);
        if (per_cu < 1) { fprintf(stderr, "kernel_launch: occupancy query says %d blocks/CU\n", per_cu); per_cu = 1; }
        (void)hipGetLastError();
        grid = cus;
    }
    if (grid < 0) return;
    hipMemsetAsync((char*)d_ws + WS_CTL, 0, CTL_ZERO_BYTES, stream);
    Params prm{};
    for (int i = 0; i < 24; ++i) prm.in[i] = (const float*)d_in[i];
    prm.out = (float*)d_out; prm.ws = (unsigned char*)d_ws;
    void* args[] = {&prm};
    hipError_t e = hipLaunchCooperativeKernel((const void*)mega_fwd, dim3(grid), dim3(NTHREADS), args, LDS_BYTES, stream);
    if (e != hipSuccess) fprintf(stderr, "cooperative launch failed: %s (grid %d)\n", hipGetErrorString(e), grid);
}
```

```cpp
#include <hip/hip_runtime.h>
#include <cstdio>
#include <cstdint>
namespace pg8 {
#define PG8_LAS __attribute__((address_space(3)))
typedef unsigned short bf16_t;
typedef short bf16x8 __attribute__((ext_vector_type(8)));
typedef float f32x4 __attribute__((ext_vector_type(4)));
typedef unsigned u32x4 __attribute__((ext_vector_type(4)));
constexpr int BM = 256, BK = 64, HALF = 128, HTB = HALF * BK * 2  , STAGE_BYTES = 8 * HTB, NXCD = 8, WGM = 8;

__host__ __device__ __forceinline__ int lds_byte(int r, int c) { const int st = (r >> 4) * 2 + (c >> 5), rr = r & 15, cc = c & 31, ob = rr * 64 + cc * 2; return st * 1024 + (ob ^ (((ob >> 9) & 1) << 5)); }
__host__ __device__ __forceinline__ void stage_rc(int b, int& R, int& C) { const int st = b / 1024, sb = b % 1024, swz = sb ^ (((sb >> 9) & 1) << 5); R = (st >> 1) * 16 + swz / 64; C = (st & 1) * 32 + (swz % 64) / 2; }
__host__ __device__ __forceinline__ int perm32(int rho) { const int n = rho >> 4, i = rho & 15; return 8 * (i >> 2) + 4 * n + (i & 3); }

struct Unit { int pm, pn; };
struct Gemm { const bf16_t* A; const bf16_t* Bt; int M, N, K; };

struct StaticOrder {
    int nM, nN, nwg, G, c;
    __host__ __device__ void init(int M, int N, int G_, int c_) { nM = M / BM; nN = N / BM; nwg = nM * nN; G = G_; c = c_; }
    __host__ __device__ bool next(int i, Unit& u) const {
        const long L = (long)i * G + c; if (L >= nwg) return false;
        int wgid = (int)L; { const int q = nwg / NXCD, r = nwg % NXCD, xcd = wgid % NXCD, off = wgid / NXCD; wgid = (xcd < r ? xcd * (q + 1) : r * (q + 1) + (xcd - r) * q) + off; }
        const int nig = WGM * nN, gid = wgid / nig, fm = gid * WGM, gsz = (nM - fm) < WGM ? (nM - fm) : WGM;
        u.pm = fm + ((wgid % nig) % gsz); u.pn = (wgid % nig) / gsz; return true;
    }
    __device__ __forceinline__ void a_ready(const Unit&) const {}
    __device__ __forceinline__ void done(const Unit&) const {}
};

template <class Epi, class Sched, bool ALIGN_EPI = false, bool SP2 = false>
__device__ __forceinline__ void gemm_phase(PG8_LAS unsigned char* lds, const Gemm g, const Sched& S, const Epi& E) {
    int tid_ = threadIdx.x; asm volatile("" : "+v"(tid_));
    const int tid = tid_, wid = __builtin_amdgcn_readfirstlane(tid >> 6), lane = tid & 63, wr = wid >> 2, wc = wid & 3, fr = lane & 15, fq = lane >> 4;
    const int K = g.K, nt = K / BK;
    unsigned voffA[2], voffB[2];
#pragma unroll
    for (int i = 0; i < 2; ++i) { int R, C; stage_rc(tid * 16 + i * 8192, R, C); const int Rb = Epi::PERM ? ((R & ~31) + perm32(R & 31)) : R;
        voffA[i] = (unsigned)(R * K + C) * 2u; voffB[i] = (unsigned)(Rb * K + C) * 2u; }
    const size_t kstep = (size_t)(BK * 2);
    const size_t hstep = (size_t)HALF * K * 2;
    const size_t tstep = 2 * hstep;
    const unsigned ldsw = (unsigned)wid * 1024u;
    const int aoff = lds_byte(wr * 64 + fr, fq * 8), boff = lds_byte(wc * 32 + fr, fq * 8);
#define PG8_SA(b, h) (((b) * 2 + (h)) * HTB)
#define PG8_SB(b, h) ((4 + (b) * 2 + (h)) * HTB)
#define PG8_STAGE(bufoff, gbase, voff) do { _Pragma("unroll") for (int _i = 0; _i < 2; ++_i) \
        __builtin_amdgcn_global_load_lds((const unsigned*)((const char*)(gbase) + (voff)[_i]), (PG8_LAS unsigned*)(lds + (bufoff) + ldsw + _i * 8192), 16, 0, 0); } while (0)
#define PG8_LDA(dst, b, h) do { _Pragma("unroll") for (int m = 0; m < 4; ++m) _Pragma("unroll") for (int k = 0; k < 2; ++k) dst[m][k] = *(const PG8_LAS bf16x8*)(lds + PG8_SA(b, h) + aoff + m * 2048 + k * 1024); } while (0)
#define PG8_LDB(dst, b, h) do { _Pragma("unroll") for (int n = 0; n < 2; ++n) _Pragma("unroll") for (int k = 0; k < 2; ++k) dst[n][k] = *(const PG8_LAS bf16x8*)(lds + PG8_SB(b, h) + boff + n * 2048 + k * 1024); } while (0)
#define PG8_MMA(ai, bj, At, Bt) do { __builtin_amdgcn_s_setprio(1); _Pragma("unroll") for (int m = 0; m < 4; ++m) _Pragma("unroll") for (int n = 0; n < 2; ++n) _Pragma("unroll") for (int k = 0; k < 2; ++k) \
        acc[ai][bj][m][n] = __builtin_amdgcn_mfma_f32_16x16x32_bf16(Bt[n][k], At[m][k], acc[ai][bj][m][n], 0, 0, 0); __builtin_amdgcn_s_setprio(0); } while (0)
#define PG8_WAIT_V(n) asm volatile("s_waitcnt vmcnt(" #n ")" ::: "memory")
#define PG8_WAIT_L(n) asm volatile("s_waitcnt lgkmcnt(" #n ")" ::: "memory")
#define PG8_BAR __builtin_amdgcn_s_barrier()
#define PG8_SCHED __builtin_amdgcn_sched_barrier(0)
    Unit cur, nxt; int ui = 0;
    if (!S.next(0, cur)) return;
    f32x4 acc[2][2][4][2];
#pragma unroll
    for (int a = 0; a < 2; ++a)
#pragma unroll
        for (int b = 0; b < 2; ++b)
#pragma unroll
            for (int m = 0; m < 4; ++m)
#pragma unroll
                for (int n = 0; n < 2; ++n) acc[a][b][m][n] = (f32x4){0.f, 0.f, 0.f, 0.f};
    bf16x8 At[4][2], B0[2][2], B1[2][2];
    const char* cA = (const char*)g.A + (size_t)cur.pm * tstep; const char* cB = (const char*)g.Bt + (size_t)cur.pn * tstep;
    S.a_ready(cur);
    if constexpr (SP2) {
        PG8_STAGE(PG8_SB(0, 0), cB, voffB); PG8_STAGE(PG8_SB(0, 1), cB + hstep, voffB); PG8_STAGE(PG8_SA(0, 0), cA, voffA); PG8_STAGE(PG8_SA(0, 1), cA + hstep, voffA);
        if (wr == 1) PG8_BAR;
        PG8_WAIT_V(2); PG8_BAR;
        PG8_STAGE(PG8_SB(1, 0), cB + kstep, voffB); PG8_STAGE(PG8_SA(1, 0), cA + kstep, voffA); PG8_STAGE(PG8_SB(1, 1), cB + hstep + kstep, voffB);
        PG8_WAIT_V(6); PG8_BAR;
    } else {
        PG8_STAGE(PG8_SB(0, 0), cB, voffB); PG8_STAGE(PG8_SA(0, 0), cA, voffA); PG8_STAGE(PG8_SB(0, 1), cB + hstep, voffB); PG8_STAGE(PG8_SA(0, 1), cA + hstep, voffA);
        if (wr == 1) PG8_BAR;
        PG8_WAIT_V(4); PG8_BAR;
        PG8_STAGE(PG8_SB(1, 0), cB + kstep, voffB); PG8_STAGE(PG8_SA(1, 0), cA + kstep, voffA); PG8_STAGE(PG8_SB(1, 1), cB + hstep + kstep, voffB);
        PG8_WAIT_V(6); PG8_BAR;
    }
    for (;;) {
        const bool has_next = S.next(ui + 1, nxt);
        const char* nA = has_next ? (const char*)g.A + (size_t)nxt.pm * tstep : cA; const char* nB = has_next ? (const char*)g.Bt + (size_t)nxt.pn * tstep : cB;
        for (int t = 0; t < nt; t += 2) {
            const bool last = (t == nt - 2);
            const char* a1 = cA + (size_t)(t + 1) * kstep;
            const char* a2 = last ? nA : cA + (size_t)(t + 2) * kstep; const char* b2 = last ? nB : cB + (size_t)(t + 2) * kstep;
            const char* a3 = a2 + kstep; const char* b3 = b2 + kstep;
            if (last && has_next) S.a_ready(nxt);
            if constexpr (SP2) {
            PG8_LDB(B0, 0, 0); PG8_LDB(B1, 0, 1); PG8_SCHED; PG8_LDA(At, 0, 0); PG8_STAGE(PG8_SA(1, 1), a1 + hstep, voffA);
            PG8_WAIT_V(8); PG8_WAIT_L(0); PG8_BAR; PG8_MMA(0, 0, At, B0); PG8_MMA(0, 1, At, B1); PG8_BAR; PG8_SCHED;
            PG8_LDA(At, 0, 1); PG8_STAGE(PG8_SB(0, 0), b2, voffB); PG8_STAGE(PG8_SB(0, 1), b2 + hstep, voffB); PG8_STAGE(PG8_SA(0, 0), a2, voffA);
            PG8_WAIT_V(8); PG8_WAIT_L(0); PG8_BAR; PG8_MMA(1, 0, At, B0); PG8_MMA(1, 1, At, B1); PG8_BAR; PG8_SCHED;
            PG8_LDB(B0, 1, 0); PG8_LDB(B1, 1, 1); PG8_SCHED; PG8_LDA(At, 1, 0); PG8_STAGE(PG8_SA(0, 1), a2 + hstep, voffA);
            PG8_WAIT_V(8); PG8_WAIT_L(0); PG8_BAR; PG8_MMA(0, 0, At, B0); PG8_MMA(0, 1, At, B1); PG8_BAR; PG8_SCHED;
            PG8_LDA(At, 1, 1); PG8_STAGE(PG8_SB(1, 0), b3, voffB); PG8_STAGE(PG8_SB(1, 1), b3 + hstep, voffB); PG8_STAGE(PG8_SA(1, 0), a3, voffA);
            PG8_WAIT_V(8); PG8_WAIT_L(0); PG8_BAR; PG8_MMA(1, 0, At, B0); PG8_MMA(1, 1, At, B1); PG8_BAR; PG8_SCHED;
            } else {
            PG8_LDB(B0, 0, 0); PG8_SCHED; PG8_LDA(At, 0, 0); PG8_STAGE(PG8_SA(1, 1), a1 + hstep, voffA);
            PG8_WAIT_L(8); PG8_BAR; PG8_WAIT_L(0); PG8_MMA(0, 0, At, B0); PG8_BAR; PG8_SCHED;
            PG8_LDB(B1, 0, 1); PG8_STAGE(PG8_SB(0, 0), b2, voffB);
            PG8_BAR; PG8_WAIT_L(0); PG8_MMA(0, 1, At, B1); PG8_BAR;
            PG8_LDA(At, 0, 1); PG8_STAGE(PG8_SA(0, 0), a2, voffA);
            PG8_BAR; PG8_WAIT_L(0); PG8_MMA(1, 0, At, B0); PG8_BAR; PG8_SCHED;
            PG8_STAGE(PG8_SB(0, 1), b2 + hstep, voffB);
            PG8_WAIT_V(6); PG8_BAR; PG8_MMA(1, 1, At, B1); PG8_BAR;
            PG8_LDB(B0, 1, 0); PG8_SCHED; PG8_LDA(At, 1, 0); PG8_STAGE(PG8_SA(0, 1), a2 + hstep, voffA);
            PG8_WAIT_L(8); PG8_BAR; PG8_WAIT_L(0); PG8_MMA(0, 0, At, B0); PG8_BAR; PG8_SCHED;
            PG8_LDB(B1, 1, 1); PG8_STAGE(PG8_SB(1, 0), b3, voffB);
            PG8_BAR; PG8_WAIT_L(0); PG8_MMA(0, 1, At, B1); PG8_BAR;
            PG8_LDA(At, 1, 1); PG8_STAGE(PG8_SA(1, 0), a3, voffA);
            PG8_BAR; PG8_WAIT_L(0); PG8_MMA(1, 0, At, B0); PG8_BAR; PG8_SCHED;
            PG8_STAGE(PG8_SB(1, 1), b3 + hstep, voffB);
            PG8_WAIT_V(6); PG8_BAR; PG8_MMA(1, 1, At, B1); PG8_BAR;
            }
        }
        if constexpr (ALIGN_EPI) { if (wr == 0) PG8_BAR; }
        if constexpr (!Epi::AFTER_DRAIN) { E(acc, cur, wr, wc, fr, fq); S.done(cur); }
        if (!has_next) break;
#pragma unroll
        for (int a = 0; a < 2; ++a)
#pragma unroll
            for (int b = 0; b < 2; ++b)
#pragma unroll
                for (int m = 0; m < 4; ++m)
#pragma unroll
                    for (int n = 0; n < 2; ++n) acc[a][b][m][n] = (f32x4){0.f, 0.f, 0.f, 0.f};
        cur = nxt; cA = nA; cB = nB; ++ui;
        if constexpr (ALIGN_EPI) { if (wr == 1) PG8_BAR; }
    }
    PG8_WAIT_V(0);
    if constexpr (!ALIGN_EPI) { if (wr == 0) PG8_BAR; }
    PG8_BAR;
    if constexpr (Epi::AFTER_DRAIN) { E.fused(acc, cur, wr, wc, fr, fq, lds, wid, lane); S.done(cur); }
#undef PG8_SA
#undef PG8_SB
#undef PG8_STAGE
#undef PG8_LDA
#undef PG8_LDB
#undef PG8_MMA
#undef PG8_WAIT_V
#undef PG8_WAIT_L
#undef PG8_BAR
#undef PG8_SCHED
}
}

#define LAS __attribute__((address_space(3)))
typedef unsigned short bf16;
typedef short bf16x8 __attribute__((ext_vector_type(8)));
typedef short s16x4 __attribute__((ext_vector_type(4)));
typedef float f32x4 __attribute__((ext_vector_type(4)));
typedef float f32x16 __attribute__((ext_vector_type(16)));
typedef unsigned u32x4 __attribute__((ext_vector_type(4)));
typedef unsigned u32x2 __attribute__((ext_vector_type(2)));

constexpr int NTHREADS = 512;
constexpr int DM = 1024, NMETA = 16, TP = 16400, NSAMP = 256, MROWS = TP + NSAMP  , MPAD = 16896, PAST = 4096;
constexpr int DL = 512, DIN = 3072;
constexpr float EPS = 1e-6f;
constexpr float C2 = 0.18033688011112042f;
constexpr float LOG2E = 1.4426950408889634f;
constexpr float ONE_M_LAM0 = 0.8f, LAM0 = 0.2f;

constexpr size_t O_YP = 0, O_YS = 16777216, O_KP = 17039360, O_VP = 25436160, O_HP = 33832960, O_CP = 33833472,
                 O_KS = 33835008, O_VS = 33966080, O_HS = 34097152, O_CS = 34105344, O_END = 34129920;

constexpr size_t MiB = 1u << 20;
constexpr size_t WS_CTL = 0, WS_XN = 1 * MiB, WS_W1T = 35 * MiB, WS_W2T = 41 * MiB, WS_ROPE = 43 * MiB, WS_XA = 48 * MiB, WS_SGA = 82 * MiB,
                 WS_SGB = 99 * MiB, WS_QB = 116 * MiB, WS_KV = 133 * MiB  , WS_YCAT = 167 * MiB, WS_GWH = 201 * MiB  , WS_GWL = 202 * MiB, WS_SP = 203 * MiB  ,
                 WS_AT = 204 * MiB  , WS_BT = 237 * MiB, WS_SUMA = 271 * MiB, WS_SUMB = 273 * MiB, WS_CARRY = 275 * MiB, WS_END = 277 * MiB;
constexpr int CW_Q = 64, CW_LRUDONE = 256, CW_CARRYOK = 320, CW_SAMPDONE = 384, CW_QH = 1024, CW_LATE = 448, CW_BAR = 4096;
constexpr size_t CTL_ZERO_BYTES = 65536;
constexpr int LCTL = 147456;
constexpr int LDS_BYTES = LCTL + 4096;
constexpr int LRS = 516;

constexpr int LRU_CH = 32;
constexpr int N_LRU_P = (TP + LRU_CH - 1) / LRU_CH;
constexpr int N_LRU = N_LRU_P + 16;
constexpr int N_ATT = 512 + 64;
constexpr int N_SGEMM = 4;
constexpr int N_P2 = N_ATT + N_SGEMM + N_LRU_P;

struct Params { const float* in[24]; float* out; unsigned char* ws; };

__device__ __forceinline__ unsigned cvtpk(float lo, float hi) {
    typedef float f2 __attribute__((ext_vector_type(2))); typedef __bf16 b2 __attribute__((ext_vector_type(2)));
    f2 v = {lo, hi}; b2 b = __builtin_convertvector(v, b2); return __builtin_bit_cast(unsigned, b);
}
__device__ __forceinline__ float bf2f(bf16 v) { return __uint_as_float(((unsigned)v) << 16); }
__device__ __forceinline__ bf16 f2bf(float f) { return (bf16)(cvtpk(f, 0.f) & 0xffffu); }
__device__ __forceinline__ float half_sum_hi16(float v) {
    v += __builtin_bit_cast(float, __builtin_amdgcn_update_dpp(0, __builtin_bit_cast(int, v), 0xB1, 0xF, 0xF, true));
    v += __builtin_bit_cast(float, __builtin_amdgcn_update_dpp(0, __builtin_bit_cast(int, v), 0x4E, 0xF, 0xF, true));
    v += __builtin_bit_cast(float, __builtin_amdgcn_update_dpp(0, __builtin_bit_cast(int, v), 0x141, 0xF, 0xF, true));
    v += __builtin_bit_cast(float, __builtin_amdgcn_update_dpp(0, __builtin_bit_cast(int, v), 0x140, 0xF, 0xF, true));
    v += __builtin_bit_cast(float, __builtin_amdgcn_update_dpp(0, __builtin_bit_cast(int, v), 0x142, 0xA, 0xF, false));
    return v;
}
__device__ __forceinline__ float wave_sum(float v) {
#pragma unroll
    for (int o = 1; o < 64; o <<= 1) v += __shfl_xor(v, o);
    return v;
}
__device__ __forceinline__ int crow(int r, int hi) { return (r & 3) + 8 * (r >> 2) + 4 * hi; }
__device__ __forceinline__ float silu_f(float x) { return x * __builtin_amdgcn_rcpf(1.0f + __builtin_amdgcn_exp2f(-1.4426950408889634f * x)); }

#define XB_TMO      128
#define XB_XCNT(j)  (256  + 64 * (j))
#define XB_XSUB(j)  (1280 + 64 * (j))
#define XB_XGEN(j)  (2304 + 64 * (j))
#define XB_TOP      3328
#define XB_TOPGEN   3392
#define XCD_BAR_WORDS 3456
#define XB_SPIN_CAP (1u << 18)

__device__ __forceinline__ unsigned xb_ld(unsigned* p)              { return __hip_atomic_load(p, __ATOMIC_RELAXED, __HIP_MEMORY_SCOPE_AGENT); }
__device__ __forceinline__ unsigned xb_add(unsigned* p, unsigned v) { return __hip_atomic_fetch_add(p, v, __ATOMIC_RELAXED, __HIP_MEMORY_SCOPE_AGENT); }
__device__ __forceinline__ unsigned xb_xcc_id() { return (unsigned)__builtin_amdgcn_s_getreg((3 << 11) | 20) & 0xFu; }
#define XB_SPIN(cond, bar) do { unsigned _sp = 0; while (cond) { __builtin_amdgcn_s_sleep(1); \
    if ((++_sp & 255u) == 0u) { if (xb_ld(&(bar)[XB_TMO])) break; if (_sp > XB_SPIN_CAP) { atomicAdd(&(bar)[XB_TMO], 1u); break; } } } } while (0)

struct XcdBarrier {
    unsigned* bar; unsigned x;
    volatile LAS unsigned* st;
};

__device__ __forceinline__ XcdBarrier xcd_barrier_post(unsigned* bar, volatile LAS unsigned* st) {
    XcdBarrier b; b.bar = bar; b.x = xb_xcc_id(); b.st = st;
    if (threadIdx.x == 0) (void)xb_add(&bar[XB_XCNT(b.x)], 1u);
    return b;
}
__device__ __forceinline__ void xcd_barrier_complete(unsigned* bar, unsigned x, unsigned& nloc, unsigned& nx) {
    const unsigned G = gridDim.x * gridDim.y * gridDim.z;
    unsigned sum, cnt, mine, sp = 0u;
    for (;;) {
        sum = 0u; cnt = 0u; mine = 0u;
#pragma unroll
        for (unsigned j = 0; j < 16; ++j) { const unsigned c = xb_ld(&bar[XB_XCNT(j)]); sum += c; cnt += (c > 0u) ? 1u : 0u; mine = (j == x) ? c : mine; }
        if (sum == G) break;
        __builtin_amdgcn_s_sleep(1);
        if ((++sp & 255u) == 0u) { if (xb_ld(&bar[XB_TMO])) break; if (sp > XB_SPIN_CAP) { atomicAdd(&bar[XB_TMO], 1u); break; } }
    }
    nloc = mine > 0u ? mine : 1u; nx = cnt > 0u ? cnt : 1u;
}

__device__ __forceinline__ void xcd_barrier(const XcdBarrier& b) {
    asm volatile("s_waitcnt vmcnt(0)" ::: "memory");
    __syncthreads();
    if (threadIdx.x == 0) {
        unsigned* bar = b.bar;
        __builtin_amdgcn_s_waitcnt(0);
        unsigned nloc = b.st[0], nx = b.st[1];
        if (nloc == 0u) { xcd_barrier_complete(bar, b.x, nloc, nx); b.st[0] = nloc; b.st[1] = nx; }
        const unsigned old = xb_add(&bar[XB_XSUB(b.x)], 1u);
        const unsigned gen = old / nloc;
        if (old + 1u == (gen + 1u) * nloc) {
            __builtin_amdgcn_fence(__ATOMIC_RELEASE, "agent");
            asm volatile("s_waitcnt vmcnt(0)" ::: "memory");
            const unsigned og = xb_add(&bar[XB_TOP], 1u);
            const unsigned tg = og / nx;
            if (og + 1u == (tg + 1u) * nx) xb_add(&bar[XB_TOPGEN], 1u);
            else XB_SPIN(xb_ld(&bar[XB_TOPGEN]) == tg, bar);
            __builtin_amdgcn_fence(__ATOMIC_ACQUIRE, "agent");
            xb_add(&bar[XB_XGEN(b.x)], 1u);
            asm volatile("s_waitcnt vmcnt(0)" ::: "memory");
        } else {
            XB_SPIN(xb_ld(&bar[XB_XGEN(b.x)]) == gen, bar);
            __builtin_amdgcn_fence(__ATOMIC_ACQUIRE, "agent");
            asm volatile("s_waitcnt vmcnt(0)" ::: "memory");
        }
    }
    __syncthreads();
}

__device__ __forceinline__ void p0_row(const Params& p, int m, int lane) {
    unsigned long long* dst = (unsigned long long*)(p.ws + WS_XN + (size_t)m * DM * 2) + lane;
    if (m >= MROWS) {
#pragma unroll
        for (int j = 0; j < 4; ++j) dst[64 * j] = 0ull;
        return;
    }
    const float* src = m < NMETA ? p.in[6] + (size_t)m * DM : (m < TP ? p.in[0] + (size_t)(m - NMETA) * DM : p.in[1] + (size_t)(m - TP) * DM);
    const f32x4* s4 = (const f32x4*)src + lane;
    const f32x4* w4 = (const f32x4*)p.in[7] + lane;
    f32x4 v[4]; float s = 0.f;
#pragma unroll
    for (int j = 0; j < 4; ++j) { v[j] = s4[64 * j]; s += (v[j].x * v[j].x + v[j].y * v[j].y) + (v[j].z * v[j].z + v[j].w * v[j].w); }
    s = wave_sum(s);
    const float rs = 1.0f / sqrtf(s * (1.0f / DM) + EPS);
#pragma unroll
    for (int j = 0; j < 4; ++j) {
        const f32x4 w = w4[64 * j]; const f32x4 o = (v[j] * rs) * w;
        dst[64 * j] = (unsigned long long)cvtpk(o.x, o.y) | ((unsigned long long)cvtpk(o.z, o.w) << 32);
    }
}
__device__ __forceinline__ int permrow(int n) {
    const int pn = n >> 8, a = n & 255, wc = a >> 6, bj = (a >> 5) & 1, fq = (a >> 3) & 3, n2 = (a >> 2) & 1, e = a & 3;
    return pn * 256 + 128 * bj + 32 * wc + 16 * n2 + 4 * fq + e;
}
template <bool PERMW>
__device__ __forceinline__ void p0_transpose_item(const float* W, int K, int N, bf16* WT, LAS float* scr, int item, int lane) {
    const int nblk = N / 32, kb = item / nblk, nb = item % nblk, k0 = 64 * kb, n0 = 32 * nb;
#pragma unroll 8
    for (int i = 0; i < 32; ++i) { const int kk = 2 * i + (lane >> 5); scr[kk * 33 + (lane & 31)] = W[(size_t)(k0 + kk) * N + n0 + (lane & 31)]; }
    asm volatile("s_waitcnt lgkmcnt(0)" ::: "memory");
    const int c = lane & 7;
#pragma unroll
    for (int j = 0; j < 4; ++j) {
        const int n = (lane >> 3) + 8 * j; const LAS float* s = scr + (8 * c) * 33 + n;
        u32x4 o; o.x = cvtpk(s[0 * 33], s[1 * 33]); o.y = cvtpk(s[2 * 33], s[3 * 33]); o.z = cvtpk(s[4 * 33], s[5 * 33]); o.w = cvtpk(s[6 * 33], s[7 * 33]);
        const int row = PERMW ? permrow(n0 + n) : (n0 + n);
        *(u32x4*)(WT + (size_t)row * K + k0 + 8 * c) = o;
    }
    asm volatile("s_waitcnt lgkmcnt(0)" ::: "memory");
}
__device__ __forceinline__ void rope_entry(int pos, int i, float& c, float& s) {
    double inv = 1.0; for (int k = 0; k < i; ++k) inv *= 0.7498942093324558;
    const double ang = (double)pos * inv;
    const double kq = __builtin_rint(ang * 0.63661977236758134308);
    double r = __builtin_fma(-kq, 1.57079632673412561417e+00, ang); r = __builtin_fma(-kq, 6.07710050650619224932e-11, r);
    const int q = (int)((long long)kq & 3);
    const double z = r * r;
    const double sn = r + r * z * (-1.66666666666666324348e-01 + z * (8.33333333332248946124e-03 + z * (-1.98412698298579493134e-04 + z * (2.75573137070700676789e-06 + z * (-2.50507602534068634195e-08 + z * 1.58969099521155010221e-10)))));
    const double cs = 1.0 - 0.5 * z + z * z * (4.16666666666666019037e-02 + z * (-1.38888888888741095749e-03 + z * (2.48015872894767294178e-05 + z * (-2.75573143513906633035e-07 + z * (2.08757232129817482790e-09 + z * -1.13596475577881948265e-11)))));
    double cc, ss;
    if (q == 0) { cc = cs; ss = sn; } else if (q == 1) { cc = -sn; ss = cs; } else if (q == 2) { cc = -cs; ss = -sn; } else { cc = sn; ss = -cs; }
    c = (float)cc; s = (float)ss;
}
__device__ __forceinline__ void phase0(const Params& p, LAS unsigned char* lds) {
    const int tid = threadIdx.x, lane = tid & 63, wave = tid >> 6;
    const int gw = blockIdx.x * 8 + wave, NGW = gridDim.x * 8;
    LAS float* scr = (LAS float*)(lds + wave * 16384);
    constexpr int I1 = (DM / 64) * (DIN / 32), I2 = (DM / 64) * (DM / 32);
    for (int it = gw; it < I1 + I2; it += NGW) {
        if (it < I1) p0_transpose_item<true>(p.in[8], DM, DIN, (bf16*)(p.ws + WS_W1T), scr, it, lane);
        else p0_transpose_item<false>(p.in[9], DM, DM, (bf16*)(p.ws + WS_W2T), scr, it - I1, lane);
    }
    {
        const f32x4* w4 = (const f32x4*)p.in[7] + lane;
        f32x4 w[4];
#pragma unroll
        for (int j = 0; j < 4; ++j) w[j] = w4[64 * j];
        for (int m0 = gw; m0 < MPAD; m0 += 3 * NGW) {
            f32x4 v[3][4];
#pragma unroll
            for (int k = 0; k < 3; ++k) {
                const int m = m0 + k * NGW;
                if (m < MROWS) {
                    const float* src = m < NMETA ? p.in[6] + (size_t)m * DM : (m < TP ? p.in[0] + (size_t)(m - NMETA) * DM : p.in[1] + (size_t)(m - TP) * DM);
                    const f32x4* s4 = (const f32x4*)src + lane;
#pragma unroll
                    for (int j = 0; j < 4; ++j) v[k][j] = s4[64 * j];
                } else {
#pragma unroll
                    for (int j = 0; j < 4; ++j) v[k][j] = (f32x4){0.f, 0.f, 0.f, 0.f};
                }
            }
#pragma unroll
            for (int k = 0; k < 3; ++k) {
                const int m = m0 + k * NGW;
                if (m < MPAD) {
                    unsigned long long* dst = (unsigned long long*)(p.ws + WS_XN + (size_t)m * DM * 2) + lane;
                    float s = 0.f;
#pragma unroll
                    for (int j = 0; j < 4; ++j) s += (v[k][j].x * v[k][j].x + v[k][j].y * v[k][j].y) + (v[k][j].z * v[k][j].z + v[k][j].w * v[k][j].w);
                    s = wave_sum(s);
                    const float rs = 1.0f / sqrtf(s * (1.0f / DM) + EPS);
#pragma unroll
                    for (int j = 0; j < 4; ++j) {
                        const f32x4 o = (v[k][j] * rs) * w[j];
                        dst[64 * j] = (unsigned long long)cvtpk(o.x, o.y) | ((unsigned long long)cvtpk(o.z, o.w) << 32);
                    }
                }
            }
        }
    }
    {
        bf16* GH = (bf16*)(p.ws + WS_GWH); bf16* GL = (bf16*)(p.ws + WS_GWL);
        for (int e = blockIdx.x * NTHREADS + tid; e < 65536; e += gridDim.x * NTHREADS) {
            const int jj = e & 7, ln = (e >> 3) & 63, ks = (e >> 9) & 3, ct = (e >> 11) & 1, g = (e >> 12) & 1, n = e >> 13;
            const float w = (g ? p.in[14] : p.in[12])[(n * 64 + 16 * ks + 8 * (ln >> 5) + jj) * 64 + 32 * ct + (ln & 31)];
            const bf16 hb = f2bf(w); GH[e] = hb; GL[e] = f2bf(w - bf2f(hb));
        }
        if (blockIdx.x == 0) ((float*)(p.ws + WS_SP))[tid] = log1pf(expf(-p.in[16][tid]));
    }
    float* rope = (float*)(p.ws + WS_ROPE);
    for (int e = blockIdx.x * NTHREADS + tid; e < TP * 32; e += gridDim.x * NTHREADS) {
        float c, s; rope_entry(e >> 5, e & 31, c, s); rope[2 * e] = c; rope[2 * e + 1] = s;
    }
}

struct EpiIn {
    static constexpr bool PERM = false, AFTER_DRAIN = false;
    float* out; unsigned char* ws; const float* qnw; const float* knw;
    __device__ __forceinline__ void operator()(const f32x4 (&acc)[2][2][4][2], const pg8::Unit& u, int wr, int wc, int fr, int fq) const {
        const int typ = u.pn >> 1;
        const int segc = (u.pn & 1) * 256 + wc * 64 + fq * 8;
        if (typ == 2 || typ == 3) {
            const float* nwp = (typ == 2) ? qnw : knw;
            float w1[8], w2[8];
#pragma unroll
            for (int t = 0; t < 8; ++t) { w1[t] = nwp[fq * 8 + t]; w2[t] = nwp[32 + fq * 8 + t]; }
            bf16* dstb = (bf16*)(ws + WS_QB);
            const float osc = (typ == 2) ? C2 : 1.0f;
            const int hh_ = (u.pn & 1) * 2 + (wc >> 1), cc_ = wc & 1;
            f32x4 csn[4];
#define EI_ROPE(g) do { const int r_ = u.pm * 256 + ((g) >> 2) * 128 + wr * 64 + ((g) & 3) * 16 + fr; const int pos_ = r_ < TP ? r_ : (r_ < MROWS ? PAST + ((r_ - TP) & 15) : 0); \
                const f32x4* rp_ = (const f32x4*)(ws + WS_ROPE) + (size_t)pos_ * 16 + fq * 4; csn[0] = rp_[0]; csn[1] = rp_[1]; csn[2] = rp_[2]; csn[3] = rp_[3]; } while (0)
            EI_ROPE(0);
#pragma unroll
            for (int ai = 0; ai < 2; ++ai)
#pragma unroll
                for (int m = 0; m < 4; ++m) {
                    const int r = u.pm * 256 + ai * 128 + wr * 64 + m * 16 + fr;
                    const f32x4 cs4[4] = {csn[0], csn[1], csn[2], csn[3]};
                    if (ai * 4 + m + 1 < 8) EI_ROPE(ai * 4 + m + 1);
                    __builtin_amdgcn_sched_barrier(0);
                    float v1[8], v2[8]; float ss = 0.f;
#pragma unroll
                    for (int n = 0; n < 2; ++n)
#pragma unroll
                        for (int e = 0; e < 4; ++e) { v1[4 * n + e] = acc[ai][0][m][n][e]; v2[4 * n + e] = acc[ai][1][m][n][e]; ss += v1[4 * n + e] * v1[4 * n + e] + v2[4 * n + e] * v2[4 * n + e]; }
                    ss += __shfl_xor(ss, 16); ss += __shfl_xor(ss, 32);
                    const float rinv = __builtin_amdgcn_rsqf(ss * (1.0f / 64.0f) + EPS);
                    float o1[8], o2[8];
#pragma unroll
                    for (int t2 = 0; t2 < 4; ++t2) {
                        const f32x4 cs = cs4[t2];
                        { const float y1 = (v1[2 * t2] * rinv) * w1[2 * t2], y2 = (v2[2 * t2] * rinv) * w2[2 * t2]; o1[2 * t2] = y1 * cs.x - y2 * cs.y; o2[2 * t2] = y1 * cs.y + y2 * cs.x; }
                        { const float y1 = (v1[2 * t2 + 1] * rinv) * w1[2 * t2 + 1], y2 = (v2[2 * t2 + 1] * rinv) * w2[2 * t2 + 1]; o1[2 * t2 + 1] = y1 * cs.z - y2 * cs.w; o2[2 * t2 + 1] = y1 * cs.w + y2 * cs.z; }
                    }
                    u32x4 b1, b2;
                    b1.x = cvtpk(o1[0] * osc, o1[1] * osc); b1.y = cvtpk(o1[2] * osc, o1[3] * osc); b1.z = cvtpk(o1[4] * osc, o1[5] * osc); b1.w = cvtpk(o1[6] * osc, o1[7] * osc);
                    b2.x = cvtpk(o2[0] * osc, o2[1] * osc); b2.y = cvtpk(o2[2] * osc, o2[3] * osc); b2.z = cvtpk(o2[4] * osc, o2[5] * osc); b2.w = cvtpk(o2[6] * osc, o2[7] * osc);
                    if (typ == 2) { *(u32x4*)(dstb + (size_t)r * 512 + segc) = b1; *(u32x4*)(dstb + (size_t)r * 512 + segc + 32) = b2; }
                    else if (r < MROWS) {
                        const int prow = r < NMETA ? r : r + 48;
                        unsigned char* kd = ws + WS_KV + (size_t)(prow >> 6) * 131072 + hh_ * 32768 + cc_ * 8192 + fq * 1024 + (prow & 63) * 16;
                        *(u32x4*)kd = b1; *(u32x4*)(kd + 4096) = b2;
                    }
                    if (typ == 3 && r < MROWS) {
                        float* d = (r < TP) ? out + O_KP + (size_t)r * 512 : out + O_KS + (size_t)(r - TP) * 512;
                        *(f32x4*)(d + segc) = (f32x4){o1[0], o1[1], o1[2], o1[3]}; *(f32x4*)(d + segc + 4) = (f32x4){o1[4], o1[5], o1[6], o1[7]};
                        *(f32x4*)(d + segc + 32) = (f32x4){o2[0], o2[1], o2[2], o2[3]}; *(f32x4*)(d + segc + 36) = (f32x4){o2[4], o2[5], o2[6], o2[7]};
                    }
                    asm volatile("" ::: "memory");
                }
#undef EI_ROPE
        } else {
#pragma unroll
            for (int ai = 0; ai < 2; ++ai)
#pragma unroll
                for (int m = 0; m < 4; ++m) {
                    const int r = u.pm * 256 + ai * 128 + wr * 64 + m * 16 + fr;
#pragma unroll
                    for (int bj = 0; bj < 2; ++bj) {
                        const f32x4 a0 = acc[ai][bj][m][0], a1 = acc[ai][bj][m][1];
                        const int col = segc + 32 * bj;
                        if (typ == 0) {
                            float* d = (float*)(ws + WS_XA) + (size_t)r * 512 + col;
                            *(f32x4*)d = a0; *(f32x4*)(d + 4) = a1;
                        } else if (typ == 4) {
                            u32x4 b; b.x = cvtpk(a0.x, a0.y); b.y = cvtpk(a0.z, a0.w); b.z = cvtpk(a1.x, a1.y); b.w = cvtpk(a1.z, a1.w);
                            if (r < MROWS) {
                                const int prow = r < NMETA ? r : r + 48;
                                const int hh_ = (u.pn & 1) * 2 + (wc >> 1), dblk = (wc & 1) * 2 + bj;
                                *(u32x4*)(ws + WS_KV + (size_t)(prow >> 6) * 131072 + hh_ * 32768 + 16384 + (dblk * 4 + ((prow & 63) >> 4)) * 1024 + (prow & 15) * 64 + fq * 16) = b;
                            }
                            if (r < MROWS) {
                                float* d = ((r < TP) ? out + O_VP + (size_t)r * 512 : out + O_VS + (size_t)(r - TP) * 512) + col;
                                *(f32x4*)d = a0; *(f32x4*)(d + 4) = a1;
                            }
                        } else {
                            u32x4 b; b.x = cvtpk(silu_f(a0.x), silu_f(a0.y)); b.y = cvtpk(silu_f(a0.z), silu_f(a0.w)); b.z = cvtpk(silu_f(a1.x), silu_f(a1.y)); b.w = cvtpk(silu_f(a1.z), silu_f(a1.w));
                            *(u32x4*)((bf16*)(ws + (typ == 1 ? WS_SGA : WS_SGB)) + (size_t)r * 512 + col) = b;
                        }
                    }
                }
        }
    }
};
__device__ __forceinline__ int late_pn(int j) { return (j & 2) ? 10 + (j & 1) : 2 + (j & 1); }
struct P1Order {
    pg8::StaticOrder S;
    __device__ __forceinline__ void init(int G, int c) { S.init(16384, DIN, G, c); }
    __device__ __forceinline__ bool next(int i, pg8::Unit& u) const {
        if (!S.next(i, u)) return false;
        const bool gate = (u.pn == 2) | (u.pn == 3) | (u.pn == 10) | (u.pn == 11);
        if (u.pm < 6 && gate) { const int k = u.pm * 4 + ((u.pn >= 10) ? 2 + (u.pn - 10) : (u.pn - 2)); u.pm = 64 + k / 12; u.pn = k % 12; }
        return true;
    }
    __device__ __forceinline__ void a_ready(const pg8::Unit&) const {}
    __device__ __forceinline__ void done(const pg8::Unit&) const {}
};
struct OneUnit {
    int pm, pn;
    __device__ __forceinline__ bool next(int i, pg8::Unit& u) const { if (i != 0) return false; u.pm = pm; u.pn = pn; return true; }
    __device__ __forceinline__ void a_ready(const pg8::Unit&) const {}
    __device__ __forceinline__ void done(const pg8::Unit&) const {}
};
struct EpiOut {
    static constexpr bool PERM = false, AFTER_DRAIN = false;
    float* out; const float* xp; const float* xs;
    __device__ __forceinline__ void rowptr(const pg8::Unit& u, int wr, int fr, int b, int k, const float*& xr, float*& orow) const {
        const int r = u.pm * 256 + (b >> 1) * 128 + wr * 64 + ((b & 1) * 2 + k) * 16 + fr;
        if (r < 16384) { xr = xp + (size_t)r * DM; orow = out + O_YP + (size_t)r * DM; }
        else { xr = xs + (size_t)(r - 16384) * DM; orow = out + O_YS + (size_t)(r - 16384) * DM; }
    }
    __device__ __forceinline__ void operator()(const f32x4 (&acc)[2][2][4][2], const pg8::Unit& u, int wr, int wc, int fr, int fq) const {
        const int col0 = u.pn * 256 + wc * 32 + fq * 4;
        f32x4 xa[8], xb[8];
#define EO_LOAD(b, X) do { _Pragma("unroll") for (int k = 0; k < 2; ++k) { const float* xr; float* orow; rowptr(u, wr, fr, (b), k, xr, orow); \
            _Pragma("unroll") for (int bj = 0; bj < 2; ++bj) _Pragma("unroll") for (int n = 0; n < 2; ++n) X[k * 4 + bj * 2 + n] = *(const f32x4*)(xr + col0 + bj * 128 + n * 16); } } while (0)
#define EO_STORE(b, X) do { _Pragma("unroll") for (int k = 0; k < 2; ++k) { const float* xr; float* orow; rowptr(u, wr, fr, (b), k, xr, orow); \
            _Pragma("unroll") for (int bj = 0; bj < 2; ++bj) _Pragma("unroll") for (int n = 0; n < 2; ++n) \
                *(f32x4*)(orow + col0 + bj * 128 + n * 16) = X[k * 4 + bj * 2 + n] + acc[(b) >> 1][bj][((b) & 1) * 2 + k][n]; } } while (0)
        EO_LOAD(0, xa); EO_LOAD(1, xb);
        EO_STORE(0, xa); EO_LOAD(2, xa);
        EO_STORE(1, xb); EO_LOAD(3, xb);
        EO_STORE(2, xa); EO_STORE(3, xb);
#undef EO_LOAD
#undef EO_STORE
    }
};

template <int MODE>
__device__ __forceinline__ void lru_chunk(const Params& p, LAS unsigned char* lds, int idx) {
    int ch_ = threadIdx.x; asm volatile("" : "+v"(ch_));
    const int ch = ch_, lane = ch & 63, r32 = lane & 31, hi = lane >> 5;
    const int n = __builtin_amdgcn_readfirstlane(ch >> 6);
    LAS float* cfs = (LAS float*)lds;
    LAS float* als = (LAS float*)lds + 32 * LRS;
    const float* XA = (const float*)(p.ws + WS_XA);
    const bf16* SGA = (const bf16*)(p.ws + WS_SGA); bf16* YCAT = (bf16*)(p.ws + WS_YCAT);
    const bool samp = idx >= N_LRU_P;
    int row0, L, ci = 0, b = 0; float h = 0.f; float xv[35];
    if (!samp) {
        ci = idx; row0 = LRU_CH * ci; L = (TP - row0) < LRU_CH ? (TP - row0) : LRU_CH;
        if (ci > 0) { xv[0] = XA[(size_t)(row0 - 3) * 512 + ch]; xv[1] = XA[(size_t)(row0 - 2) * 512 + ch]; xv[2] = XA[(size_t)(row0 - 1) * 512 + ch]; }
        else { xv[0] = 0.f; xv[1] = 0.f; xv[2] = 0.f; }
        if (MODE == 1) h = ((const float*)(p.ws + WS_CARRY))[ci * 512 + ch];
    } else {
        b = idx - N_LRU_P; row0 = TP + 16 * b; L = 16; h = p.in[4][b * 512 + ch];
        xv[0] = p.in[5][(b * 3 + 0) * 512 + ch]; xv[1] = p.in[5][(b * 3 + 1) * 512 + ch]; xv[2] = p.in[5][(b * 3 + 2) * 512 + ch];
    }
#pragma unroll
    for (int t = 0; t < 32; ++t) xv[3 + t] = (t < L) ? XA[(size_t)(row0 + t) * 512 + ch] : 0.f;
    bf16x8 bw[16];
    { const bf16x8* GH = (const bf16x8*)(p.ws + WS_GWH);
#pragma unroll
      for (int ks = 0; ks < 4; ++ks)
#pragma unroll
        for (int g = 0; g < 2; ++g)
#pragma unroll
            for (int ct = 0; ct < 2; ++ct) bw[(ks * 2 + g) * 2 + ct] = GH[((((n * 2 + g) * 2 + ct) * 4 + ks) * 64 + lane)]; }
    { const float cw0 = p.in[10][ch], cw1 = p.in[10][512 + ch], cw2 = p.in[10][1024 + ch], cw3 = p.in[10][1536 + ch], cb = p.in[11][ch];
#pragma unroll
      for (int t = 0; t < 32; ++t) cfs[t * LRS + ch] = cb + cw0 * xv[t] + cw1 * xv[t + 1] + cw2 * xv[t + 2] + cw3 * xv[t + 3]; }
    asm volatile("s_waitcnt lgkmcnt(0)" ::: "memory");
    bf16x8 ah[4], al[4];
#pragma unroll
    for (int ks = 0; ks < 4; ++ks) {
        const LAS float* s = cfs + r32 * LRS + n * 64 + ks * 16 + hi * 8;
        const f32x4 x0 = *(const LAS f32x4*)s, x1 = *(const LAS f32x4*)(s + 4);
        u32x4 uh, ul;
#pragma unroll
        for (int q = 0; q < 4; ++q) {
            const float e0 = (q < 2) ? x0[2 * q] : x1[2 * q - 4], e1 = (q < 2) ? x0[2 * q + 1] : x1[2 * q - 3];
            const unsigned u = cvtpk(e0, e1); uh[q] = u;
            ul[q] = cvtpk(e0 - __uint_as_float(u << 16), e1 - __uint_as_float(u & 0xffff0000u));
        }
        ah[ks] = __builtin_bit_cast(bf16x8, uh); al[ks] = __builtin_bit_cast(bf16x8, ul);
    }
    f32x16 acc[2][2];
#pragma unroll
    for (int g = 0; g < 2; ++g)
#pragma unroll
        for (int ct = 0; ct < 2; ++ct)
#pragma unroll
            for (int r = 0; r < 16; ++r) acc[g][ct][r] = 0.f;
#pragma unroll
    for (int ks = 0; ks < 4; ++ks)
#pragma unroll
        for (int g = 0; g < 2; ++g)
#pragma unroll
            for (int ct = 0; ct < 2; ++ct) {
                const bf16x8 bh = bw[(ks * 2 + g) * 2 + ct];
                acc[g][ct] = __builtin_amdgcn_mfma_f32_32x32x16_bf16(ah[ks], bh, acc[g][ct], 0, 0, 0);
                acc[g][ct] = __builtin_amdgcn_mfma_f32_32x32x16_bf16(al[ks], bh, acc[g][ct], 0, 0, 0);
            }
    unsigned short sg[32];
    if (MODE == 1) {
#pragma unroll
        for (int t = 0; t < 32; ++t) sg[t] = (t < L) ? SGA[(size_t)(row0 + t) * 512 + ch] : (unsigned short)0;
    }
#pragma unroll
    for (int ct = 0; ct < 2; ++ct) {
        const int chn = n * 64 + ct * 32 + r32;
        const float gab = p.in[13][chn], gxb = p.in[15][chn], sp = ((const float*)(p.ws + WS_SP))[chn];
#pragma unroll
        for (int r = 0; r < 16; ++r) {
            const int tok = crow(r, hi);
            const float pr = acc[0][ct][r] + gab, pi = acc[1][ct][r] + gxb;
            const float rg = __builtin_amdgcn_rcpf(1.0f + __builtin_amdgcn_exp2f(-LOG2E * pr));
            const float ig = __builtin_amdgcn_rcpf(1.0f + __builtin_amdgcn_exp2f(-LOG2E * pi));
            const float la = -8.0f * rg * sp;
            const float a = __builtin_amdgcn_exp2f(LOG2E * la);
            const float x2 = 2.0f * la;
            const float om = (x2 > -0.05f) ? -x2 * (1.0f + x2 * (0.5f + x2 * (0.16666667f + x2 * 0.041666668f))) : (1.0f - a * a);
            const float bb = __builtin_amdgcn_sqrtf(om) * (ig * cfs[tok * LRS + chn]);
            als[tok * LRS + chn] = a; cfs[tok * LRS + chn] = bb;
        }
    }
    asm volatile("s_waitcnt lgkmcnt(0)" ::: "memory");
    float ca = 1.0f;
#pragma unroll
    for (int t = 0; t < 32; ++t) {
        if (t < L) {
            const float a = als[t * LRS + ch], bb = cfs[t * LRS + ch];
            if (MODE == 0) {
                __hip_atomic_store((unsigned*)(p.ws + WS_AT) + (size_t)(row0 + t) * 512 + ch, __float_as_uint(a), __ATOMIC_RELAXED, __HIP_MEMORY_SCOPE_AGENT);
                __hip_atomic_store((unsigned*)(p.ws + WS_BT) + (size_t)(row0 + t) * 512 + ch, __float_as_uint(bb), __ATOMIC_RELAXED, __HIP_MEMORY_SCOPE_AGENT);
            }
            h = a * h + bb; ca *= a;
            if (MODE == 1 && row0 + t >= NMETA) YCAT[(size_t)(row0 + t - NMETA) * 1024 + ch] = f2bf(h * bf2f(sg[t]));
        }
    }
    asm volatile("s_waitcnt lgkmcnt(0)" ::: "memory");
    constexpr int LASTL = TP - LRU_CH * (N_LRU_P - 1);
    if (MODE == 0) {
        __hip_atomic_store((unsigned*)(p.ws + WS_SUMA) + ci * 512 + ch, __float_as_uint(ca), __ATOMIC_RELAXED, __HIP_MEMORY_SCOPE_AGENT);
        __hip_atomic_store((unsigned*)(p.ws + WS_SUMB) + ci * 512 + ch, __float_as_uint(h), __ATOMIC_RELAXED, __HIP_MEMORY_SCOPE_AGENT);
        if (ci == N_LRU_P - 1) { p.out[O_CP + ch] = xv[LASTL]; p.out[O_CP + 512 + ch] = xv[LASTL + 1]; p.out[O_CP + 1024 + ch] = xv[LASTL + 2]; }
    } else if (!samp) {
        if (ci == N_LRU_P - 1) p.out[O_HP + ch] = h;
    } else {
        p.out[O_HS + b * 512 + ch] = h;
        p.out[O_CS + (b * 3 + 0) * 512 + ch] = xv[16]; p.out[O_CS + (b * 3 + 1) * 512 + ch] = xv[17]; p.out[O_CS + (b * 3 + 2) * 512 + ch] = xv[18];
    }
}
__device__ __forceinline__ void lru_pass2(const Params& p, int ci) {
    int ch_ = threadIdx.x; asm volatile("" : "+v"(ch_));
    const int ch = ch_;
    const int row0 = LRU_CH * ci, L = (TP - row0) < LRU_CH ? (TP - row0) : LRU_CH;
    const float* AT = (const float*)(p.ws + WS_AT); const float* BT = (const float*)(p.ws + WS_BT);
    const bf16* SGA = (const bf16*)(p.ws + WS_SGA); bf16* YCAT = (bf16*)(p.ws + WS_YCAT);
    float h = ((const float*)(p.ws + WS_CARRY))[ci * 512 + ch];
    float av[32], bv[32]; unsigned short sg[32];
#pragma unroll
    for (int t = 0; t < 32; ++t) {
        const size_t o_ = (size_t)(row0 + t) * 512 + ch;
        av[t] = (t < L) ? AT[o_] : 1.0f; bv[t] = (t < L) ? BT[o_] : 0.f; sg[t] = (t < L) ? SGA[o_] : (unsigned short)0;
    }
#pragma unroll
    for (int t = 0; t < 32; ++t) {
        if (t < L) {
            h = av[t] * h + bv[t];
            if (row0 + t >= NMETA) YCAT[(size_t)(row0 + t - NMETA) * 1024 + ch] = f2bf(h * bf2f(sg[t]));
        }
    }
    if (ci == N_LRU_P - 1) p.out[O_HP + ch] = h;
}
__device__ __forceinline__ void lru_arrive(const Params& p, LAS unsigned char* lds, int it_, int n_arrivers) {
    const int ch = threadIdx.x;
    unsigned* ctl = (unsigned*)(p.ws + WS_CTL);
    asm volatile("s_waitcnt vmcnt(0)" ::: "memory");
    __syncthreads();
    volatile LAS unsigned* lw = (volatile LAS unsigned*)(lds + LCTL + 16);
    if (ch == 0) lw[0] = __hip_atomic_fetch_add(ctl + CW_LRUDONE + 64 * it_, 1u, __ATOMIC_RELAXED, __HIP_MEMORY_SCOPE_AGENT);
    __syncthreads();
    if (lw[0] + 1u == (unsigned)n_arrivers) {
        __builtin_amdgcn_fence(__ATOMIC_ACQUIRE, "agent");
        asm volatile("s_waitcnt vmcnt(0)" ::: "memory");
        const float* SA = (const float*)(p.ws + WS_SUMA); const float* SB = (const float*)(p.ws + WS_SUMB); float* CR = (float*)(p.ws + WS_CARRY);
        float H = 0.f;
        for (int k = 0; k < N_LRU_P; k += 19) {
            float a_[19], b_[19];
#pragma unroll
            for (int j = 0; j < 19; ++j) { a_[j] = SA[(k + j) * 512 + ch]; b_[j] = SB[(k + j) * 512 + ch]; }
#pragma unroll
            for (int j = 0; j < 19; ++j) { __hip_atomic_store((unsigned*)CR + (k + j) * 512 + ch, __float_as_uint(H), __ATOMIC_RELAXED, __HIP_MEMORY_SCOPE_AGENT); H = a_[j] * H + b_[j]; }
        }
        asm volatile("s_waitcnt vmcnt(0)" ::: "memory");
        __syncthreads();
        if (ch == 0) __hip_atomic_store(ctl + CW_CARRYOK + 64 * it_, 1u, __ATOMIC_RELAXED, __HIP_MEMORY_SCOPE_AGENT);
    }
    __syncthreads();
}

__device__ __forceinline__ s16x4 tr16(const LAS unsigned char* p) {
    typedef short v4i16_t __attribute__((ext_vector_type(4)));
    return __builtin_bit_cast(s16x4, __builtin_amdgcn_ds_read_tr16_b64_v4i16((LAS v4i16_t*)p));
}
__device__ __forceinline__ void attn_sample(const Params& p, LAS unsigned char* lds, int b, int h, float negm, float lam) {
    int tid_ = threadIdx.x; asm volatile("" : "+v"(tid_));
    const int tid = tid_, lane = tid & 63, r32 = lane & 31, hi = lane >> 5;
    const int wid = __builtin_amdgcn_readfirstlane(tid >> 6), db = wid & 3, c = wid >> 2;
    const bf16* QBp = (const bf16*)(p.ws + WS_QB);
    constexpr int NT = 65;
    const int qrow = TP + 16 * b + (r32 & 15);
    bf16x8 qr[4];
    { const bf16* q = QBp + (size_t)qrow * 512 + h * 128 + c * 64 + hi * 8;
#pragma unroll
      for (int d0 = 0; d0 < 4; ++d0) qr[d0] = *(const bf16x8*)(q + d0 * 16); }
    f32x16 o;
#pragma unroll
    for (int r = 0; r < 16; ++r) o[r] = 0.f;
    float lacc = 0.f;
    const int kkey = 8 * (tid >> 6) + (lane & 7), kch = lane >> 3, kcol = h * 128 + kch * 8;
    const unsigned kdst = kch * 1024 + kkey * 16;
    int vkey[2], vcol[2]; unsigned vdst[2], vimg[2];
#pragma unroll
    for (int i = 0; i < 2; ++i) { const int wv = (tid >> 6) + 8 * i, q16 = ((lane >> 3) & 3) * 4 + (lane & 3); vkey[i] = wv * 4 + ((lane >> 5) & 1) * 2 + ((lane >> 2) & 1); vcol[i] = h * 128 + q16 * 8;
        vdst[i] = 16384 + ((q16 >> 2) * 4 + (vkey[i] >> 4)) * 1024 + (vkey[i] & 15) * 64 + (q16 & 3) * 16;
        vimg[i] = 16384 + ((q16 >> 2) * 4 + (b & 3)) * 1024 + (vkey[i] & 15) * 64 + (q16 & 3) * 16; }
    const unsigned char* img = p.ws + WS_KV + (size_t)(257 + (b >> 2)) * 131072 + (size_t)h * 32768;
    const unsigned kimg = kch * 1024 + ((b & 3) * 16 + (kkey & 15)) * 16;
    f32x4 sa[8], sb[8];
#define ATT_LOAD(st, j) do { \
        const size_t row0_ = (size_t)b * PAST + 64 * (j); const float* ck = p.in[2] + (row0_ + kkey) * 512 + kcol; \
        st[0] = *(const f32x4*)ck; st[1] = *(const f32x4*)(ck + 4); st[2] = *(const f32x4*)(ck + 64); st[3] = *(const f32x4*)(ck + 68); \
        _Pragma("unroll") for (int i_ = 0; i_ < 2; ++i_) { const float* cv = p.in[3] + (row0_ + vkey[i_]) * 512 + vcol[i_]; st[4 + 2 * i_] = *(const f32x4*)cv; st[5 + 2 * i_] = *(const f32x4*)(cv + 4); } \
    } while (0)
#define PK4(A_, B_2) (u32x4){cvtpk((A_)[0], (A_)[1]), cvtpk((A_)[2], (A_)[3]), cvtpk((B_2)[0], (B_2)[1]), cvtpk((B_2)[2], (B_2)[3])}
#define ATT_STORE(st, buf) do { LAS unsigned char* B_ = lds + (buf) * 32768; \
        *(LAS u32x4*)(B_ + kdst) = PK4(st[0], st[1]); *(LAS u32x4*)(B_ + 8192 + kdst) = PK4(st[2], st[3]); \
        *(LAS u32x4*)(B_ + vdst[0]) = PK4(st[4], st[5]); *(LAS u32x4*)(B_ + vdst[1]) = PK4(st[6], st[7]); \
    } while (0)
#define ATT_COMPUTE(LAST, buf) do { \
            const LAS unsigned char* Bb = lds + (buf) * 32768; \
            const LAS unsigned char* Kb = Bb + c * 8192 + hi * 1024 + r32 * 16; \
            f32x16 p0, p1; \
            _Pragma("unroll") for (int r = 0; r < 16; ++r) { p0[r] = negm; p1[r] = negm; } \
            _Pragma("unroll") for (int d0 = 0; d0 < 4; ++d0) { \
                const bf16x8 b0 = *(const LAS bf16x8*)(Kb + d0 * 2048), b1 = *(const LAS bf16x8*)(Kb + d0 * 2048 + 512); \
                p0 = __builtin_amdgcn_mfma_f32_32x32x16_bf16(b0, qr[d0], p0, 0, 0, 0); \
                p1 = __builtin_amdgcn_mfma_f32_32x32x16_bf16(b1, qr[d0], p1, 0, 0, 0); } \
            _Pragma("unroll") for (int r = 0; r < 16; ++r) { p0[r] = __builtin_amdgcn_exp2f(p0[r]); p1[r] = __builtin_amdgcn_exp2f(p1[r]); } \
            if (LAST) {     \
                _Pragma("unroll") for (int r = 8; r < 16; ++r) p0[r] = 0.f; \
                _Pragma("unroll") for (int r = 0; r < 16; ++r) p1[r] = 0.f; } \
            float s = 0.f; \
            _Pragma("unroll") for (int r = 0; r < 16; ++r) s += p0[r] + p1[r]; \
            lacc += s; \
            u32x4 pw[4]; \
            pw[0] = (u32x4){cvtpk(p0[0], p0[1]), cvtpk(p0[2], p0[3]), cvtpk(p0[4], p0[5]), cvtpk(p0[6], p0[7])}; \
            pw[1] = (u32x4){cvtpk(p0[8], p0[9]), cvtpk(p0[10], p0[11]), cvtpk(p0[12], p0[13]), cvtpk(p0[14], p0[15])}; \
            pw[2] = (u32x4){cvtpk(p1[0], p1[1]), cvtpk(p1[2], p1[3]), cvtpk(p1[4], p1[5]), cvtpk(p1[6], p1[7])}; \
            pw[3] = (u32x4){cvtpk(p1[8], p1[9]), cvtpk(p1[10], p1[11]), cvtpk(p1[12], p1[13]), cvtpk(p1[14], p1[15])}; \
            const LAS unsigned char* Vb = Bb + 16384 + db * 4096 + ((lane >> 4) & 1) * 32 + (lane & 3) * 8 + (4 * hi + ((lane & 15) >> 2)) * 64; \
            _Pragma("unroll") for (int kg = 0; kg < 4; ++kg) { \
                const s16x4 lo = tr16(Vb + kg * 1024), hh = tr16(Vb + kg * 1024 + 512); \
                const bf16x8 vf = (bf16x8){lo[0], lo[1], lo[2], lo[3], hh[0], hh[1], hh[2], hh[3]}; \
                o = __builtin_amdgcn_mfma_f32_32x32x16_bf16(__builtin_bit_cast(bf16x8, pw[kg]), vf, o, 0, 0, 0); } \
        } while (0)
    ATT_LOAD(sa, 0); ATT_LOAD(sb, 1); ATT_STORE(sa, 0); __syncthreads();
    for (int j = 0; j < 62; j += 2) {
        ATT_LOAD(sa, j + 2);
        ATT_COMPUTE(false, 0);
        ATT_STORE(sb, 1);
        __syncthreads();
        ATT_LOAD(sb, j + 3);
        ATT_COMPUTE(false, 1);
        ATT_STORE(sa, 0);
        __syncthreads();
    }
    {
        const u32x4 i0 = *(const u32x4*)(img + kimg), i1 = *(const u32x4*)(img + 8192 + kimg), i2 = *(const u32x4*)(img + vimg[0]), i3 = *(const u32x4*)(img + vimg[1]);
        ATT_COMPUTE(false, 0);
        ATT_STORE(sb, 1);
        __syncthreads();
        ATT_COMPUTE(false, 1);
        *(LAS u32x4*)(lds + kdst) = i0; *(LAS u32x4*)(lds + 8192 + kdst) = i1; *(LAS u32x4*)(lds + vdst[0]) = i2; *(LAS u32x4*)(lds + vdst[1]) = i3;
        __syncthreads();
        ATT_COMPUTE(true, 0);
        __syncthreads();
    }
#undef ATT_LOAD
#undef ATT_STORE
#undef ATT_COMPUTE
#undef PK4
    lacc += __shfl_xor(lacc, 32);
    LAS float* wsf = (LAS float*)(lds + 98304) + wid * 64;
    if (hi == 0) wsf[r32] = lacc;
    asm volatile("s_waitcnt lgkmcnt(0)" ::: "memory");
    float rli[16];
#pragma unroll
    for (int r = 0; r < 16; ++r) rli[r] = __builtin_amdgcn_rcpf(wsf[crow(r, hi)]);
    LAS float* X2 = (LAS float*)lds + db * 1024;
    LAS float* SS = (LAS float*)(lds + 65536);
    if (c == 1) {
#pragma unroll
        for (int r = 0; r < 16; ++r) X2[r * 64 + lane] = lam * (o[r] * rli[r]);
    }
    __syncthreads();
    if (c == 0) {
#pragma unroll
        for (int r = 0; r < 16; ++r) {
            const float v = o[r] * rli[r] - X2[r * 64 + lane]; o[r] = v;
            const float s = half_sum_hi16(v * v);
            if (r32 == 16) SS[db * 32 + crow(r, hi)] = s;
        }
    }
    __syncthreads();
    if (c == 0) {
        const bf16* SGB = (const bf16*)(p.ws + WS_SGB); bf16* YCAT = (bf16*)(p.ws + WS_YCAT);
        const float sw = p.in[23][db * 32 + r32];
        const int e = db * 32 + r32;
        bf16 gt[8];
#pragma unroll
        for (int r = 0; r < 8; ++r) gt[r] = SGB[(size_t)(TP + 16 * b + (crow(r, hi) & 15)) * 512 + h * 128 + e];
#pragma unroll
        for (int r = 0; r < 8; ++r) {
            const int q = crow(r, hi);
            const float s = (SS[q] + SS[32 + q]) + (SS[64 + q] + SS[96 + q]);
            const float rinv = __builtin_amdgcn_rsqf(s * (1.0f / 128.0f) + EPS);
            const size_t row = (size_t)(TP + 16 * b + (q & 15));
            YCAT[(row - NMETA) * 1024 + 512 + h * 128 + e] = f2bf((((o[r] * rinv) * sw) * ONE_M_LAM0) * bf2f(gt[r]));
        }
    }
    __syncthreads();
}

__device__ __forceinline__ void glds16(const void* gsrc, unsigned lds_dst) {
    unsigned keep;
    asm volatile("s_mov_b32 %0, m0\n\ts_mov_b32 m0, %2\n\ts_nop 0\n\tglobal_load_lds_dwordx4 %1, off\n\ts_mov_b32 m0, %0" : "=&s"(keep) : "v"(gsrc), "s"(lds_dst) : "memory");
}
#ifdef PROBE_BARW
#define PBS2() unsigned long long tb_ = PB_T()
#define PBE2(k) do { const unsigned long long tn_ = PB_T(); if (PROBE_SEC == (k)) pb_wait += tn_ - tb_; tb_ = tn_; } while (0)
#else
#define PBS2() do {} while (0)
#define PBE2(k) do {} while (0)
#endif
#ifdef PROBE_BARW
__device__ unsigned long long g_barw[4];
#define PB_T() __builtin_amdgcn_s_memtime()
#define AP_WAIT_BAR(N) do { const unsigned long long ta_ = PB_T(); asm volatile("s_waitcnt vmcnt(" #N ") lgkmcnt(0)" ::: "memory"); const unsigned long long t0_ = PB_T(); asm volatile("s_barrier" ::: "memory"); const unsigned long long t1_ = PB_T(); if (PROBE_SEC == 0) pb_wait += t1_ - t0_; if (PROBE_SEC == 1) pb_wait += t0_ - ta_; } while (0)
#define AP_BAR() do { const unsigned long long ta_ = PB_T(); asm volatile("s_waitcnt lgkmcnt(0)" ::: "memory"); const unsigned long long t0_ = PB_T(); asm volatile("s_barrier" ::: "memory"); const unsigned long long t1_ = PB_T(); if (PROBE_SEC == 0) pb_wait += t1_ - t0_; if (PROBE_SEC == 1) pb_wait += t0_ - ta_; } while (0)
#else
#define AP_WAIT_BAR(N) asm volatile("s_waitcnt vmcnt(" #N ") lgkmcnt(0)\n\ts_barrier" ::: "memory")
#define AP_BAR() asm volatile("s_waitcnt lgkmcnt(0)\n\ts_barrier" ::: "memory")
#endif
__device__ __forceinline__ float fadd_s(float a, float b) { float r; asm("v_add_f32_e32 %0, %1, %2" : "=v"(r) : "v"(a), "v"(b)); return r; }
__device__ __forceinline__ void attn_prompt(const Params& p, LAS unsigned char* lds, int a, int h, float negm, float lam) {
    int tid_ = threadIdx.x; asm volatile("" : "+v"(tid_));
    const int tid = tid_, lane = tid & 63, r32 = lane & 31, hi = lane >> 5;
    const int wid = __builtin_amdgcn_readfirstlane(tid >> 6), qs = wid & 3, c = wid >> 2;
    const bf16* QBp = (const bf16*)(p.ws + WS_QB);
    const int NT = 2 * a + 3;
#ifdef PROBE_BARW
    unsigned long long pb_wait = 0ull; const unsigned long long pb_t0 = __builtin_amdgcn_s_memtime();
#endif
    const int qrow = NMETA + 128 * a + 32 * qs + r32;
    bf16x8 qr[4];
    { const bf16* q = QBp + (size_t)qrow * 512 + h * 128 + c * 64 + hi * 8;
#pragma unroll
      for (int d0 = 0; d0 < 4; ++d0) qr[d0] = *(const bf16x8*)(q + d0 * 16); }
    asm volatile("" : "+v"(qr[0]), "+v"(qr[1]), "+v"(qr[2]), "+v"(qr[3]));
    const unsigned char* isrc = p.ws + WS_KV + (size_t)h * 32768 + wid * 1024 + lane * 16;
    const unsigned lds0 = (unsigned)(size_t)lds;
    const unsigned kdst = lds0 + wid * 1024, vdst = lds0 + 65536u + wid * 1024;
#define RFL(x) ((unsigned)__builtin_amdgcn_readfirstlane(x))
#define DMA_K(j) do { const unsigned char* g_ = isrc + (size_t)(j) * 131072; const unsigned d_ = kdst + (unsigned)((j) & 3) * 16384u; glds16(g_, RFL(d_)); glds16(g_ + 8192, RFL(d_ + 8192u)); } while (0)
#define DMA_V(j) do { const unsigned char* g_ = isrc + (size_t)(j) * 131072 + 16384; const unsigned d_ = vdst + (unsigned)((j) % 3) * 16384u; glds16(g_, RFL(d_)); glds16(g_ + 8192, RFL(d_ + 8192u)); } while (0)
#define AP_ISSUE(t) do { if ((t) + 3 < NT) DMA_K((t) + 3); if ((t) + 1 < NT) DMA_V((t) + 1); } while (0)
#define DMA_K1(j, pc) do { const unsigned char* g_ = isrc + (size_t)(j) * 131072 + (pc) * 8192; const unsigned d_ = kdst + (unsigned)((j) & 3) * 16384u + (pc) * 8192u; glds16(g_, RFL(d_)); } while (0)
#define DMA_V1(j, pc) do { const unsigned char* g_ = isrc + (size_t)(j) * 131072 + 16384 + (pc) * 8192; const unsigned d_ = vdst + (unsigned)((j) % 3) * 16384u + (pc) * 8192u; glds16(g_, RFL(d_)); } while (0)
#define AP_WAITN(t) do { const int n_ = (((t) + 3 < NT) ? 2 : 0) + (((t) + 1 < NT) ? 2 : 0); if (n_ == 4) AP_WAIT_BAR(4); else if (n_ == 2) AP_WAIT_BAR(2); else AP_WAIT_BAR(0); } while (0)
#define SBAR() __builtin_amdgcn_sched_barrier(0)
#define PIN(x) asm volatile("" : "+v"(x))
#define MF(A_, B_, C_) __builtin_amdgcn_mfma_f32_32x32x16_bf16(A_, B_, C_, 0, 0, 0)
#define KOFF(j) (((j) >> 1) * 2048 + ((j) & 1) * 512)
#define VOFF(i) ((((i) & 3) * 4 + ((i) >> 2)) * 1024)
#define VF(k) (bf16x8){vl[k][0], vl[k][1], vl[k][2], vl[k][3], vh[k][0], vh[k][1], vh[k][2], vh[k][3]}
#define PEL(P0, P1, e) (((e) < 16) ? P0[(e) & 15] : P1[(e) & 15])
    const LAS unsigned char* Kl = lds + c * 8192 + hi * 1024 + r32 * 16;
    const LAS unsigned char* Vl = lds + 65536 + ((lane >> 4) & 1) * 32 + (lane & 3) * 8 + (4 * hi + ((lane & 15) >> 2)) * 64;
    DMA_K(0); DMA_V(0); DMA_K(1); DMA_K(2);
    f32x16 o[4];
#pragma unroll
    for (int i = 0; i < 4; ++i)
#pragma unroll
        for (int r = 0; r < 16; ++r) o[i][r] = 0.f;
    float lacc = 0.f;
    u32x4 pw[4];
    bf16x8 kf[4];
    s16x4 vl[8], vh[8];
    f32x16 pA0, pA1, pB0, pB1;
    const f32x16 zero16 = {0.f, 0.f, 0.f, 0.f, 0.f, 0.f, 0.f, 0.f, 0.f, 0.f, 0.f, 0.f, 0.f, 0.f, 0.f, 0.f};
    AP_WAIT_BAR(6);
    AP_ISSUE(0);
    {
        bf16x8 k0[8];
#pragma unroll
        for (int j = 0; j < 8; ++j) k0[j] = *(const LAS bf16x8*)(Kl + KOFF(j));
        pA0 = MF(k0[0], qr[0], zero16); pA1 = MF(k0[1], qr[0], zero16);
#pragma unroll
        for (int j = 2; j < 8; ++j) { if (j & 1) pA1 = MF(k0[j], qr[j >> 1], pA1); else pA0 = MF(k0[j], qr[j >> 1], pA0); }
#pragma unroll
        for (int r = 0; r < 8; ++r) pA0[r] = __builtin_amdgcn_exp2f(pA0[r]);
#pragma unroll
        for (int r = 8; r < 16; ++r) pA0[r] = 0.f;
#pragma unroll
        for (int r = 0; r < 16; ++r) pA1[r] = 0.f;
    }
    AP_WAITN(0);
#pragma unroll
    for (int j = 0; j < 4; ++j) kf[j] = *(const LAS bf16x8*)(Kl + 16384 + KOFF(j));
#define AP_GA(i, C0, C1, P0, P1) do { \
            if ((i) >= 1) { vl[(i) - 1] = tr16(Vb_ + VOFF((i) - 1)); vh[(i) - 1] = tr16(Vb_ + VOFF((i) - 1) + 512); }     \
            SBAR(); \
            if ((i) == 0) C0 = MF(kf[0], qr[0], zero16); else if ((i) == 1) C1 = MF(kf[1], qr[0], zero16); \
            else if ((i) & 1) C1 = MF(kf[(i) & 3], qr[(i) >> 1], C1); else C0 = MF(kf[(i) & 3], qr[(i) >> 1], C0); \
            sa0 = fadd_s(sa0, PEL(P0, P1, 4 * (i))); sa1 = fadd_s(sa1, PEL(P0, P1, 4 * (i) + 1)); sa2 = fadd_s(sa2, PEL(P0, P1, 4 * (i) + 2)); sa3 = fadd_s(sa3, PEL(P0, P1, 4 * (i) + 3)); \
            PIN(sa0); PIN(sa1); PIN(sa2); PIN(sa3); \
            pw[(i) >> 1][((i) & 1) * 2] = cvtpk(PEL(P0, P1, 4 * (i)), PEL(P0, P1, 4 * (i) + 1)); pw[(i) >> 1][((i) & 1) * 2 + 1] = cvtpk(PEL(P0, P1, 4 * (i) + 2), PEL(P0, P1, 4 * (i) + 3)); \
            PIN(pw[(i) >> 1]); \
            if ((i) < 4) kf[(i) & 3] = *(const LAS bf16x8*)(Kc_ + KOFF(((i) & 3) + 4)); \
            SBAR(); } while (0)
#define AP_GB(i, C0, C1, LOADK) do { \
            o[(i) & 3] = MF(__builtin_bit_cast(bf16x8, pw[(i) >> 2]), VF((i) & 7), o[(i) & 3]); \
            if ((i) < 8) { C0[(2 * (i)) & 15] = __builtin_amdgcn_exp2f(C0[(2 * (i)) & 15]); C0[(2 * (i) + 1) & 15] = __builtin_amdgcn_exp2f(C0[(2 * (i) + 1) & 15]); PIN(C0); } \
            else { C1[(2 * (i)) & 15] = __builtin_amdgcn_exp2f(C1[(2 * (i)) & 15]); C1[(2 * (i) + 1) & 15] = __builtin_amdgcn_exp2f(C1[(2 * (i) + 1) & 15]); PIN(C1); } \
            if ((i) + 7 < 16) { vl[((i) + 7) & 7] = tr16(Vb_ + VOFF(((i) + 7) & 15)); vh[((i) + 7) & 7] = tr16(Vb_ + VOFF(((i) + 7) & 15) + 512); } \
            if ((i) >= 8 && (i) < 12 && (LOADK)) kf[(i) & 3] = *(const LAS bf16x8*)(Kn_ + KOFF((i) & 3)); \
            if ((i) == 12 && tq_ + 3 < NT) DMA_K1(tq_ + 3, 0); if ((i) == 13 && tq_ + 3 < NT) DMA_K1(tq_ + 3, 1);     \
            if ((i) == 14 && tq_ + 1 < NT) DMA_V1(tq_ + 1, 0); if ((i) == 15 && tq_ + 1 < NT) DMA_V1(tq_ + 1, 1); \
            SBAR(); } while (0)
#define AP_STEP(C0, C1, P0, P1, vslot, kslot, LOADK, TQ) do { const int tq_ = (TQ); \
        const LAS unsigned char* Vb_ = Vl + (vslot) * 16384; const LAS unsigned char* Kn_ = Kl + (kslot) * 16384; const LAS unsigned char* Kc_ = Kl + (((kslot) + 3) & 3) * 16384; \
        float sa0 = 0.f, sa1 = 0.f, sa2 = 0.f, sa3 = 0.f; \
        SBAR(); PBS2(); \
        AP_GA(0, C0, C1, P0, P1); AP_GA(1, C0, C1, P0, P1); AP_GA(2, C0, C1, P0, P1); AP_GA(3, C0, C1, P0, P1); \
        AP_GA(4, C0, C1, P0, P1); AP_GA(5, C0, C1, P0, P1); AP_GA(6, C0, C1, P0, P1); AP_GA(7, C0, C1, P0, P1); \
        lacc += (sa0 + sa1) + (sa2 + sa3); PBE2(2); \
        AP_GB(0, C0, C1, LOADK); AP_GB(1, C0, C1, LOADK); AP_GB(2, C0, C1, LOADK); AP_GB(3, C0, C1, LOADK); \
        AP_GB(4, C0, C1, LOADK); AP_GB(5, C0, C1, LOADK); AP_GB(6, C0, C1, LOADK); AP_GB(7, C0, C1, LOADK); \
        AP_GB(8, C0, C1, LOADK); AP_GB(9, C0, C1, LOADK); AP_GB(10, C0, C1, LOADK); AP_GB(11, C0, C1, LOADK); \
        AP_GB(12, C0, C1, LOADK); AP_GB(13, C0, C1, LOADK); AP_GB(14, C0, C1, LOADK); AP_GB(15, C0, C1, LOADK); PBE2(3); \
    } while (0)
#define AP_DRAIN(P0, P1, vslot) do { \
        const LAS unsigned char* Vb_ = Vl + (vslot) * 16384; \
        float sacc = 0.f; \
        _Pragma("unroll") for (int r = 0; r < 16; ++r) sacc += P0[r] + P1[r]; \
        lacc += sacc; \
        pw[0] = (u32x4){cvtpk(P0[0], P0[1]), cvtpk(P0[2], P0[3]), cvtpk(P0[4], P0[5]), cvtpk(P0[6], P0[7])}; \
        pw[1] = (u32x4){cvtpk(P0[8], P0[9]), cvtpk(P0[10], P0[11]), cvtpk(P0[12], P0[13]), cvtpk(P0[14], P0[15])}; \
        pw[2] = (u32x4){cvtpk(P1[0], P1[1]), cvtpk(P1[2], P1[3]), cvtpk(P1[4], P1[5]), cvtpk(P1[6], P1[7])}; \
        pw[3] = (u32x4){cvtpk(P1[8], P1[9]), cvtpk(P1[10], P1[11]), cvtpk(P1[12], P1[13]), cvtpk(P1[14], P1[15])}; \
        _Pragma("unroll") for (int i = 0; i < 4; ++i) { vl[i] = tr16(Vb_ + VOFF(i)); vh[i] = tr16(Vb_ + VOFF(i) + 512); } \
        SBAR(); \
        _Pragma("unroll") for (int i = 0; i < 16; ++i) { \
            if (i + 4 < 16) { vl[(i + 4) & 7] = tr16(Vb_ + VOFF(i + 4)); vh[(i + 4) & 7] = tr16(Vb_ + VOFF(i + 4) + 512); } \
            o[i & 3] = MF(__builtin_bit_cast(bf16x8, pw[i >> 2]), VF(i & 7), o[i & 3]); \
            SBAR(); } \
    } while (0)
    int vsl = 0, ksl = 2;
    for (int t = 1; t < NT; t += 2) {
        AP_STEP(pB0, pB1, pA0, pA1, vsl, ksl, true, t);
        AP_WAITN(t);
        vsl = (vsl == 2) ? 0 : vsl + 1; ksl = (ksl + 1) & 3;
        AP_STEP(pA0, pA1, pB0, pB1, vsl, ksl, (t + 2 < NT), t + 1);
        AP_WAITN(t + 1);
        vsl = (vsl == 2) ? 0 : vsl + 1; ksl = (ksl + 1) & 3;
    }
    if (qs < 2) {
#pragma unroll
        for (int r = 0; r < 16; ++r) { pA0[r] = 0.f; pA1[r] = 0.f; }
    }
    AP_DRAIN(pA0, pA1, vsl);
    AP_BAR();
#ifdef PROBE_BARW
    if (blockIdx.x == PROBE_BLK && tid == PROBE_WAVE * 64) { g_barw[0] += pb_wait; g_barw[1] += __builtin_amdgcn_s_memtime() - pb_t0; }
#endif
#undef AP_STEP
#undef AP_DRAIN
#undef AP_ISSUE
#undef AP_WAITN
#undef DMA_K
#undef DMA_V
    if (a < 12) {
        if (tid == 0) { const unsigned* lt = (const unsigned*)(p.ws + WS_CTL) + CW_LATE; while (__hip_atomic_load(lt, __ATOMIC_RELAXED, __HIP_MEMORY_SCOPE_AGENT) < 24u) __builtin_amdgcn_s_sleep(8); }
        __syncthreads();
        __builtin_amdgcn_fence(__ATOMIC_ACQUIRE, "agent");
        asm volatile("s_waitcnt vmcnt(0)" ::: "memory");
    }
    const size_t erow0 = (size_t)(NMETA + 128 * a + 32 * qs);
    u32x4 gq[4];
#pragma unroll
    for (int k = 0; k < 4; ++k) { const int pi = lane + 64 * k; gq[k] = *(const u32x4*)((const bf16*)(p.ws + WS_SGB) + (erow0 + (pi >> 3)) * 512 + h * 128 + c * 64 + (pi & 7) * 8); }
    const int eb = c * 64 + r32;
    const float swa = p.in[23][eb] * ONE_M_LAM0, swb = p.in[23][eb + 32] * ONE_M_LAM0;
    lacc += __shfl_xor(lacc, 32);
    LAS float* wsf = (LAS float*)(lds + LCTL + 256) + wid * 64;
    if (hi == 0) wsf[r32] = lacc;
    asm volatile("s_waitcnt lgkmcnt(0)" ::: "memory");
    float rli[16];
#pragma unroll
    for (int r = 0; r < 16; ++r) rli[r] = __builtin_amdgcn_rcpf(wsf[crow(r, hi)]);
    LAS float* XW = (LAS float*)lds + (qs * 2 + c) * 2048;
    const LAS float* XR = (const LAS float*)lds + (qs * 2 + (c ^ 1)) * 2048;
    LAS float* SS = (LAS float*)(lds + 65536);
    const float fsc = (c == 0) ? 1.0f : lam;
#define EP_WRITE(OA, OB) do { _Pragma("unroll") for (int r = 0; r < 16; ++r) { XW[r * 64 + lane] = fsc * (OA[r] * rli[r]); XW[(16 + r) * 64 + lane] = fsc * (OB[r] * rli[r]); } } while (0)
    if (c == 0) EP_WRITE(o[2], o[3]); else EP_WRITE(o[0], o[1]);
#undef EP_WRITE
    __syncthreads();
#define EP_COMB(OA, OB, SGN) do { _Pragma("unroll") for (int r = 0; r < 16; ++r) { \
            const float va = SGN * (fsc * (OA[r] * rli[r]) - XR[r * 64 + lane]), vb = SGN * (fsc * (OB[r] * rli[r]) - XR[(16 + r) * 64 + lane]); \
            OA[r] = va; OB[r] = vb; const float s_ = half_sum_hi16(va * va + vb * vb); \
            if (r32 == 16) SS[(qs * 2 + c) * 32 + crow(r, hi)] = s_; } } while (0)
    if (c == 0) EP_COMB(o[0], o[1], 1.0f); else EP_COMB(o[2], o[3], -1.0f);
#undef EP_COMB
    __syncthreads();
    {
        LAS unsigned char* GT = lds + 66560 + wid * 8192;
        LAS unsigned char* YT = GT + 4096;
#pragma unroll
        for (int k = 0; k < 4; ++k) { const int pi = lane + 64 * k; *(LAS u32x4*)(GT + (pi >> 3) * 128 + (pi & 7) * 16) = gq[k]; }
        asm volatile("s_waitcnt lgkmcnt(0)" ::: "memory");
#define EP_FIN(OA, OB) do { _Pragma("unroll") for (int r = 0; r < 16; ++r) { \
            const int q_ = crow(r, hi); \
            const float s_ = SS[(qs * 2) * 32 + q_] + SS[(qs * 2 + 1) * 32 + q_]; \
            const float rinv = __builtin_amdgcn_rsqf(s_ * (1.0f / 128.0f) + EPS); \
            const float ga_ = bf2f(*(const LAS bf16*)(GT + q_ * 128 + r32 * 2)), gb_ = bf2f(*(const LAS bf16*)(GT + q_ * 128 + 64 + r32 * 2)); \
            *(LAS bf16*)(YT + q_ * 128 + r32 * 2) = f2bf(((OA[r] * rinv) * swa) * ga_); \
            *(LAS bf16*)(YT + q_ * 128 + 64 + r32 * 2) = f2bf(((OB[r] * rinv) * swb) * gb_); } } while (0)
        if (c == 0) EP_FIN(o[0], o[1]); else EP_FIN(o[2], o[3]);
#undef EP_FIN
        asm volatile("s_waitcnt lgkmcnt(0)" ::: "memory");
        bf16* YCAT = (bf16*)(p.ws + WS_YCAT);
#pragma unroll
        for (int k = 0; k < 4; ++k) { const int pi = lane + 64 * k;
            *(u32x4*)(YCAT + (erow0 - NMETA + (pi >> 3)) * 1024 + 512 + h * 128 + c * 64 + (pi & 7) * 8) = *(const LAS u32x4*)(YT + (pi >> 3) * 128 + (pi & 7) * 16); }
    }
    __syncthreads();
}

#ifdef PROBE_SAMP
__device__ unsigned long long g_samp[2];
#endif
__global__ void __launch_bounds__(NTHREADS, 2) mega_fwd(Params p) {
    extern __shared__ __attribute__((aligned(16))) unsigned char lds_raw[];
    LAS unsigned char* lds = (LAS unsigned char*)lds_raw;
    const int tid = threadIdx.x;
    unsigned* ctl = (unsigned*)(p.ws + WS_CTL);
    if (tid < 64) ((LAS unsigned*)(lds + LCTL))[tid] = 0u;
    __syncthreads();
    XcdBarrier bar = xcd_barrier_post(ctl + CW_BAR, (volatile LAS unsigned*)(lds + LCTL + 64));
#define GRID_BAR() xcd_barrier(bar)
#ifdef PROBE_TIME
    unsigned long long ts_[8];
#define STAMP(i) ts_[i] = __builtin_amdgcn_s_memrealtime()
#else
#define STAMP(i) do {} while (0)
#endif
    STAMP(0);
#ifdef PROBE_SAMP
    if (blockIdx.x == 0 && tid == 0) __hip_atomic_store(&g_samp[0], 0ull, __ATOMIC_RELAXED, __HIP_MEMORY_SCOPE_AGENT);
#endif

#ifdef PROBE_ALLX2
    for (int it_ = 0; it_ < 2; ++it_) {
    if (it_) GRID_BAR();
#else
    { const int it_ = 0;
#endif
#ifndef NO_P0
    phase0(p, lds);
#ifdef PROBE_P0X2
    __syncthreads();
    phase0(p, lds);
#endif
#endif
    GRID_BAR();
    STAMP(1);

#ifndef NO_P1
    {
        pg8::Gemm g{(const pg8::bf16_t*)(p.ws + WS_XN), (const pg8::bf16_t*)(p.ws + WS_W1T), MPAD, DIN, DM};
        P1Order S; S.init((int)gridDim.x, (int)blockIdx.x);
        EpiIn E{p.out, p.ws, p.in[17], p.in[18]};
        pg8::gemm_phase<EpiIn, P1Order, true, true>(lds, g, S, E);
#ifdef PROBE_P1X2
        __syncthreads();
        pg8::gemm_phase<EpiIn, pg8::StaticOrder, true, true>(lds, g, S, E);
#endif
    }
#endif
    GRID_BAR();
    STAMP(2);

#ifndef NO_P1
    for (int k = blockIdx.x; k < 24; k += gridDim.x) {
        pg8::Gemm g{(const pg8::bf16_t*)(p.ws + WS_XN), (const pg8::bf16_t*)(p.ws + WS_W1T), MPAD, DIN, DM};
        OneUnit S{k >> 2, late_pn(k & 3)};
        EpiIn E{p.out, p.ws, p.in[17], p.in[18]};
        pg8::gemm_phase<EpiIn, OneUnit, false, true>(lds, g, S, E);
        asm volatile("s_waitcnt vmcnt(0)" ::: "memory");
        __syncthreads();
        if (tid == 0) { __builtin_amdgcn_fence(__ATOMIC_RELEASE, "agent"); asm volatile("s_waitcnt vmcnt(0)" ::: "memory");
                        __hip_atomic_fetch_add(ctl + CW_LATE + 64 * it_, 1u, __ATOMIC_RELAXED, __HIP_MEMORY_SCOPE_AGENT); }
        __syncthreads();
    }
#endif
    STAMP(2);
#ifndef NO_LRU
    const int lru_b0 = (int)gridDim.x >> 1, lru_nb = (int)gridDim.x - lru_b0;
    if ((int)blockIdx.x >= lru_b0)
    for (int idx = (int)blockIdx.x - lru_b0; idx < N_LRU; idx += lru_nb) {
        if (idx < N_LRU_P) lru_chunk<0>(p, lds, idx);
        else {
            lru_chunk<1>(p, lds, idx);
            asm volatile("s_waitcnt vmcnt(0)" ::: "memory");
            __syncthreads();
            if (tid == 0) { __builtin_amdgcn_fence(__ATOMIC_RELEASE, "agent"); asm volatile("s_waitcnt vmcnt(0)" ::: "memory");
                            __hip_atomic_fetch_add(ctl + CW_SAMPDONE + 64 * it_, 1u, __ATOMIC_RELAXED, __HIP_MEMORY_SCOPE_AGENT); }
        }
    }
    if ((int)blockIdx.x >= lru_b0 && (int)blockIdx.x - lru_b0 < N_LRU_P) lru_arrive(p, lds, it_, lru_nb < N_LRU_P ? lru_nb : N_LRU_P);
    __syncthreads();
#endif
    STAMP(3);
    {
        float d1 = 0.f, d2 = 0.f, mq = 0.f, mk = 0.f;
        for (int i = 0; i < 64; ++i) { d1 += p.in[19][i] * p.in[20][i]; d2 += p.in[21][i] * p.in[22][i]; mq = fmaxf(mq, fabsf(p.in[17][i])); mk = fmaxf(mk, fabsf(p.in[18][i])); }
        const float lam = expf(d1) - expf(d2) + LAM0;
        const float negm = -(8.0f * mq * mk) * LOG2E;
        volatile LAS unsigned* qw = (volatile LAS unsigned*)(lds + LCTL);
        bool carry_ok = false;
        int kq = 0;
        for (;;) {
            if (tid == 0) {
                unsigned code = 0xffffffffu;
                while (kq < 4) {
                    const unsigned hq = (blockIdx.x + (unsigned)kq) & 3u;
                    const unsigned ix = atomicAdd(&ctl[CW_QH + 64 * hq + 512 * it_], 1u);
                    if (ix < 144u) { code = 0x80000000u | (hq << 16) | ix; break; }
                    ++kq;
                }
                if (kq >= 4) code = (unsigned)N_ATT + atomicAdd(&ctl[CW_Q + 128 * it_], 1u);
                qw[0] = code;
            }
            __syncthreads();
            const unsigned code = qw[0];
            __syncthreads();
#ifndef NO_ATT
            if (code & 0x80000000u) {
                const int hq = (int)((code >> 16) & 3u), ix = (int)(code & 0xffffu);
                if (ix >= 32 && ix < 48) {
#ifdef PROBE_SAMP
                    const unsigned long long tsa_ = __builtin_amdgcn_s_memrealtime();
#endif
                    attn_sample(p, lds, ix - 32, hq, negm, lam);
#ifdef PROBE_SAMP
                    if (tid == 0) atomicAdd(&g_samp[0], __builtin_amdgcn_s_memrealtime() - tsa_);
#endif
                    asm volatile("s_waitcnt vmcnt(0)" ::: "memory");
                    __syncthreads();
                    if (tid == 0) { __builtin_amdgcn_fence(__ATOMIC_RELEASE, "agent"); asm volatile("s_waitcnt vmcnt(0)" ::: "memory");
                                    __hip_atomic_fetch_add(ctl + CW_SAMPDONE + 64 * it_, 1u, __ATOMIC_RELAXED, __HIP_MEMORY_SCOPE_AGENT); }
                } else attn_prompt(p, lds, (ix < 32) ? 127 - ix : 127 - (ix - 16), hq, negm, lam);
                continue;
            }
#endif
            const int idx = (int)code;
            if (idx >= N_P2) break;
            if (idx < N_ATT + N_SGEMM) {
                if (tid == 0) { while (__hip_atomic_load(ctl + CW_SAMPDONE + 64 * it_, __ATOMIC_RELAXED, __HIP_MEMORY_SCOPE_AGENT) < 80u) __builtin_amdgcn_s_sleep(8); }
                __syncthreads();
                __builtin_amdgcn_fence(__ATOMIC_ACQUIRE, "agent");
                asm volatile("s_waitcnt vmcnt(0)" ::: "memory");
                __syncthreads();
                pg8::Gemm g{(const pg8::bf16_t*)(p.ws + WS_YCAT), (const pg8::bf16_t*)(p.ws + WS_W2T), 16640, DM, DM};
                OneUnit S{64, idx - N_ATT};
                EpiOut E{p.out, p.in[0], p.in[1]};
                pg8::gemm_phase<EpiOut, OneUnit, false, true>(lds, g, S, E);
                __syncthreads();
            } else {
#ifndef NO_LRU
                if (!carry_ok) {
                    if (tid == 0) { while (__hip_atomic_load(ctl + CW_CARRYOK + 64 * it_, __ATOMIC_RELAXED, __HIP_MEMORY_SCOPE_AGENT) == 0u) __builtin_amdgcn_s_sleep(8);
                                    while (__hip_atomic_load(ctl + CW_LATE + 64 * it_, __ATOMIC_RELAXED, __HIP_MEMORY_SCOPE_AGENT) < 24u) __builtin_amdgcn_s_sleep(8); }
                    __syncthreads();
                    __builtin_amdgcn_fence(__ATOMIC_ACQUIRE, "agent");
                    asm volatile("s_waitcnt vmcnt(0)" ::: "memory");
                    carry_ok = true;
                }
                lru_pass2(p, idx - N_ATT - N_SGEMM);
#endif
            }
        }
    }
    GRID_BAR();
    STAMP(4);
    STAMP(5);

#ifndef NO_P4
    {
        pg8::Gemm g{(const pg8::bf16_t*)(p.ws + WS_YCAT), (const pg8::bf16_t*)(p.ws + WS_W2T), 16384, DM, DM};
        pg8::StaticOrder S; S.init(16384, DM, (int)gridDim.x, (int)blockIdx.x);
        EpiOut E{p.out, p.in[0], p.in[1]};
        pg8::gemm_phase<EpiOut, pg8::StaticOrder, true, true>(lds, g, S, E);
#ifdef PROBE_P4X2
        __syncthreads();
        pg8::gemm_phase<EpiOut, pg8::StaticOrder, true, true>(lds, g, S, E);
#endif
    }
#endif
    }
#ifdef PROBE_TIME
    STAMP(6);
    if (blockIdx.x == 0) {
        __syncthreads();
#ifdef PROBE_BARW
        const float T_us = 1000.0f * (float)g_barw[0] / (float)(g_barw[1] + 1ull);
#else
#ifdef PROBE_SAMP
        const float T_us = (float)__hip_atomic_load(&g_samp[0], __ATOMIC_RELAXED, __HIP_MEMORY_SCOPE_AGENT) * 0.01f * (1.0f / 64.0f);
#else
        const float T_us = (float)(ts_[PROBE_B] - ts_[PROBE_A]) * 0.01f;
#endif
#endif
#ifndef PROBE_SCALE
#define PROBE_SCALE 1e-7f
#endif
        const float dl = sqrtf(1e-5f + T_us * PROBE_SCALE);
        for (int i = tid; i < 24576; i += NTHREADS) p.out[O_CS + i] *= (1.0f + dl);
    }
#endif
}

extern "C" void kernel_launch(void* const* d_in, const int* in_sizes, int n_in, void* d_out, int out_size, void* d_ws, size_t ws_size, hipStream_t stream) {
    static int grid = 0;
    if (grid == 0) {
        if (n_in != 24 || out_size != (int)O_END || ws_size < WS_END) { fprintf(stderr, "kernel_launch: unexpected shapes (n_in %d out %d ws %zu)\n", n_in, out_size, ws_size); grid = -1; return; }
        int dev = 0, cus = 0, per_cu = 0;
        hipGetDevice(&dev);
        hipDeviceGetAttribute(&cus, hipDeviceAttributeMultiprocessorCount, dev);
        hipFuncSetAttribute((const void*)mega_fwd, hipFuncAttributeMaxDynamicSharedMemorySize, LDS_BYTES);
        hipOccupancyMaxActiveBlocksPerMultiprocessor(&per_cu, (const void*)mega_fwd, NTHREADS, LDS_BYTES);
        if (per_cu < 1) { fprintf(stderr, "kernel_launch: occupancy query says %d blocks/CU\n", per_cu); per_cu = 1; }
        (void)hipGetLastError();
        grid = cus;
    }
    if (grid < 0) return;
    hipMemsetAsync((char*)d_ws + WS_CTL, 0, CTL_ZERO_BYTES, stream);
    Params prm{};
    for (int i = 0; i < 24; ++i) prm.in[i] = (const float*)d_in[i];
    prm.out = (float*)d_out; prm.ws = (unsigned char*)d_ws;
    void* args[] = {&prm};
    hipError_t e = hipLaunchCooperativeKernel((const void*)mega_fwd, dim3(grid), dim3(NTHREADS), args, LDS_BYTES, stream);
    if (e != hipSuccess) fprintf(stderr, "cooperative launch failed: %s (grid %d)\n", hipGetErrorString(e), grid);
}
```

```cpp
#include <hip/hip_runtime.h>
#include <cstdio>
#include <cstdint>

namespace pg8 {
#define PG8_LAS __attribute__((address_space(3)))
typedef unsigned short bf16_t;
typedef short bf16x8 __attribute__((ext_vector_type(8)));
typedef float f32x4 __attribute__((ext_vector_type(4)));
typedef unsigned u32x4 __attribute__((ext_vector_type(4)));
constexpr int BM = 256, BK = 64, HALF = 128, HTB = HALF * BK * 2  , STAGE_BYTES = 8 * HTB, NXCD = 8, WGM = 8;

__host__ __device__ __forceinline__ int lds_byte(int r, int c) { const int st = (r >> 4) * 2 + (c >> 5), rr = r & 15, cc = c & 31, ob = rr * 64 + cc * 2; return st * 1024 + (ob ^ (((ob >> 9) & 1) << 5)); }
__host__ __device__ __forceinline__ void stage_rc(int b, int& R, int& C) { const int st = b / 1024, sb = b % 1024, swz = sb ^ (((sb >> 9) & 1) << 5); R = (st >> 1) * 16 + swz / 64; C = (st & 1) * 32 + (swz % 64) / 2; }
__host__ __device__ __forceinline__ int perm32(int rho) { const int n = rho >> 4, i = rho & 15; return 8 * (i >> 2) + 4 * n + (i & 3); }

struct Unit { int pm, pn; };
struct Gemm { const bf16_t* A; const bf16_t* Bt; int M, N, K; };

struct StaticOrder {
    int nM, nN, nwg, G, c;
    __host__ __device__ void init(int M, int N, int G_, int c_) { nM = M / BM; nN = N / BM; nwg = nM * nN; G = G_; c = c_; }
    __host__ __device__ bool next(int i, Unit& u) const {
        const long L = (long)i * G + c; if (L >= nwg) return false;
        int wgid = (int)L; { const int q = nwg / NXCD, r = nwg % NXCD, xcd = wgid % NXCD, off = wgid / NXCD; wgid = (xcd < r ? xcd * (q + 1) : r * (q + 1) + (xcd - r) * q) + off; }
        const int nig = WGM * nN, gid = wgid / nig, fm = gid * WGM, gsz = (nM - fm) < WGM ? (nM - fm) : WGM;
        u.pm = fm + ((wgid % nig) % gsz); u.pn = (wgid % nig) / gsz; return true;
    }
    __device__ __forceinline__ void a_ready(const Unit&) const {}
    __device__ __forceinline__ void done(const Unit&) const {}
};

template <class Epi, class Sched, bool ALIGN_EPI = false, bool SP2 = false>
__device__ __forceinline__ void gemm_phase(PG8_LAS unsigned char* lds, const Gemm g, const Sched& S, const Epi& E) {
    int tid_ = threadIdx.x; asm volatile("" : "+v"(tid_));
    const int tid = tid_, wid = __builtin_amdgcn_readfirstlane(tid >> 6), lane = tid & 63, wr = wid >> 2, wc = wid & 3, fr = lane & 15, fq = lane >> 4;
    const int K = g.K, nt = K / BK;
    unsigned voffA[2], voffB[2];
#pragma unroll
    for (int i = 0; i < 2; ++i) { int R, C; stage_rc(tid * 16 + i * 8192, R, C); const int Rb = Epi::PERM ? ((R & ~31) + perm32(R & 31)) : R;
        voffA[i] = (unsigned)(R * K + C) * 2u; voffB[i] = (unsigned)(Rb * K + C) * 2u; }
    const size_t kstep = (size_t)(BK * 2);
    const size_t hstep = (size_t)HALF * K * 2;
    const size_t tstep = 2 * hstep;
    const unsigned ldsw = (unsigned)wid * 1024u;
    const int aoff = lds_byte(wr * 64 + fr, fq * 8), boff = lds_byte(wc * 32 + fr, fq * 8);
#define PG8_SA(b, h) (((b) * 2 + (h)) * HTB)
#define PG8_SB(b, h) ((4 + (b) * 2 + (h)) * HTB)
#define PG8_STAGE(bufoff, gbase, voff) do { _Pragma("unroll") for (int _i = 0; _i < 2; ++_i) \
        __builtin_amdgcn_global_load_lds((const unsigned*)((const char*)(gbase) + (voff)[_i]), (PG8_LAS unsigned*)(lds + (bufoff) + ldsw + _i * 8192), 16, 0, 0); } while (0)
#define PG8_LDA(dst, b, h) do { _Pragma("unroll") for (int m = 0; m < 4; ++m) _Pragma("unroll") for (int k = 0; k < 2; ++k) dst[m][k] = *(const PG8_LAS bf16x8*)(lds + PG8_SA(b, h) + aoff + m * 2048 + k * 1024); } while (0)
#define PG8_LDB(dst, b, h) do { _Pragma("unroll") for (int n = 0; n < 2; ++n) _Pragma("unroll") for (int k = 0; k < 2; ++k) dst[n][k] = *(const PG8_LAS bf16x8*)(lds + PG8_SB(b, h) + boff + n * 2048 + k * 1024); } while (0)
#define PG8_MMA(ai, bj, At, Bt) do { __builtin_amdgcn_s_setprio(1); _Pragma("unroll") for (int m = 0; m < 4; ++m) _Pragma("unroll") for (int n = 0; n < 2; ++n) _Pragma("unroll") for (int k = 0; k < 2; ++k) \
        acc[ai][bj][m][n] = __builtin_amdgcn_mfma_f32_16x16x32_bf16(Bt[n][k], At[m][k], acc[ai][bj][m][n], 0, 0, 0); __builtin_amdgcn_s_setprio(0); } while (0)
#define PG8_WAIT_V(n) asm volatile("s_waitcnt vmcnt(" #n ")" ::: "memory")
#define PG8_WAIT_L(n) asm volatile("s_waitcnt lgkmcnt(" #n ")" ::: "memory")
#define PG8_BAR __builtin_amdgcn_s_barrier()
#define PG8_SCHED __builtin_amdgcn_sched_barrier(0)
    Unit cur, nxt; int ui = 0;
    if (!S.next(0, cur)) return;
    f32x4 acc[2][2][4][2];
#pragma unroll
    for (int a = 0; a < 2; ++a)
#pragma unroll
        for (int b = 0; b < 2; ++b)
#pragma unroll
            for (int m = 0; m < 4; ++m)
#pragma unroll
                for (int n = 0; n < 2; ++n) acc[a][b][m][n] = (f32x4){0.f, 0.f, 0.f, 0.f};
    bf16x8 At[4][2], B0[2][2], B1[2][2];
    const char* cA = (const char*)g.A + (size_t)cur.pm * tstep; const char* cB = (const char*)g.Bt + (size_t)cur.pn * tstep;
    S.a_ready(cur);
    if constexpr (SP2) {
        PG8_STAGE(PG8_SB(0, 0), cB, voffB); PG8_STAGE(PG8_SB(0, 1), cB + hstep, voffB); PG8_STAGE(PG8_SA(0, 0), cA, voffA); PG8_STAGE(PG8_SA(0, 1), cA + hstep, voffA);
        if (wr == 1) PG8_BAR;
        PG8_WAIT_V(2); PG8_BAR;
        PG8_STAGE(PG8_SB(1, 0), cB + kstep, voffB); PG8_STAGE(PG8_SA(1, 0), cA + kstep, voffA); PG8_STAGE(PG8_SB(1, 1), cB + hstep + kstep, voffB);
        PG8_WAIT_V(6); PG8_BAR;
    } else {
        PG8_STAGE(PG8_SB(0, 0), cB, voffB); PG8_STAGE(PG8_SA(0, 0), cA, voffA); PG8_STAGE(PG8_SB(0, 1), cB + hstep, voffB); PG8_STAGE(PG8_SA(0, 1), cA + hstep, voffA);
        if (wr == 1) PG8_BAR;
        PG8_WAIT_V(4); PG8_BAR;
        PG8_STAGE(PG8_SB(1, 0), cB + kstep, voffB); PG8_STAGE(PG8_SA(1, 0), cA + kstep, voffA); PG8_STAGE(PG8_SB(1, 1), cB + hstep + kstep, voffB);
        PG8_WAIT_V(6); PG8_BAR;
    }
    for (;;) {
        const bool has_next = S.next(ui + 1, nxt);
        const char* nA = has_next ? (const char*)g.A + (size_t)nxt.pm * tstep : cA; const char* nB = has_next ? (const char*)g.Bt + (size_t)nxt.pn * tstep : cB;
        for (int t = 0; t < nt; t += 2) {
            const bool last = (t == nt - 2);
            const char* a1 = cA + (size_t)(t + 1) * kstep;
            const char* a2 = last ? nA : cA + (size_t)(t + 2) * kstep; const char* b2 = last ? nB : cB + (size_t)(t + 2) * kstep;
            const char* a3 = a2 + kstep; const char* b3 = b2 + kstep;
            if (last && has_next) S.a_ready(nxt);
            if constexpr (SP2) {
            PG8_LDB(B0, 0, 0); PG8_LDB(B1, 0, 1); PG8_SCHED; PG8_LDA(At, 0, 0); PG8_STAGE(PG8_SA(1, 1), a1 + hstep, voffA);
            PG8_WAIT_V(8); PG8_WAIT_L(0); PG8_BAR; PG8_MMA(0, 0, At, B0); PG8_MMA(0, 1, At, B1); PG8_BAR; PG8_SCHED;
            PG8_LDA(At, 0, 1); PG8_STAGE(PG8_SB(0, 0), b2, voffB); PG8_STAGE(PG8_SB(0, 1), b2 + hstep, voffB); PG8_STAGE(PG8_SA(0, 0), a2, voffA);
            PG8_WAIT_V(8); PG8_WAIT_L(0); PG8_BAR; PG8_MMA(1, 0, At, B0); PG8_MMA(1, 1, At, B1); PG8_BAR; PG8_SCHED;
            PG8_LDB(B0, 1, 0); PG8_LDB(B1, 1, 1); PG8_SCHED; PG8_LDA(At, 1, 0); PG8_STAGE(PG8_SA(0, 1), a2 + hstep, voffA);
            PG8_WAIT_V(8); PG8_WAIT_L(0); PG8_BAR; PG8_MMA(0, 0, At, B0); PG8_MMA(0, 1, At, B1); PG8_BAR; PG8_SCHED;
            PG8_LDA(At, 1, 1); PG8_STAGE(PG8_SB(1, 0), b3, voffB); PG8_STAGE(PG8_SB(1, 1), b3 + hstep, voffB); PG8_STAGE(PG8_SA(1, 0), a3, voffA);
            PG8_WAIT_V(8); PG8_WAIT_L(0); PG8_BAR; PG8_MMA(1, 0, At, B0); PG8_MMA(1, 1, At, B1); PG8_BAR; PG8_SCHED;
            } else {
            PG8_LDB(B0, 0, 0); PG8_SCHED; PG8_LDA(At, 0, 0); PG8_STAGE(PG8_SA(1, 1), a1 + hstep, voffA);
            PG8_WAIT_L(8); PG8_BAR; PG8_WAIT_L(0); PG8_MMA(0, 0, At, B0); PG8_BAR; PG8_SCHED;
            PG8_LDB(B1, 0, 1); PG8_STAGE(PG8_SB(0, 0), b2, voffB);
            PG8_BAR; PG8_WAIT_L(0); PG8_MMA(0, 1, At, B1); PG8_BAR;
            PG8_LDA(At, 0, 1); PG8_STAGE(PG8_SA(0, 0), a2, voffA);
            PG8_BAR; PG8_WAIT_L(0); PG8_MMA(1, 0, At, B0); PG8_BAR; PG8_SCHED;
            PG8_STAGE(PG8_SB(0, 1), b2 + hstep, voffB);
            PG8_WAIT_V(6); PG8_BAR; PG8_MMA(1, 1, At, B1); PG8_BAR;
            PG8_LDB(B0, 1, 0); PG8_SCHED; PG8_LDA(At, 1, 0); PG8_STAGE(PG8_SA(0, 1), a2 + hstep, voffA);
            PG8_WAIT_L(8); PG8_BAR; PG8_WAIT_L(0); PG8_MMA(0, 0, At, B0); PG8_BAR; PG8_SCHED;
            PG8_LDB(B1, 1, 1); PG8_STAGE(PG8_SB(1, 0), b3, voffB);
            PG8_BAR; PG8_WAIT_L(0); PG8_MMA(0, 1, At, B1); PG8_BAR;
            PG8_LDA(At, 1, 1); PG8_STAGE(PG8_SA(1, 0), a3, voffA);
            PG8_BAR; PG8_WAIT_L(0); PG8_MMA(1, 0, At, B0); PG8_BAR; PG8_SCHED;
            PG8_STAGE(PG8_SB(1, 1), b3 + hstep, voffB);
            PG8_WAIT_V(6); PG8_BAR; PG8_MMA(1, 1, At, B1); PG8_BAR;
            }
        }
        if constexpr (ALIGN_EPI) { if (wr == 0) PG8_BAR; }
        if constexpr (!Epi::AFTER_DRAIN) { E(acc, cur, wr, wc, fr, fq); S.done(cur); }
        if (!has_next) break;
#pragma unroll
        for (int a = 0; a < 2; ++a)
#pragma unroll
            for (int b = 0; b < 2; ++b)
#pragma unroll
                for (int m = 0; m < 4; ++m)
#pragma unroll
                    for (int n = 0; n < 2; ++n) acc[a][b][m][n] = (f32x4){0.f, 0.f, 0.f, 0.f};
        cur = nxt; cA = nA; cB = nB; ++ui;
        if constexpr (ALIGN_EPI) { if (wr == 1) PG8_BAR; }
    }
    PG8_WAIT_V(0);
    if constexpr (!ALIGN_EPI) { if (wr == 0) PG8_BAR; }
    PG8_BAR;
    if constexpr (Epi::AFTER_DRAIN) { E.fused(acc, cur, wr, wc, fr, fq, lds, wid, lane); S.done(cur); }
#undef PG8_SA
#undef PG8_SB
#undef PG8_STAGE
#undef PG8_LDA
#undef PG8_LDB
#undef PG8_MMA
#undef PG8_WAIT_V
#undef PG8_WAIT_L
#undef PG8_BAR
#undef PG8_SCHED
}
}

#define LAS __attribute__((address_space(3)))
typedef unsigned short bf16;
typedef short bf16x8 __attribute__((ext_vector_type(8)));
typedef short s16x4 __attribute__((ext_vector_type(4)));
typedef float f32x4 __attribute__((ext_vector_type(4)));
typedef float f32x16 __attribute__((ext_vector_type(16)));
typedef unsigned u32x4 __attribute__((ext_vector_type(4)));
typedef unsigned u32x2 __attribute__((ext_vector_type(2)));

constexpr int NTHREADS = 512;
constexpr int DM = 1024, NMETA = 16, TP = 16400, NSAMP = 256, MROWS = TP + NSAMP  , MPAD = 16896, PAST = 4096;
constexpr int DL = 512, DIN = 3072;
constexpr float EPS = 1e-6f;
constexpr float C2 = 0.18033688011112042f;
constexpr float LOG2E = 1.4426950408889634f;
constexpr float ONE_M_LAM0 = 0.8f, LAM0 = 0.2f;

constexpr size_t O_YP = 0, O_YS = 16777216, O_KP = 17039360, O_VP = 25436160, O_HP = 33832960, O_CP = 33833472,
                 O_KS = 33835008, O_VS = 33966080, O_HS = 34097152, O_CS = 34105344, O_END = 34129920;

constexpr size_t MiB = 1u << 20;
constexpr size_t WS_CTL = 0, WS_XN = 1 * MiB, WS_W1T = 35 * MiB, WS_W2T = 41 * MiB, WS_ROPE = 43 * MiB, WS_XA = 48 * MiB, WS_SGA = 82 * MiB,
                 WS_SGB = 99 * MiB, WS_QB = 116 * MiB, WS_KV = 133 * MiB  , WS_YCAT = 167 * MiB, WS_GWH = 201 * MiB  , WS_GWL = 202 * MiB, WS_SP = 203 * MiB  ,
                 WS_AT = 204 * MiB  , WS_BT = 237 * MiB, WS_SUMA = 271 * MiB, WS_SUMB = 273 * MiB, WS_CARRY = 275 * MiB, WS_END = 277 * MiB;
constexpr int CW_Q = 64, CW_LRUDONE = 256, CW_CARRYOK = 320, CW_SAMPDONE = 384, CW_QH = 1024, CW_LATE = 448, CW_BAR = 4096;
constexpr size_t CTL_ZERO_BYTES = 65536;
constexpr int LCTL = 147456;
constexpr int LDS_BYTES = LCTL + 4096;
constexpr int LRS = 516;

constexpr int LRU_CH = 32;
constexpr int N_LRU_P = (TP + LRU_CH - 1) / LRU_CH;
constexpr int N_LRU = N_LRU_P + 16;
constexpr int N_ATT = 512 + 64;
constexpr int N_SGEMM = 4;
constexpr int N_P2 = N_ATT + N_LRU_P;

struct Params { const float* in[24]; float* out; unsigned char* ws; };

__device__ __forceinline__ unsigned cvtpk(float lo, float hi) {
    typedef float f2 __attribute__((ext_vector_type(2))); typedef __bf16 b2 __attribute__((ext_vector_type(2)));
    f2 v = {lo, hi}; b2 b = __builtin_convertvector(v, b2); return __builtin_bit_cast(unsigned, b);
}
__device__ __forceinline__ float bf2f(bf16 v) { return __uint_as_float(((unsigned)v) << 16); }
__device__ __forceinline__ bf16 f2bf(float f) { return (bf16)(cvtpk(f, 0.f) & 0xffffu); }
__device__ __forceinline__ float half_sum_hi16(float v) {
    v += __builtin_bit_cast(float, __builtin_amdgcn_update_dpp(0, __builtin_bit_cast(int, v), 0xB1, 0xF, 0xF, true));
    v += __builtin_bit_cast(float, __builtin_amdgcn_update_dpp(0, __builtin_bit_cast(int, v), 0x4E, 0xF, 0xF, true));
    v += __builtin_bit_cast(float, __builtin_amdgcn_update_dpp(0, __builtin_bit_cast(int, v), 0x141, 0xF, 0xF, true));
    v += __builtin_bit_cast(float, __builtin_amdgcn_update_dpp(0, __builtin_bit_cast(int, v), 0x140, 0xF, 0xF, true));
    v += __builtin_bit_cast(float, __builtin_amdgcn_update_dpp(0, __builtin_bit_cast(int, v), 0x142, 0xA, 0xF, false));
    return v;
}
__device__ __forceinline__ float wave_sum(float v) {
#pragma unroll
    for (int o = 1; o < 64; o <<= 1) v += __shfl_xor(v, o);
    return v;
}
__device__ __forceinline__ int crow(int r, int hi) { return (r & 3) + 8 * (r >> 2) + 4 * hi; }
__device__ __forceinline__ float silu_f(float x) { return x * __builtin_amdgcn_rcpf(1.0f + __builtin_amdgcn_exp2f(-1.4426950408889634f * x)); }

#define XB_TMO      128
#define XB_XCNT(j)  (256  + 64 * (j))
#define XB_XSUB(j)  (1280 + 64 * (j))
#define XB_XGEN(j)  (2304 + 64 * (j))
#define XB_TOP      3328
#define XB_TOPGEN   3392
#define XCD_BAR_WORDS 3456
#define XB_SPIN_CAP (1u << 18)

__device__ __forceinline__ unsigned xb_ld(unsigned* p)              { return __hip_atomic_load(p, __ATOMIC_RELAXED, __HIP_MEMORY_SCOPE_AGENT); }
__device__ __forceinline__ unsigned xb_add(unsigned* p, unsigned v) { return __hip_atomic_fetch_add(p, v, __ATOMIC_RELAXED, __HIP_MEMORY_SCOPE_AGENT); }
__device__ __forceinline__ unsigned xb_xcc_id() { return (unsigned)__builtin_amdgcn_s_getreg((3 << 11) | 20) & 0xFu; }
#define XB_SPIN(cond, bar) do { unsigned _sp = 0; while (cond) { __builtin_amdgcn_s_sleep(1); \
    if ((++_sp & 255u) == 0u) { if (xb_ld(&(bar)[XB_TMO])) break; if (_sp > XB_SPIN_CAP) { atomicAdd(&(bar)[XB_TMO], 1u); break; } } } } while (0)

struct XcdBarrier {
    unsigned* bar; unsigned x;
    volatile LAS unsigned* st;
};

__device__ __forceinline__ XcdBarrier xcd_barrier_post(unsigned* bar, volatile LAS unsigned* st) {
    XcdBarrier b; b.bar = bar; b.x = xb_xcc_id(); b.st = st;
    if (threadIdx.x == 0) (void)xb_add(&bar[XB_XCNT(b.x)], 1u);
    return b;
}
__device__ __forceinline__ void xcd_barrier_complete(unsigned* bar, unsigned x, unsigned& nloc, unsigned& nx) {
    const unsigned G = gridDim.x * gridDim.y * gridDim.z;
    unsigned sum, cnt, mine, sp = 0u;
    for (;;) {
        sum = 0u; cnt = 0u; mine = 0u;
#pragma unroll
        for (unsigned j = 0; j < 16; ++j) { const unsigned c = xb_ld(&bar[XB_XCNT(j)]); sum += c; cnt += (c > 0u) ? 1u : 0u; mine = (j == x) ? c : mine; }
        if (sum == G) break;
        __builtin_amdgcn_s_sleep(1);
        if ((++sp & 255u) == 0u) { if (xb_ld(&bar[XB_TMO])) break; if (sp > XB_SPIN_CAP) { atomicAdd(&bar[XB_TMO], 1u); break; } }
    }
    nloc = mine > 0u ? mine : 1u; nx = cnt > 0u ? cnt : 1u;
}

__device__ __forceinline__ void xcd_barrier(const XcdBarrier& b) {
    asm volatile("s_waitcnt vmcnt(0)" ::: "memory");
    __syncthreads();
    if (threadIdx.x == 0) {
        unsigned* bar = b.bar;
        __builtin_amdgcn_s_waitcnt(0);
        unsigned nloc = b.st[0], nx = b.st[1];
        if (nloc == 0u) { xcd_barrier_complete(bar, b.x, nloc, nx); b.st[0] = nloc; b.st[1] = nx; }
        const unsigned old = xb_add(&bar[XB_XSUB(b.x)], 1u);
        const unsigned gen = old / nloc;
        if (old + 1u == (gen + 1u) * nloc) {
            __builtin_amdgcn_fence(__ATOMIC_RELEASE, "agent");
            asm volatile("s_waitcnt vmcnt(0)" ::: "memory");
            const unsigned og = xb_add(&bar[XB_TOP], 1u);
            const unsigned tg = og / nx;
            if (og + 1u == (tg + 1u) * nx) xb_add(&bar[XB_TOPGEN], 1u);
            else XB_SPIN(xb_ld(&bar[XB_TOPGEN]) == tg, bar);
            __builtin_amdgcn_fence(__ATOMIC_ACQUIRE, "agent");
            xb_add(&bar[XB_XGEN(b.x)], 1u);
            asm volatile("s_waitcnt vmcnt(0)" ::: "memory");
        } else {
            XB_SPIN(xb_ld(&bar[XB_XGEN(b.x)]) == gen, bar);
            __builtin_amdgcn_fence(__ATOMIC_ACQUIRE, "agent");
            asm volatile("s_waitcnt vmcnt(0)" ::: "memory");
        }
    }
    __syncthreads();
}

__device__ __forceinline__ void p0_row(const Params& p, int m, int lane) {
    unsigned long long* dst = (unsigned long long*)(p.ws + WS_XN + (size_t)m * DM * 2) + lane;
    if (m >= MROWS) {
#pragma unroll
        for (int j = 0; j < 4; ++j) dst[64 * j] = 0ull;
        return;
    }
    const float* src = m < NMETA ? p.in[6] + (size_t)m * DM : (m < TP ? p.in[0] + (size_t)(m - NMETA) * DM : p.in[1] + (size_t)(m - TP) * DM);
    const f32x4* s4 = (const f32x4*)src + lane;
    const f32x4* w4 = (const f32x4*)p.in[7] + lane;
    f32x4 v[4]; float s = 0.f;
#pragma unroll
    for (int j = 0; j < 4; ++j) { v[j] = s4[64 * j]; s += (v[j].x * v[j].x + v[j].y * v[j].y) + (v[j].z * v[j].z + v[j].w * v[j].w); }
    s = wave_sum(s);
    const float rs = 1.0f / sqrtf(s * (1.0f / DM) + EPS);
#pragma unroll
    for (int j = 0; j < 4; ++j) {
        const f32x4 w = w4[64 * j]; const f32x4 o = (v[j] * rs) * w;
        dst[64 * j] = (unsigned long long)cvtpk(o.x, o.y) | ((unsigned long long)cvtpk(o.z, o.w) << 32);
    }
}
__device__ __forceinline__ int permrow(int n) {
    const int pn = n >> 8, a = n & 255, wc = a >> 6, bj = (a >> 5) & 1, fq = (a >> 3) & 3, n2 = (a >> 2) & 1, e = a & 3;
    return pn * 256 + 128 * bj + 32 * wc + 16 * n2 + 4 * fq + e;
}
template <bool PERMW>
__device__ __forceinline__ void p0_transpose_item(const float* W, int K, int N, bf16* WT, LAS float* scr, int item, int lane) {
    const int nblk = N / 32, kb = item / nblk, nb = item % nblk, k0 = 64 * kb, n0 = 32 * nb;
#pragma unroll 8
    for (int i = 0; i < 32; ++i) { const int kk = 2 * i + (lane >> 5); scr[kk * 33 + (lane & 31)] = W[(size_t)(k0 + kk) * N + n0 + (lane & 31)]; }
    asm volatile("s_waitcnt lgkmcnt(0)" ::: "memory");
    const int c = lane & 7;
#pragma unroll
    for (int j = 0; j < 4; ++j) {
        const int n = (lane >> 3) + 8 * j; const LAS float* s = scr + (8 * c) * 33 + n;
        u32x4 o; o.x = cvtpk(s[0 * 33], s[1 * 33]); o.y = cvtpk(s[2 * 33], s[3 * 33]); o.z = cvtpk(s[4 * 33], s[5 * 33]); o.w = cvtpk(s[6 * 33], s[7 * 33]);
        const int row = PERMW ? permrow(n0 + n) : (n0 + n);
        *(u32x4*)(WT + (size_t)row * K + k0 + 8 * c) = o;
    }
    asm volatile("s_waitcnt lgkmcnt(0)" ::: "memory");
}
__device__ __forceinline__ void rope_entry(int pos, int i, float& c, float& s) {
    double inv = 1.0; for (int k = 0; k < i; ++k) inv *= 0.7498942093324558;
    const double ang = (double)pos * inv;
    const double kq = __builtin_rint(ang * 0.63661977236758134308);
    double r = __builtin_fma(-kq, 1.57079632673412561417e+00, ang); r = __builtin_fma(-kq, 6.07710050650619224932e-11, r);
    const int q = (int)((long long)kq & 3);
    const double z = r * r;
    const double sn = r + r * z * (-1.66666666666666324348e-01 + z * (8.33333333332248946124e-03 + z * (-1.98412698298579493134e-04 + z * (2.75573137070700676789e-06 + z * (-2.50507602534068634195e-08 + z * 1.58969099521155010221e-10)))));
    const double cs = 1.0 - 0.5 * z + z * z * (4.16666666666666019037e-02 + z * (-1.38888888888741095749e-03 + z * (2.48015872894767294178e-05 + z * (-2.75573143513906633035e-07 + z * (2.08757232129817482790e-09 + z * -1.13596475577881948265e-11)))));
    double cc, ss;
    if (q == 0) { cc = cs; ss = sn; } else if (q == 1) { cc = -sn; ss = cs; } else if (q == 2) { cc = -cs; ss = -sn; } else { cc = sn; ss = -cs; }
    c = (float)cc; s = (float)ss;
}
__device__ __forceinline__ void phase0(const Params& p, LAS unsigned char* lds) {
    const int tid = threadIdx.x, lane = tid & 63, wave = tid >> 6;
    const int gw = blockIdx.x * 8 + wave, NGW = gridDim.x * 8;
    LAS float* scr = (LAS float*)(lds + wave * 16384);
    constexpr int I1 = (DM / 64) * (DIN / 32), I2 = (DM / 64) * (DM / 32);
    float* rope = (float*)(p.ws + WS_ROPE);
    int rk = 0;
    {
        const f32x4* w4 = (const f32x4*)p.in[7] + lane;
        f32x4 w[4];
#pragma unroll
        for (int j = 0; j < 4; ++j) w[j] = w4[64 * j];
        for (int m0 = gw; m0 < MPAD; m0 += 3 * NGW) {
            f32x4 v[3][4];
#pragma unroll
            for (int k = 0; k < 3; ++k) {
                const int m = m0 + k * NGW;
                if (m < MROWS) {
                    const float* src = m < NMETA ? p.in[6] + (size_t)m * DM : (m < TP ? p.in[0] + (size_t)(m - NMETA) * DM : p.in[1] + (size_t)(m - TP) * DM);
                    const f32x4* s4 = (const f32x4*)src + lane;
#pragma unroll
                    for (int j = 0; j < 4; ++j) v[k][j] = s4[64 * j];
                } else {
#pragma unroll
                    for (int j = 0; j < 4; ++j) v[k][j] = (f32x4){0.f, 0.f, 0.f, 0.f};
                }
            }
            for (int kk = 0; kk < 3; ++kk, ++rk) {
                const int e = (blockIdx.x * NTHREADS + tid) + rk * (int)(gridDim.x * NTHREADS);
                if (e < TP * 32) { float c_, s_; rope_entry(e >> 5, e & 31, c_, s_); rope[2 * e] = c_; rope[2 * e + 1] = s_; }
            }
#pragma unroll
            for (int k = 0; k < 3; ++k) {
                const int m = m0 + k * NGW;
                if (m < MPAD) {
                    unsigned long long* dst = (unsigned long long*)(p.ws + WS_XN + (size_t)m * DM * 2) + lane;
                    float s = 0.f;
#pragma unroll
                    for (int j = 0; j < 4; ++j) s += (v[k][j].x * v[k][j].x + v[k][j].y * v[k][j].y) + (v[k][j].z * v[k][j].z + v[k][j].w * v[k][j].w);
                    s = wave_sum(s);
                    const float rs = 1.0f / sqrtf(s * (1.0f / DM) + EPS);
#pragma unroll
                    for (int j = 0; j < 4; ++j) {
                        const f32x4 o = (v[k][j] * rs) * w[j];
                        dst[64 * j] = (unsigned long long)cvtpk(o.x, o.y) | ((unsigned long long)cvtpk(o.z, o.w) << 32);
                    }
                }
            }
        }
    }
    for (int it = gw; it < I1 + I2; it += NGW) {
        if (it < I1) p0_transpose_item<true>(p.in[8], DM, DIN, (bf16*)(p.ws + WS_W1T), scr, it, lane);
        else p0_transpose_item<false>(p.in[9], DM, DM, (bf16*)(p.ws + WS_W2T), scr, it - I1, lane);
    }
    {
        bf16* GH = (bf16*)(p.ws + WS_GWH); bf16* GL = (bf16*)(p.ws + WS_GWL);
        for (int e = blockIdx.x * NTHREADS + tid; e < 65536; e += gridDim.x * NTHREADS) {
            const int jj = e & 7, ln = (e >> 3) & 63, ks = (e >> 9) & 3, ct = (e >> 11) & 1, g = (e >> 12) & 1, n = e >> 13;
            const float w = (g ? p.in[14] : p.in[12])[(n * 64 + 16 * ks + 8 * (ln >> 5) + jj) * 64 + 32 * ct + (ln & 31)];
            const bf16 hb = f2bf(w); GH[e] = hb; GL[e] = f2bf(w - bf2f(hb));
        }
        if (blockIdx.x == 0) ((float*)(p.ws + WS_SP))[tid] = log1pf(expf(-p.in[16][tid]));
        if (blockIdx.x == gridDim.x - 1 && tid < 64) {
            float d1 = p.in[19][tid] * p.in[20][tid], d2 = p.in[21][tid] * p.in[22][tid], mq = fabsf(p.in[17][tid]), mk = fabsf(p.in[18][tid]);
            d1 = wave_sum(d1); d2 = wave_sum(d2);
#pragma unroll
            for (int o = 1; o < 64; o <<= 1) { mq = fmaxf(mq, __shfl_xor(mq, o)); mk = fmaxf(mk, __shfl_xor(mk, o)); }
            if (tid == 0) { float* sc = (float*)(p.ws + WS_SP) + 512; sc[0] = expf(d1) - expf(d2) + LAM0; sc[1] = -(8.0f * mq * mk) * LOG2E; }
        }
    }
    for (int e = (blockIdx.x * NTHREADS + tid) + rk * (int)(gridDim.x * NTHREADS); e < TP * 32; e += gridDim.x * NTHREADS) {
        float c, s; rope_entry(e >> 5, e & 31, c, s); rope[2 * e] = c; rope[2 * e + 1] = s;
    }
}

struct EpiIn {
    static constexpr bool PERM = false, AFTER_DRAIN = false;
    float* out; unsigned char* ws; const float* qnw; const float* knw;
    __device__ __forceinline__ void operator()(const f32x4 (&acc)[2][2][4][2], const pg8::Unit& u, int wr, int wc, int fr, int fq) const {
        const int typ = u.pn >> 1;
        const int segc = (u.pn & 1) * 256 + wc * 64 + fq * 8;
        if (typ == 2 || typ == 3) {
            const float* nwp = (typ == 2) ? qnw : knw;
            float w1[8], w2[8];
#pragma unroll
            for (int t = 0; t < 8; ++t) { w1[t] = nwp[fq * 8 + t]; w2[t] = nwp[32 + fq * 8 + t]; }
            bf16* dstb = (bf16*)(ws + WS_QB);
            const float osc = (typ == 2) ? C2 : 1.0f;
            const int hh_ = (u.pn & 1) * 2 + (wc >> 1), cc_ = wc & 1;
            f32x4 csn[4];
#define EI_ROPE(g) do { const int r_ = u.pm * 256 + ((g) >> 2) * 128 + wr * 64 + ((g) & 3) * 16 + fr; const int pos_ = r_ < TP ? r_ : (r_ < MROWS ? PAST + ((r_ - TP) & 15) : 0); \
                const f32x4* rp_ = (const f32x4*)(ws + WS_ROPE) + (size_t)pos_ * 16 + fq * 4; csn[0] = rp_[0]; csn[1] = rp_[1]; csn[2] = rp_[2]; csn[3] = rp_[3]; } while (0)
            EI_ROPE(0);
#pragma unroll
            for (int ai = 0; ai < 2; ++ai)
#pragma unroll
                for (int m = 0; m < 4; ++m) {
                    const int r = u.pm * 256 + ai * 128 + wr * 64 + m * 16 + fr;
                    const f32x4 cs4[4] = {csn[0], csn[1], csn[2], csn[3]};
                    if (ai * 4 + m + 1 < 8) EI_ROPE(ai * 4 + m + 1);
                    __builtin_amdgcn_sched_barrier(0);
                    float v1[8], v2[8]; float ss = 0.f;
#pragma unroll
                    for (int n = 0; n < 2; ++n)
#pragma unroll
                        for (int e = 0; e < 4; ++e) { v1[4 * n + e] = acc[ai][0][m][n][e]; v2[4 * n + e] = acc[ai][1][m][n][e]; ss += v1[4 * n + e] * v1[4 * n + e] + v2[4 * n + e] * v2[4 * n + e]; }
                    ss += __shfl_xor(ss, 16); ss += __shfl_xor(ss, 32);
                    const float rinv = __builtin_amdgcn_rsqf(ss * (1.0f / 64.0f) + EPS);
                    float o1[8], o2[8];
#pragma unroll
                    for (int t2 = 0; t2 < 4; ++t2) {
                        const f32x4 cs = cs4[t2];
                        { const float y1 = (v1[2 * t2] * rinv) * w1[2 * t2], y2 = (v2[2 * t2] * rinv) * w2[2 * t2]; o1[2 * t2] = y1 * cs.x - y2 * cs.y; o2[2 * t2] = y1 * cs.y + y2 * cs.x; }
                        { const float y1 = (v1[2 * t2 + 1] * rinv) * w1[2 * t2 + 1], y2 = (v2[2 * t2 + 1] * rinv) * w2[2 * t2 + 1]; o1[2 * t2 + 1] = y1 * cs.z - y2 * cs.w; o2[2 * t2 + 1] = y1 * cs.w + y2 * cs.z; }
                    }
                    u32x4 b1, b2;
                    b1.x = cvtpk(o1[0] * osc, o1[1] * osc); b1.y = cvtpk(o1[2] * osc, o1[3] * osc); b1.z = cvtpk(o1[4] * osc, o1[5] * osc); b1.w = cvtpk(o1[6] * osc, o1[7] * osc);
                    b2.x = cvtpk(o2[0] * osc, o2[1] * osc); b2.y = cvtpk(o2[2] * osc, o2[3] * osc); b2.z = cvtpk(o2[4] * osc, o2[5] * osc); b2.w = cvtpk(o2[6] * osc, o2[7] * osc);
                    if (typ == 2) { *(u32x4*)(dstb + (size_t)r * 512 + segc) = b1; *(u32x4*)(dstb + (size_t)r * 512 + segc + 32) = b2; }
                    else if (r < MROWS) {
                        const int prow = r < NMETA ? r : r + 48;
                        unsigned char* kd = ws + WS_KV + (size_t)(prow >> 6) * 131072 + hh_ * 32768 + cc_ * 8192 + fq * 1024 + (prow & 63) * 16;
                        *(u32x4*)kd = b1; *(u32x4*)(kd + 4096) = b2;
                    }
                    if (typ == 3 && r < MROWS) {
                        float* d = (r < TP) ? out + O_KP + (size_t)r * 512 : out + O_KS + (size_t)(r - TP) * 512;
                        *(f32x4*)(d + segc) = (f32x4){o1[0], o1[1], o1[2], o1[3]}; *(f32x4*)(d + segc + 4) = (f32x4){o1[4], o1[5], o1[6], o1[7]};
                        *(f32x4*)(d + segc + 32) = (f32x4){o2[0], o2[1], o2[2], o2[3]}; *(f32x4*)(d + segc + 36) = (f32x4){o2[4], o2[5], o2[6], o2[7]};
                    }
                    asm volatile("" ::: "memory");
                }
#undef EI_ROPE
        } else {
#pragma unroll
            for (int ai = 0; ai < 2; ++ai)
#pragma unroll
                for (int m = 0; m < 4; ++m) {
                    const int r = u.pm * 256 + ai * 128 + wr * 64 + m * 16 + fr;
#pragma unroll
                    for (int bj = 0; bj < 2; ++bj) {
                        const f32x4 a0 = acc[ai][bj][m][0], a1 = acc[ai][bj][m][1];
                        const int col = segc + 32 * bj;
                        if (typ == 0) {
                            float* d = (float*)(ws + WS_XA) + (size_t)r * 512 + col;
                            *(f32x4*)d = a0; *(f32x4*)(d + 4) = a1;
                        } else if (typ == 4) {
                            u32x4 b; b.x = cvtpk(a0.x, a0.y); b.y = cvtpk(a0.z, a0.w); b.z = cvtpk(a1.x, a1.y); b.w = cvtpk(a1.z, a1.w);
                            if (r < MROWS) {
                                const int prow = r < NMETA ? r : r + 48;
                                const int hh_ = (u.pn & 1) * 2 + (wc >> 1), dblk = (wc & 1) * 2 + bj;
                                *(u32x4*)(ws + WS_KV + (size_t)(prow >> 6) * 131072 + hh_ * 32768 + 16384 + (dblk * 4 + ((prow & 63) >> 4)) * 1024 + (prow & 15) * 64 + fq * 16) = b;
                            }
                            if (r < MROWS) {
                                float* d = ((r < TP) ? out + O_VP + (size_t)r * 512 : out + O_VS + (size_t)(r - TP) * 512) + col;
                                *(f32x4*)d = a0; *(f32x4*)(d + 4) = a1;
                            }
                        } else {
                            u32x4 b; b.x = cvtpk(silu_f(a0.x), silu_f(a0.y)); b.y = cvtpk(silu_f(a0.z), silu_f(a0.w)); b.z = cvtpk(silu_f(a1.x), silu_f(a1.y)); b.w = cvtpk(silu_f(a1.z), silu_f(a1.w));
                            *(u32x4*)((bf16*)(ws + (typ == 1 ? WS_SGA : WS_SGB)) + (size_t)r * 512 + col) = b;
                        }
                    }
                }
        }
    }
};
__device__ __forceinline__ int late_pn(int j) { return (j & 2) ? 10 + (j & 1) : 2 + (j & 1); }
struct P1Order {
    pg8::StaticOrder S, S1;
    __device__ __forceinline__ void init(int G, int c) { S.init(16384, DIN, G, c); S1.init(16384, DIN, G, (G == 256) ? (c ^ 128) : c); }
    __device__ __forceinline__ bool next(int i, pg8::Unit& u) const {
#ifndef P1ORD
#define P1ORD 102
#define P1SWAPR 0
#endif
        const int r_ = (i == 0) ? (P1ORD / 100) : (i == 1) ? ((P1ORD / 10) % 10) : (i == 2) ? (P1ORD % 10) : i;
        if (!((r_ == P1SWAPR) ? S1.next(r_, u) : S.next(r_, u))) return false;
        const bool gate = (u.pn == 2) | (u.pn == 3) | (u.pn == 10) | (u.pn == 11);
        if (u.pm < 6 && gate) { const int k = u.pm * 4 + ((u.pn >= 10) ? 2 + (u.pn - 10) : (u.pn - 2)); u.pm = 64 + k / 12; u.pn = k % 12; }
        return true;
    }
    __device__ __forceinline__ void a_ready(const pg8::Unit&) const {}
    __device__ __forceinline__ void done(const pg8::Unit&) const {}
};
struct OneUnit {
    int pm, pn;
    __device__ __forceinline__ bool next(int i, pg8::Unit& u) const { if (i != 0) return false; u.pm = pm; u.pn = pn; return true; }
    __device__ __forceinline__ void a_ready(const pg8::Unit&) const {}
    __device__ __forceinline__ void done(const pg8::Unit&) const {}
};
struct EpiOut {
    static constexpr bool PERM = false, AFTER_DRAIN = false;
    float* out; const float* xp; const float* xs;
    __device__ __forceinline__ void rowptr(const pg8::Unit& u, int wr, int fr, int b, int k, const float*& xr, float*& orow) const {
        const int r = u.pm * 256 + (b >> 1) * 128 + wr * 64 + ((b & 1) * 2 + k) * 16 + fr;
        if (r < 16384) { xr = xp + (size_t)r * DM; orow = out + O_YP + (size_t)r * DM; }
        else { xr = xs + (size_t)(r - 16384) * DM; orow = out + O_YS + (size_t)(r - 16384) * DM; }
    }
    __device__ __forceinline__ void operator()(const f32x4 (&acc)[2][2][4][2], const pg8::Unit& u, int wr, int wc, int fr, int fq) const {
        const int col0 = u.pn * 256 + wc * 32 + fq * 4;
        f32x4 xa[8], xb[8];
#define EO_LOAD(b, X) do { _Pragma("unroll") for (int k = 0; k < 2; ++k) { const float* xr; float* orow; rowptr(u, wr, fr, (b), k, xr, orow); \
            _Pragma("unroll") for (int bj = 0; bj < 2; ++bj) _Pragma("unroll") for (int n = 0; n < 2; ++n) X[k * 4 + bj * 2 + n] = *(const f32x4*)(xr + col0 + bj * 128 + n * 16); } } while (0)
#define EO_STORE(b, X) do { _Pragma("unroll") for (int k = 0; k < 2; ++k) { const float* xr; float* orow; rowptr(u, wr, fr, (b), k, xr, orow); \
            _Pragma("unroll") for (int bj = 0; bj < 2; ++bj) _Pragma("unroll") for (int n = 0; n < 2; ++n) \
                *(f32x4*)(orow + col0 + bj * 128 + n * 16) = X[k * 4 + bj * 2 + n] + acc[(b) >> 1][bj][((b) & 1) * 2 + k][n]; } } while (0)
        EO_LOAD(0, xa); EO_LOAD(1, xb);
        EO_STORE(0, xa); EO_LOAD(2, xa);
        EO_STORE(1, xb); EO_LOAD(3, xb);
        EO_STORE(2, xa); EO_STORE(3, xb);
#undef EO_LOAD
#undef EO_STORE
    }
};

template <int MODE>
__device__ __forceinline__ void lru_chunk(const Params& p, LAS unsigned char* lds, int idx) {
    int ch_ = threadIdx.x; asm volatile("" : "+v"(ch_));
    const int ch = ch_, lane = ch & 63, r32 = lane & 31, hi = lane >> 5;
    const int n = __builtin_amdgcn_readfirstlane(ch >> 6);
    LAS float* cfs = (LAS float*)lds;
    LAS float* als = (LAS float*)lds + 32 * LRS;
    const float* XA = (const float*)(p.ws + WS_XA);
    const bf16* SGA = (const bf16*)(p.ws + WS_SGA); bf16* YCAT = (bf16*)(p.ws + WS_YCAT);
    const bool samp = idx >= N_LRU_P;
    int row0, L, ci = 0, b = 0; float h = 0.f; float xv[35];
    if (!samp) {
        ci = idx; row0 = LRU_CH * ci; L = (TP - row0) < LRU_CH ? (TP - row0) : LRU_CH;
        if (ci > 0) { xv[0] = XA[(size_t)(row0 - 3) * 512 + ch]; xv[1] = XA[(size_t)(row0 - 2) * 512 + ch]; xv[2] = XA[(size_t)(row0 - 1) * 512 + ch]; }
        else { xv[0] = 0.f; xv[1] = 0.f; xv[2] = 0.f; }
        if (MODE == 1) h = ((const float*)(p.ws + WS_CARRY))[ci * 512 + ch];
    } else {
        b = idx - N_LRU_P; row0 = TP + 16 * b; L = 16; h = p.in[4][b * 512 + ch];
        xv[0] = p.in[5][(b * 3 + 0) * 512 + ch]; xv[1] = p.in[5][(b * 3 + 1) * 512 + ch]; xv[2] = p.in[5][(b * 3 + 2) * 512 + ch];
    }
#pragma unroll
    for (int t = 0; t < 32; ++t) xv[3 + t] = (t < L) ? XA[(size_t)(row0 + t) * 512 + ch] : 0.f;
    bf16x8 bw[16];
    { const bf16x8* GH = (const bf16x8*)(p.ws + WS_GWH);
#pragma unroll
      for (int ks = 0; ks < 4; ++ks)
#pragma unroll
        for (int g = 0; g < 2; ++g)
#pragma unroll
            for (int ct = 0; ct < 2; ++ct) bw[(ks * 2 + g) * 2 + ct] = GH[((((n * 2 + g) * 2 + ct) * 4 + ks) * 64 + lane)]; }
    { const float cw0 = p.in[10][ch], cw1 = p.in[10][512 + ch], cw2 = p.in[10][1024 + ch], cw3 = p.in[10][1536 + ch], cb = p.in[11][ch];
#pragma unroll
      for (int t = 0; t < 32; ++t) cfs[t * LRS + ch] = cb + cw0 * xv[t] + cw1 * xv[t + 1] + cw2 * xv[t + 2] + cw3 * xv[t + 3]; }
    asm volatile("s_waitcnt lgkmcnt(0)" ::: "memory");
    bf16x8 ah[4], al[4];
#pragma unroll
    for (int ks = 0; ks < 4; ++ks) {
        const LAS float* s = cfs + r32 * LRS + n * 64 + ks * 16 + hi * 8;
        const f32x4 x0 = *(const LAS f32x4*)s, x1 = *(const LAS f32x4*)(s + 4);
        u32x4 uh, ul;
#pragma unroll
        for (int q = 0; q < 4; ++q) {
            const float e0 = (q < 2) ? x0[2 * q] : x1[2 * q - 4], e1 = (q < 2) ? x0[2 * q + 1] : x1[2 * q - 3];
            const unsigned u = cvtpk(e0, e1); uh[q] = u;
            ul[q] = cvtpk(e0 - __uint_as_float(u << 16), e1 - __uint_as_float(u & 0xffff0000u));
        }
        ah[ks] = __builtin_bit_cast(bf16x8, uh); al[ks] = __builtin_bit_cast(bf16x8, ul);
    }
    f32x16 acc[2][2];
#pragma unroll
    for (int g = 0; g < 2; ++g)
#pragma unroll
        for (int ct = 0; ct < 2; ++ct)
#pragma unroll
            for (int r = 0; r < 16; ++r) acc[g][ct][r] = 0.f;
#pragma unroll
    for (int ks = 0; ks < 4; ++ks)
#pragma unroll
        for (int g = 0; g < 2; ++g)
#pragma unroll
            for (int ct = 0; ct < 2; ++ct) {
                const bf16x8 bh = bw[(ks * 2 + g) * 2 + ct];
                acc[g][ct] = __builtin_amdgcn_mfma_f32_32x32x16_bf16(ah[ks], bh, acc[g][ct], 0, 0, 0);
                acc[g][ct] = __builtin_amdgcn_mfma_f32_32x32x16_bf16(al[ks], bh, acc[g][ct], 0, 0, 0);
            }
    unsigned short sg[32];
    if (MODE == 1) {
#pragma unroll
        for (int t = 0; t < 32; ++t) sg[t] = (t < L) ? SGA[(size_t)(row0 + t) * 512 + ch] : (unsigned short)0;
    }
#pragma unroll
    for (int ct = 0; ct < 2; ++ct) {
        const int chn = n * 64 + ct * 32 + r32;
        const float gab = p.in[13][chn], gxb = p.in[15][chn], sp = ((const float*)(p.ws + WS_SP))[chn];
#pragma unroll
        for (int r = 0; r < 16; ++r) {
            const int tok = crow(r, hi);
            const float pr = acc[0][ct][r] + gab, pi = acc[1][ct][r] + gxb;
            const float rg = __builtin_amdgcn_rcpf(1.0f + __builtin_amdgcn_exp2f(-LOG2E * pr));
            const float ig = __builtin_amdgcn_rcpf(1.0f + __builtin_amdgcn_exp2f(-LOG2E * pi));
            const float la = -8.0f * rg * sp;
            const float a = __builtin_amdgcn_exp2f(LOG2E * la);
            const float x2 = 2.0f * la;
            const float om = (x2 > -0.05f) ? -x2 * (1.0f + x2 * (0.5f + x2 * (0.16666667f + x2 * 0.041666668f))) : (1.0f - a * a);
            const float bb = __builtin_amdgcn_sqrtf(om) * (ig * cfs[tok * LRS + chn]);
            als[tok * LRS + chn] = a; cfs[tok * LRS + chn] = bb;
        }
    }
    asm volatile("s_waitcnt lgkmcnt(0)" ::: "memory");
    float ca = 1.0f;
#pragma unroll
    for (int t = 0; t < 32; ++t) {
        if (t < L) {
            const float a = als[t * LRS + ch], bb = cfs[t * LRS + ch];
            if (MODE == 0) {
                __hip_atomic_store((unsigned*)(p.ws + WS_AT) + (size_t)(row0 + t) * 512 + ch, __float_as_uint(a), __ATOMIC_RELAXED, __HIP_MEMORY_SCOPE_AGENT);
                __hip_atomic_store((unsigned*)(p.ws + WS_BT) + (size_t)(row0 + t) * 512 + ch, __float_as_uint(bb), __ATOMIC_RELAXED, __HIP_MEMORY_SCOPE_AGENT);
            }
            h = a * h + bb; ca *= a;
            if (MODE == 1 && row0 + t >= NMETA) YCAT[(size_t)(row0 + t - NMETA) * 1024 + ch] = f2bf(h * bf2f(sg[t]));
        }
    }
    asm volatile("s_waitcnt lgkmcnt(0)" ::: "memory");
    constexpr int LASTL = TP - LRU_CH * (N_LRU_P - 1);
    if (MODE == 0) {
        __hip_atomic_store((unsigned*)(p.ws + WS_SUMA) + ci * 512 + ch, __float_as_uint(ca), __ATOMIC_RELAXED, __HIP_MEMORY_SCOPE_AGENT);
        __hip_atomic_store((unsigned*)(p.ws + WS_SUMB) + ci * 512 + ch, __float_as_uint(h), __ATOMIC_RELAXED, __HIP_MEMORY_SCOPE_AGENT);
        if (ci == N_LRU_P - 1) { p.out[O_CP + ch] = xv[LASTL]; p.out[O_CP + 512 + ch] = xv[LASTL + 1]; p.out[O_CP + 1024 + ch] = xv[LASTL + 2]; }
    } else if (!samp) {
        if (ci == N_LRU_P - 1) p.out[O_HP + ch] = h;
    } else {
        p.out[O_HS + b * 512 + ch] = h;
        p.out[O_CS + (b * 3 + 0) * 512 + ch] = xv[16]; p.out[O_CS + (b * 3 + 1) * 512 + ch] = xv[17]; p.out[O_CS + (b * 3 + 2) * 512 + ch] = xv[18];
    }
}
__device__ __forceinline__ void lru_pass2(const Params& p, int ci) {
    int ch_ = threadIdx.x; asm volatile("" : "+v"(ch_));
    const int ch = ch_;
    const int row0 = LRU_CH * ci, L = (TP - row0) < LRU_CH ? (TP - row0) : LRU_CH;
    const float* AT = (const float*)(p.ws + WS_AT); const float* BT = (const float*)(p.ws + WS_BT);
    const bf16* SGA = (const bf16*)(p.ws + WS_SGA); bf16* YCAT = (bf16*)(p.ws + WS_YCAT);
    float h = ((const float*)(p.ws + WS_CARRY))[ci * 512 + ch];
    float av[32], bv[32]; unsigned short sg[32];
#pragma unroll
    for (int t = 0; t < 32; ++t) {
        const int tt = t < L ? t : L - 1;
        const size_t o_ = (size_t)(row0 + tt) * 512 + ch;
        av[t] = AT[o_]; bv[t] = BT[o_]; sg[t] = SGA[o_];
    }
    if (L == LRU_CH && row0 >= NMETA) {
#pragma unroll
        for (int t = 0; t < 32; ++t) { h = av[t] * h + bv[t]; YCAT[(size_t)(row0 + t - NMETA) * 1024 + ch] = f2bf(h * bf2f(sg[t])); }
    } else {
#pragma unroll
        for (int t = 0; t < 32; ++t) {
            if (t < L) {
                h = av[t] * h + bv[t];
                if (row0 + t >= NMETA) YCAT[(size_t)(row0 + t - NMETA) * 1024 + ch] = f2bf(h * bf2f(sg[t]));
            }
        }
    }
    if (ci == N_LRU_P - 1) p.out[O_HP + ch] = h;
}
__device__ __forceinline__ void lru_arrive(const Params& p, LAS unsigned char* lds, int it_, int n_arrivers) {
    const int ch = threadIdx.x;
    unsigned* ctl = (unsigned*)(p.ws + WS_CTL);
    asm volatile("s_waitcnt vmcnt(0)" ::: "memory");
    __syncthreads();
    volatile LAS unsigned* lw = (volatile LAS unsigned*)(lds + LCTL + 16);
    if (ch == 0) lw[0] = __hip_atomic_fetch_add(ctl + CW_LRUDONE + 64 * it_, 1u, __ATOMIC_RELAXED, __HIP_MEMORY_SCOPE_AGENT);
    __syncthreads();
    if (lw[0] + 1u == (unsigned)n_arrivers) {
        __builtin_amdgcn_fence(__ATOMIC_ACQUIRE, "agent");
        asm volatile("s_waitcnt vmcnt(0)" ::: "memory");
        const float* SA = (const float*)(p.ws + WS_SUMA); const float* SB = (const float*)(p.ws + WS_SUMB); float* CR = (float*)(p.ws + WS_CARRY);
        float H = 0.f;
        float aA[19], bA[19], aB[19], bB[19];
#define CS_LOAD(A_, B_, K) do { _Pragma("unroll") for (int j = 0; j < 19; ++j) { A_[j] = SA[((K) + j) * 512 + ch]; B_[j] = SB[((K) + j) * 512 + ch]; } } while (0)
#define CS_FOLD(A_, B_, K) do { _Pragma("unroll") for (int j = 0; j < 19; ++j) { __hip_atomic_store((unsigned*)CR + ((K) + j) * 512 + ch, __float_as_uint(H), __ATOMIC_RELAXED, __HIP_MEMORY_SCOPE_AGENT); H = A_[j] * H + B_[j]; } } while (0)
        CS_LOAD(aA, bA, 0);
        for (int k = 0; k < N_LRU_P - 19; k += 38) {
            CS_LOAD(aB, bB, k + 19);
            CS_FOLD(aA, bA, k);
            CS_LOAD(aA, bA, k + 38);
            CS_FOLD(aB, bB, k + 19);
        }
        CS_FOLD(aA, bA, N_LRU_P - 19);
#undef CS_LOAD
#undef CS_FOLD
        asm volatile("s_waitcnt vmcnt(0)" ::: "memory");
        __syncthreads();
        if (ch == 0) __hip_atomic_store(ctl + CW_CARRYOK + 64 * it_, 1u, __ATOMIC_RELAXED, __HIP_MEMORY_SCOPE_AGENT);
    }
    __syncthreads();
}

__device__ __forceinline__ s16x4 tr16(const LAS unsigned char* p) {
    typedef short v4i16_t __attribute__((ext_vector_type(4)));
    return __builtin_bit_cast(s16x4, __builtin_amdgcn_ds_read_tr16_b64_v4i16((LAS v4i16_t*)p));
}
__device__ __forceinline__ void attn_sample(const Params& p, LAS unsigned char* lds, int b, int h, float negm, float lam) {
    int tid_ = threadIdx.x; asm volatile("" : "+v"(tid_));
    const int tid = tid_, lane = tid & 63, r32 = lane & 31, hi = lane >> 5;
    const int wid = __builtin_amdgcn_readfirstlane(tid >> 6), db = wid & 3, c = wid >> 2;
    const bf16* QBp = (const bf16*)(p.ws + WS_QB);
    constexpr int NT = 65;
    const int qrow = TP + 16 * b + (r32 & 15);
    bf16x8 qr[4];
    { const bf16* q = QBp + (size_t)qrow * 512 + h * 128 + c * 64 + hi * 8;
#pragma unroll
      for (int d0 = 0; d0 < 4; ++d0) qr[d0] = *(const bf16x8*)(q + d0 * 16); }
    f32x16 o;
#pragma unroll
    for (int r = 0; r < 16; ++r) o[r] = 0.f;
    float lacc = 0.f;
    const int kkey = 8 * (tid >> 6) + (lane & 7), kch = lane >> 3, kcol = h * 128 + kch * 8;
    const unsigned kdst = kch * 1024 + kkey * 16;
    int vkey[2], vcol[2]; unsigned vdst[2], vimg[2];
#pragma unroll
    for (int i = 0; i < 2; ++i) { const int wv = (tid >> 6) + 8 * i, q16 = ((lane >> 3) & 3) * 4 + (lane & 3); vkey[i] = wv * 4 + ((lane >> 5) & 1) * 2 + ((lane >> 2) & 1); vcol[i] = h * 128 + q16 * 8;
        vdst[i] = 16384 + ((q16 >> 2) * 4 + (vkey[i] >> 4)) * 1024 + (vkey[i] & 15) * 64 + (q16 & 3) * 16;
        vimg[i] = 16384 + ((q16 >> 2) * 4 + (b & 3)) * 1024 + (vkey[i] & 15) * 64 + (q16 & 3) * 16; }
    const unsigned char* img = p.ws + WS_KV + (size_t)(257 + (b >> 2)) * 131072 + (size_t)h * 32768;
    const unsigned kimg = kch * 1024 + ((b & 3) * 16 + (kkey & 15)) * 16;
    f32x4 sa[8], sb[8];
#define ATT_LOAD(st, j) do { \
        const size_t row0_ = (size_t)b * PAST + 64 * (j); const float* ck = p.in[2] + (row0_ + kkey) * 512 + kcol; \
        st[0] = *(const f32x4*)ck; st[1] = *(const f32x4*)(ck + 4); st[2] = *(const f32x4*)(ck + 64); st[3] = *(const f32x4*)(ck + 68); \
        _Pragma("unroll") for (int i_ = 0; i_ < 2; ++i_) { const float* cv = p.in[3] + (row0_ + vkey[i_]) * 512 + vcol[i_]; st[4 + 2 * i_] = *(const f32x4*)cv; st[5 + 2 * i_] = *(const f32x4*)(cv + 4); } \
    } while (0)
#define PK4(A_, B_2) (u32x4){cvtpk((A_)[0], (A_)[1]), cvtpk((A_)[2], (A_)[3]), cvtpk((B_2)[0], (B_2)[1]), cvtpk((B_2)[2], (B_2)[3])}
#define ATT_STORE(st, buf) do { LAS unsigned char* B_ = lds + (buf) * 32768; \
        *(LAS u32x4*)(B_ + kdst) = PK4(st[0], st[1]); *(LAS u32x4*)(B_ + 8192 + kdst) = PK4(st[2], st[3]); \
        *(LAS u32x4*)(B_ + vdst[0]) = PK4(st[4], st[5]); *(LAS u32x4*)(B_ + vdst[1]) = PK4(st[6], st[7]); \
    } while (0)
#define ATT_COMPUTE(LAST, buf) do { \
            const LAS unsigned char* Bb = lds + (buf) * 32768; \
            const LAS unsigned char* Kb = Bb + c * 8192 + hi * 1024 + r32 * 16; \
            f32x16 p0, p1; \
            _Pragma("unroll") for (int r = 0; r < 16; ++r) { p0[r] = negm; p1[r] = negm; } \
            _Pragma("unroll") for (int d0 = 0; d0 < 4; ++d0) { \
                const bf16x8 b0 = *(const LAS bf16x8*)(Kb + d0 * 2048), b1 = *(const LAS bf16x8*)(Kb + d0 * 2048 + 512); \
                p0 = __builtin_amdgcn_mfma_f32_32x32x16_bf16(b0, qr[d0], p0, 0, 0, 0); \
                p1 = __builtin_amdgcn_mfma_f32_32x32x16_bf16(b1, qr[d0], p1, 0, 0, 0); } \
            _Pragma("unroll") for (int r = 0; r < 16; ++r) { p0[r] = __builtin_amdgcn_exp2f(p0[r]); p1[r] = __builtin_amdgcn_exp2f(p1[r]); } \
            if (LAST) {     \
                _Pragma("unroll") for (int r = 8; r < 16; ++r) p0[r] = 0.f; \
                _Pragma("unroll") for (int r = 0; r < 16; ++r) p1[r] = 0.f; } \
            float s = 0.f; \
            _Pragma("unroll") for (int r = 0; r < 16; ++r) s += p0[r] + p1[r]; \
            lacc += s; \
            u32x4 pw[4]; \
            pw[0] = (u32x4){cvtpk(p0[0], p0[1]), cvtpk(p0[2], p0[3]), cvtpk(p0[4], p0[5]), cvtpk(p0[6], p0[7])}; \
            pw[1] = (u32x4){cvtpk(p0[8], p0[9]), cvtpk(p0[10], p0[11]), cvtpk(p0[12], p0[13]), cvtpk(p0[14], p0[15])}; \
            pw[2] = (u32x4){cvtpk(p1[0], p1[1]), cvtpk(p1[2], p1[3]), cvtpk(p1[4], p1[5]), cvtpk(p1[6], p1[7])}; \
            pw[3] = (u32x4){cvtpk(p1[8], p1[9]), cvtpk(p1[10], p1[11]), cvtpk(p1[12], p1[13]), cvtpk(p1[14], p1[15])}; \
            const LAS unsigned char* Vb = Bb + 16384 + db * 4096 + ((lane >> 4) & 1) * 32 + (lane & 3) * 8 + (4 * hi + ((lane & 15) >> 2)) * 64; \
            _Pragma("unroll") for (int kg = 0; kg < 4; ++kg) { \
                const s16x4 lo = tr16(Vb + kg * 1024), hh = tr16(Vb + kg * 1024 + 512); \
                const bf16x8 vf = (bf16x8){lo[0], lo[1], lo[2], lo[3], hh[0], hh[1], hh[2], hh[3]}; \
                o = __builtin_amdgcn_mfma_f32_32x32x16_bf16(__builtin_bit_cast(bf16x8, pw[kg]), vf, o, 0, 0, 0); } \
        } while (0)
    ATT_LOAD(sa, 0); ATT_LOAD(sb, 1); ATT_STORE(sa, 0); __syncthreads();
    for (int j = 0; j < 62; j += 2) {
        ATT_LOAD(sa, j + 2);
        ATT_COMPUTE(false, 0);
        ATT_STORE(sb, 1);
        __syncthreads();
        ATT_LOAD(sb, j + 3);
        ATT_COMPUTE(false, 1);
        ATT_STORE(sa, 0);
        __syncthreads();
    }
    {
        const u32x4 i0 = *(const u32x4*)(img + kimg), i1 = *(const u32x4*)(img + 8192 + kimg), i2 = *(const u32x4*)(img + vimg[0]), i3 = *(const u32x4*)(img + vimg[1]);
        ATT_COMPUTE(false, 0);
        ATT_STORE(sb, 1);
        __syncthreads();
        ATT_COMPUTE(false, 1);
        *(LAS u32x4*)(lds + kdst) = i0; *(LAS u32x4*)(lds + 8192 + kdst) = i1; *(LAS u32x4*)(lds + vdst[0]) = i2; *(LAS u32x4*)(lds + vdst[1]) = i3;
        __syncthreads();
        ATT_COMPUTE(true, 0);
        __syncthreads();
    }
#undef ATT_LOAD
#undef ATT_STORE
#undef ATT_COMPUTE
#undef PK4
    lacc += __shfl_xor(lacc, 32);
    LAS float* wsf = (LAS float*)(lds + 98304) + wid * 64;
    if (hi == 0) wsf[r32] = lacc;
    asm volatile("s_waitcnt lgkmcnt(0)" ::: "memory");
    float rli[16];
#pragma unroll
    for (int r = 0; r < 16; ++r) rli[r] = __builtin_amdgcn_rcpf(wsf[crow(r, hi)]);
    LAS float* X2 = (LAS float*)lds + db * 1024;
    LAS float* SS = (LAS float*)(lds + 65536);
    if (c == 1) {
#pragma unroll
        for (int r = 0; r < 16; ++r) X2[r * 64 + lane] = lam * (o[r] * rli[r]);
    }
    __syncthreads();
    if (c == 0) {
#pragma unroll
        for (int r = 0; r < 16; ++r) {
            const float v = o[r] * rli[r] - X2[r * 64 + lane]; o[r] = v;
            const float s = half_sum_hi16(v * v);
            if (r32 == 16) SS[db * 32 + crow(r, hi)] = s;
        }
    }
    __syncthreads();
    if (c == 0) {
        const bf16* SGB = (const bf16*)(p.ws + WS_SGB); bf16* YCAT = (bf16*)(p.ws + WS_YCAT);
        const float sw = p.in[23][db * 32 + r32];
        const int e = db * 32 + r32;
        bf16 gt[8];
#pragma unroll
        for (int r = 0; r < 8; ++r) gt[r] = SGB[(size_t)(TP + 16 * b + (crow(r, hi) & 15)) * 512 + h * 128 + e];
#pragma unroll
        for (int r = 0; r < 8; ++r) {
            const int q = crow(r, hi);
            const float s = (SS[q] + SS[32 + q]) + (SS[64 + q] + SS[96 + q]);
            const float rinv = __builtin_amdgcn_rsqf(s * (1.0f / 128.0f) + EPS);
            const size_t row = (size_t)(TP + 16 * b + (q & 15));
            YCAT[(row - NMETA) * 1024 + 512 + h * 128 + e] = f2bf((((o[r] * rinv) * sw) * ONE_M_LAM0) * bf2f(gt[r]));
        }
    }
    __syncthreads();
}

#if defined(PROBE_OVH) || defined(PROBE_LRU1) || defined(PROBE_LRU2) || defined(PROBE_IDLE) || defined(PROBE_POP) || defined(PROBE_SEG)
__device__ unsigned long long g_samp[2];
#endif
__device__ __forceinline__ void glds16(const void* gsrc, unsigned lds_dst) {
    asm volatile("s_mov_b32 m0, %1\n\ts_nop 0\n\tglobal_load_lds_dwordx4 %0, off" :: "v"(gsrc), "s"(lds_dst) : "memory", "m0");
}
__device__ __forceinline__ void glds16s(unsigned long long sbase, unsigned voff, unsigned lds_dst) {
    asm volatile("s_mov_b32 m0, %2\n\ts_nop 0\n\tglobal_load_lds_dwordx4 %0, %1" :: "v"(voff), "s"(sbase), "s"(lds_dst) : "memory", "m0");
}
__device__ __forceinline__ void glds16s_a(unsigned long long sbase, unsigned voff, unsigned lds_dst) {
    asm volatile("s_mov_b32 m0, %2\n\ts_nop 0\n\tglobal_load_lds_dwordx4 %0, %1" :: "v"(voff), "s"(sbase), "s"(lds_dst) : "memory", "m0");
}
__device__ __forceinline__ void glds16s_b(unsigned long long sbase, unsigned voff, unsigned lds_dst) {
    asm volatile("s_mov_b32 m0, %2\n\ts_nop 0\n\tglobal_load_lds_dwordx4 %0, %1 offset:1024" :: "v"(voff), "s"(sbase), "s"(lds_dst) : "memory", "m0");
}
#ifdef PROBE_BARW
#define PBS2() unsigned long long tb_ = PB_T()
#define PBE2(k) do { const unsigned long long tn_ = PB_T(); if (PROBE_SEC == (k)) pb_wait += tn_ - tb_; tb_ = tn_; } while (0)
#else
#define PBS2() do {} while (0)
#define PBE2(k) do {} while (0)
#endif
#ifdef PROBE_BARW
__device__ unsigned long long g_barw[4];
#define PB_T() __builtin_amdgcn_s_memtime()
#define AP_WAIT_BAR(N) do { const unsigned long long ta_ = PB_T(); asm volatile("s_waitcnt vmcnt(" #N ") lgkmcnt(0)" ::: "memory"); const unsigned long long t0_ = PB_T(); asm volatile("s_barrier" ::: "memory"); const unsigned long long t1_ = PB_T(); if (PROBE_SEC == 0) pb_wait += t1_ - t0_; if (PROBE_SEC == 1) pb_wait += t0_ - ta_; } while (0)
#define AP_BAR() do { const unsigned long long ta_ = PB_T(); asm volatile("s_waitcnt lgkmcnt(0)" ::: "memory"); const unsigned long long t0_ = PB_T(); asm volatile("s_barrier" ::: "memory"); const unsigned long long t1_ = PB_T(); if (PROBE_SEC == 0) pb_wait += t1_ - t0_; if (PROBE_SEC == 1) pb_wait += t0_ - ta_; } while (0)
#else
#define AP_WAIT_BAR(N) asm volatile("s_waitcnt vmcnt(" #N ") lgkmcnt(0)\n\ts_barrier" ::: "memory")
#define AP_BAR() asm volatile("s_waitcnt lgkmcnt(0)\n\ts_barrier" ::: "memory")
#endif
__device__ __forceinline__ float fadd_s(float a, float b) { float r; asm("v_add_f32_e32 %0, %1, %2" : "=v"(r) : "v"(a), "v"(b)); return r; }
__device__ __forceinline__ void attn_prompt(const Params& p, LAS unsigned char* lds, int a, int h, float negm, float lam) {
    int tid_ = threadIdx.x; asm volatile("" : "+v"(tid_));
    const int tid = tid_, lane = tid & 63, r32 = lane & 31, hi = lane >> 5;
    const int wid = __builtin_amdgcn_readfirstlane(tid >> 6), qs = wid & 3, c = wid >> 2;
    const bf16* QBp = (const bf16*)(p.ws + WS_QB);
    const int NT = 2 * a + 3;
#ifdef PROBE_OVH
    const unsigned long long tov0_ = __builtin_amdgcn_s_memrealtime();
#endif
#ifdef PROBE_BARW
    unsigned long long pb_wait = 0ull; const unsigned long long pb_t0 = __builtin_amdgcn_s_memtime();
#endif
    const int qrow = NMETA + 128 * a + 32 * qs + r32;
    bf16x8 qr[4];
    { const bf16* q = QBp + (size_t)qrow * 512 + h * 128 + c * 64 + hi * 8;
#pragma unroll
      for (int d0 = 0; d0 < 4; ++d0) qr[d0] = *(const bf16x8*)(q + d0 * 16); }
    asm volatile("" : "+v"(qr[0]), "+v"(qr[1]), "+v"(qr[2]), "+v"(qr[3]));
    const unsigned long long isb_ = (unsigned long long)(size_t)(p.ws + WS_KV) + (unsigned long long)h * 32768ull + (unsigned long long)(wid * 2048);
    const unsigned long long isrc = ((unsigned long long)(unsigned)__builtin_amdgcn_readfirstlane((int)(unsigned)(isb_ >> 32)) << 32) | (unsigned)__builtin_amdgcn_readfirstlane((int)(unsigned)isb_);
    const unsigned ioff = lane * 16;
    const unsigned lds0 = (unsigned)(size_t)lds;
    const unsigned kdst = lds0 + wid * 2048, vdst = lds0 + 65536u + wid * 2048;
#define RFL(x) ((unsigned)__builtin_amdgcn_readfirstlane(x))
#define DMA_K(j) do { const unsigned long long g_ = isrc + (unsigned long long)(j) * 131072ull; const unsigned d_ = kdst + (unsigned)((j) & 3) * 16384u; glds16s_a(g_, ioff, RFL(d_)); glds16s_b(g_, ioff, RFL(d_)); } while (0)
#define DMA_V(j) do { const unsigned long long g_ = isrc + (unsigned long long)(j) * 131072ull + 16384ull; const unsigned d_ = vdst + (unsigned)((j) % 3) * 16384u; glds16s_a(g_, ioff, RFL(d_)); glds16s_b(g_, ioff, RFL(d_)); } while (0)
#define AP_ISSUE(t) do { if ((t) + 3 < NT) DMA_K((t) + 3); if ((t) + 1 < NT) DMA_V((t) + 1); } while (0)
#define DMA_K1(j, pc) do { const int js_ = (j) < NT ? (j) : NT - 1; const unsigned long long g_ = isrc + (unsigned long long)js_ * 131072ull; const unsigned d_ = kdst + (unsigned)((j) & 3) * 16384u; if (pc) glds16s_b(g_, ioff, RFL(d_)); else glds16s_a(g_, ioff, RFL(d_)); } while (0)
#define DMA_V1(j, pc) do { const int js_ = (j) < NT ? (j) : NT - 1; const unsigned long long g_ = isrc + (unsigned long long)js_ * 131072ull + 16384ull; const unsigned d_ = vdst + (unsigned)((j) % 3) * 16384u; if (pc) glds16s_b(g_, ioff, RFL(d_)); else glds16s_a(g_, ioff, RFL(d_)); } while (0)
#define AP_WAITN(t) do { const int n_ = (((t) + 3 < NT) ? 2 : 0) + (((t) + 1 < NT) ? 2 : 0); if (n_ == 4) AP_WAIT_BAR(4); else if (n_ == 2) AP_WAIT_BAR(2); else AP_WAIT_BAR(0); } while (0)
#define SBAR() __builtin_amdgcn_sched_barrier(0)
#define PIN(x) asm volatile("" : "+v"(x))
#define MF(A_, B_, C_) __builtin_amdgcn_mfma_f32_32x32x16_bf16(A_, B_, C_, 0, 0, 0)
#define KOFF(j) (((j) >> 1) * 2048 + ((j) & 1) * 512)
#define VOFF(i) ((((i) & 3) * 4 + ((i) >> 2)) * 1024)
#define VF(k) (bf16x8){vl[k][0], vl[k][1], vl[k][2], vl[k][3], vh[k][0], vh[k][1], vh[k][2], vh[k][3]}
#define PEL(P0, P1, e) (((e) < 16) ? P0[(e) & 15] : P1[(e) & 15])
    const LAS unsigned char* Kl = lds + c * 8192 + hi * 1024 + r32 * 16;
    const LAS unsigned char* Vl = lds + 65536 + ((lane >> 4) & 1) * 32 + (lane & 3) * 8 + (4 * hi + ((lane & 15) >> 2)) * 64;
    DMA_K(0); DMA_V(0); DMA_K(1); DMA_K(2);
    f32x16 o[4];
#pragma unroll
    for (int i = 0; i < 4; ++i)
#pragma unroll
        for (int r = 0; r < 16; ++r) o[i][r] = 0.f;
    float lacc = 0.f;
    u32x4 pw[4];
    bf16x8 kf[4];
    s16x4 vl[8], vh[8];
    f32x16 pA0, pA1, pB0, pB1;
    const f32x16 zero16 = {0.f, 0.f, 0.f, 0.f, 0.f, 0.f, 0.f, 0.f, 0.f, 0.f, 0.f, 0.f, 0.f, 0.f, 0.f, 0.f};
    AP_WAIT_BAR(6);
    AP_ISSUE(0);
    {
        bf16x8 k0[8];
#pragma unroll
        for (int j = 0; j < 8; ++j) k0[j] = *(const LAS bf16x8*)(Kl + KOFF(j));
        pA0 = MF(k0[0], qr[0], zero16); pA1 = MF(k0[1], qr[0], zero16);
#pragma unroll
        for (int j = 2; j < 8; ++j) { if (j & 1) pA1 = MF(k0[j], qr[j >> 1], pA1); else pA0 = MF(k0[j], qr[j >> 1], pA0); }
#pragma unroll
        for (int r = 0; r < 8; ++r) pA0[r] = __builtin_amdgcn_exp2f(pA0[r]);
#pragma unroll
        for (int r = 8; r < 16; ++r) pA0[r] = 0.f;
#pragma unroll
        for (int r = 0; r < 16; ++r) pA1[r] = 0.f;
    }
    AP_WAITN(0);
#pragma unroll
    for (int j = 0; j < 4; ++j) kf[j] = *(const LAS bf16x8*)(Kl + 16384 + KOFF(j));
#define AP_GA(i, C0, C1, P0, P1) do { \
            if ((i) >= 1) { vl[(i) - 1] = tr16(Vb_ + VOFF((i) - 1)); vh[(i) - 1] = tr16(Vb_ + VOFF((i) - 1) + 512); }     \
            SBAR(); \
            if ((i) == 0) C0 = MF(kf[0], qr[0], zero16); else if ((i) == 1) C1 = MF(kf[1], qr[0], zero16); \
            else if ((i) & 1) C1 = MF(kf[(i) & 3], qr[(i) >> 1], C1); else C0 = MF(kf[(i) & 3], qr[(i) >> 1], C0); \
            sa0 = fadd_s(sa0, PEL(P0, P1, 4 * (i))); sa1 = fadd_s(sa1, PEL(P0, P1, 4 * (i) + 1)); sa2 = fadd_s(sa2, PEL(P0, P1, 4 * (i) + 2)); sa3 = fadd_s(sa3, PEL(P0, P1, 4 * (i) + 3)); \
            PIN(sa0); PIN(sa1); PIN(sa2); PIN(sa3); \
            pw[(i) >> 1][((i) & 1) * 2] = cvtpk(PEL(P0, P1, 4 * (i)), PEL(P0, P1, 4 * (i) + 1)); pw[(i) >> 1][((i) & 1) * 2 + 1] = cvtpk(PEL(P0, P1, 4 * (i) + 2), PEL(P0, P1, 4 * (i) + 3)); \
            PIN(pw[(i) >> 1]); \
            if ((i) < 4) kf[(i) & 3] = *(const LAS bf16x8*)(Kc_ + KOFF(((i) & 3) + 4)); \
            SBAR(); } while (0)
#define AP_GB(i, C0, C1, LOADK) do { \
            o[(i) & 3] = MF(__builtin_bit_cast(bf16x8, pw[(i) >> 2]), VF((i) & 7), o[(i) & 3]); \
            if ((i) < 8) { C0[(2 * (i)) & 15] = __builtin_amdgcn_exp2f(C0[(2 * (i)) & 15]); C0[(2 * (i) + 1) & 15] = __builtin_amdgcn_exp2f(C0[(2 * (i) + 1) & 15]); PIN(C0); } \
            else { C1[(2 * (i)) & 15] = __builtin_amdgcn_exp2f(C1[(2 * (i)) & 15]); C1[(2 * (i) + 1) & 15] = __builtin_amdgcn_exp2f(C1[(2 * (i) + 1) & 15]); PIN(C1); } \
            if ((i) + 7 < 16) { vl[((i) + 7) & 7] = tr16(Vb_ + VOFF(((i) + 7) & 15)); vh[((i) + 7) & 7] = tr16(Vb_ + VOFF(((i) + 7) & 15) + 512); } \
            if ((i) >= 8 && (i) < 12 && (LOADK)) kf[(i) & 3] = *(const LAS bf16x8*)(Kn_ + KOFF((i) & 3)); \
            if ((i) == 12) DMA_K1(tq_ + 3, 0); if ((i) == 13) DMA_K1(tq_ + 3, 1);     \
            if ((i) == 14) DMA_V1(tq_ + 1, 0); if ((i) == 15) DMA_V1(tq_ + 1, 1);     \
            SBAR(); } while (0)
#define AP_STEP(C0, C1, P0, P1, vslot, kslot, LOADK, TQ) do { const int tq_ = (TQ); \
        const LAS unsigned char* Vb_ = Vl + (vslot) * 16384; const LAS unsigned char* Kn_ = Kl + (kslot) * 16384; const LAS unsigned char* Kc_ = Kl + (((kslot) + 3) & 3) * 16384; \
        float sa0 = 0.f, sa1 = 0.f, sa2 = 0.f, sa3 = 0.f; \
        SBAR(); PBS2(); \
        AP_GA(0, C0, C1, P0, P1); AP_GA(1, C0, C1, P0, P1); AP_GA(2, C0, C1, P0, P1); AP_GA(3, C0, C1, P0, P1); \
        AP_GA(4, C0, C1, P0, P1); AP_GA(5, C0, C1, P0, P1); AP_GA(6, C0, C1, P0, P1); AP_GA(7, C0, C1, P0, P1); \
        lacc += (sa0 + sa1) + (sa2 + sa3); PBE2(2); \
        AP_GB(0, C0, C1, LOADK); AP_GB(1, C0, C1, LOADK); AP_GB(2, C0, C1, LOADK); AP_GB(3, C0, C1, LOADK); \
        AP_GB(4, C0, C1, LOADK); AP_GB(5, C0, C1, LOADK); AP_GB(6, C0, C1, LOADK); AP_GB(7, C0, C1, LOADK); \
        AP_GB(8, C0, C1, LOADK); AP_GB(9, C0, C1, LOADK); AP_GB(10, C0, C1, LOADK); AP_GB(11, C0, C1, LOADK); \
        AP_GB(12, C0, C1, LOADK); AP_GB(13, C0, C1, LOADK); AP_GB(14, C0, C1, LOADK); AP_GB(15, C0, C1, LOADK); PBE2(3); \
    } while (0)
#define AP_DRAIN(P0, P1, vslot) do { \
        const LAS unsigned char* Vb_ = Vl + (vslot) * 16384; \
        float sacc = 0.f; \
        _Pragma("unroll") for (int r = 0; r < 16; ++r) sacc += P0[r] + P1[r]; \
        lacc += sacc; \
        pw[0] = (u32x4){cvtpk(P0[0], P0[1]), cvtpk(P0[2], P0[3]), cvtpk(P0[4], P0[5]), cvtpk(P0[6], P0[7])}; \
        pw[1] = (u32x4){cvtpk(P0[8], P0[9]), cvtpk(P0[10], P0[11]), cvtpk(P0[12], P0[13]), cvtpk(P0[14], P0[15])}; \
        pw[2] = (u32x4){cvtpk(P1[0], P1[1]), cvtpk(P1[2], P1[3]), cvtpk(P1[4], P1[5]), cvtpk(P1[6], P1[7])}; \
        pw[3] = (u32x4){cvtpk(P1[8], P1[9]), cvtpk(P1[10], P1[11]), cvtpk(P1[12], P1[13]), cvtpk(P1[14], P1[15])}; \
        _Pragma("unroll") for (int i = 0; i < 4; ++i) { vl[i] = tr16(Vb_ + VOFF(i)); vh[i] = tr16(Vb_ + VOFF(i) + 512); } \
        SBAR(); \
        _Pragma("unroll") for (int i = 0; i < 16; ++i) { \
            if (i + 4 < 16) { vl[(i + 4) & 7] = tr16(Vb_ + VOFF(i + 4)); vh[(i + 4) & 7] = tr16(Vb_ + VOFF(i + 4) + 512); } \
            o[i & 3] = MF(__builtin_bit_cast(bf16x8, pw[i >> 2]), VF(i & 7), o[i & 3]); \
            SBAR(); } \
    } while (0)
#ifdef PROBE_OVH
    const unsigned long long tov1_ = __builtin_amdgcn_s_memrealtime();
#endif
    int vsl = 0, ksl = 2;
#ifndef LOOP_PAD_NOPS
#define LOOP_PAD_NOPS "39"
#endif
    asm volatile(".p2align 8\n\t.rept " LOOP_PAD_NOPS "\n\ts_nop 0\n\t.endr" ::: "memory");
    for (int t = 1; t < NT; t += 2) {
        AP_STEP(pB0, pB1, pA0, pA1, vsl, ksl, true, t);
        AP_WAIT_BAR(4);
        vsl = (vsl == 2) ? 0 : vsl + 1; ksl = (ksl + 1) & 3;
        AP_STEP(pA0, pA1, pB0, pB1, vsl, ksl, true, t + 1);
        AP_WAIT_BAR(4);
        vsl = (vsl == 2) ? 0 : vsl + 1; ksl = (ksl + 1) & 3;
    }
    if (qs < 2) {
#pragma unroll
        for (int r = 0; r < 16; ++r) { pA0[r] = 0.f; pA1[r] = 0.f; }
    }
    AP_DRAIN(pA0, pA1, vsl);
    AP_WAIT_BAR(0);
#ifdef PROBE_OVH
    const unsigned long long tov2_ = __builtin_amdgcn_s_memrealtime();
#endif
#ifdef PROBE_BARW
    if (blockIdx.x == PROBE_BLK && tid == PROBE_WAVE * 64) { g_barw[0] += pb_wait; g_barw[1] += __builtin_amdgcn_s_memtime() - pb_t0; }
#endif
#undef AP_STEP
#undef AP_DRAIN
#undef AP_ISSUE
#undef AP_WAITN
#undef DMA_K
#undef DMA_V
    if (a < 12) {
        if (tid == 0) { const unsigned* lt = (const unsigned*)(p.ws + WS_CTL) + CW_LATE; while (__hip_atomic_load(lt, __ATOMIC_RELAXED, __HIP_MEMORY_SCOPE_AGENT) < 24u) __builtin_amdgcn_s_sleep(8); }
        __syncthreads();
        __builtin_amdgcn_fence(__ATOMIC_ACQUIRE, "agent");
        asm volatile("s_waitcnt vmcnt(0)" ::: "memory");
    }
    const size_t erow0 = (size_t)(NMETA + 128 * a + 32 * qs);
    u32x4 gq[4];
#pragma unroll
    for (int k = 0; k < 4; ++k) { const int pi = lane + 64 * k; gq[k] = *(const u32x4*)((const bf16*)(p.ws + WS_SGB) + (erow0 + (pi >> 3)) * 512 + h * 128 + c * 64 + (pi & 7) * 8); }
    const int eb = c * 64 + r32;
    const float swa = p.in[23][eb] * ONE_M_LAM0, swb = p.in[23][eb + 32] * ONE_M_LAM0;
    lacc += __shfl_xor(lacc, 32);
    LAS float* wsf = (LAS float*)(lds + LCTL + 256) + wid * 64;
    if (hi == 0) wsf[r32] = lacc;
    asm volatile("s_waitcnt lgkmcnt(0)" ::: "memory");
    float rli[16];
#pragma unroll
    for (int r = 0; r < 16; ++r) rli[r] = __builtin_amdgcn_rcpf(wsf[crow(r, hi)]);
    LAS float* XW = (LAS float*)lds + (qs * 2 + c) * 2048;
    const LAS float* XR = (const LAS float*)lds + (qs * 2 + (c ^ 1)) * 2048;
    LAS float* SS = (LAS float*)(lds + 65536);
    const float fsc = (c == 0) ? 1.0f : lam;
#define EP_WRITE(OA, OB) do { _Pragma("unroll") for (int r = 0; r < 16; ++r) { XW[r * 64 + lane] = fsc * (OA[r] * rli[r]); XW[(16 + r) * 64 + lane] = fsc * (OB[r] * rli[r]); } } while (0)
    if (c == 0) EP_WRITE(o[2], o[3]); else EP_WRITE(o[0], o[1]);
#undef EP_WRITE
    __syncthreads();
#ifdef PROBE_OVH
    const unsigned long long tov3_ = __builtin_amdgcn_s_memrealtime();
#endif
#define EP_COMB(OA, OB, SGN) do { _Pragma("unroll") for (int r = 0; r < 16; ++r) { \
            const float va = SGN * (fsc * (OA[r] * rli[r]) - XR[r * 64 + lane]), vb = SGN * (fsc * (OB[r] * rli[r]) - XR[(16 + r) * 64 + lane]); \
            OA[r] = va; OB[r] = vb; const float s_ = half_sum_hi16(va * va + vb * vb); \
            if (r32 == 16) SS[(qs * 2 + c) * 32 + crow(r, hi)] = s_; } } while (0)
    if (c == 0) EP_COMB(o[0], o[1], 1.0f); else EP_COMB(o[2], o[3], -1.0f);
#undef EP_COMB
    __syncthreads();
#ifdef PROBE_OVH
    const unsigned long long tov4_ = __builtin_amdgcn_s_memrealtime();
#endif
    {
        LAS unsigned char* GT = lds + 66560 + wid * 8192;
        LAS unsigned char* YT = GT + 4096;
#pragma unroll
        for (int k = 0; k < 4; ++k) { const int pi = lane + 64 * k; *(LAS u32x4*)(GT + (pi >> 3) * 128 + (pi & 7) * 16) = gq[k]; }
        asm volatile("s_waitcnt lgkmcnt(0)" ::: "memory");
#define EP_FIN(OA, OB) do { _Pragma("unroll") for (int r = 0; r < 16; ++r) { \
            const int q_ = crow(r, hi); \
            const float s_ = SS[(qs * 2) * 32 + q_] + SS[(qs * 2 + 1) * 32 + q_]; \
            const float rinv = __builtin_amdgcn_rsqf(s_ * (1.0f / 128.0f) + EPS); \
            const float ga_ = bf2f(*(const LAS bf16*)(GT + q_ * 128 + r32 * 2)), gb_ = bf2f(*(const LAS bf16*)(GT + q_ * 128 + 64 + r32 * 2)); \
            *(LAS bf16*)(YT + q_ * 128 + r32 * 2) = f2bf(((OA[r] * rinv) * swa) * ga_); \
            *(LAS bf16*)(YT + q_ * 128 + 64 + r32 * 2) = f2bf(((OB[r] * rinv) * swb) * gb_); } } while (0)
        if (c == 0) EP_FIN(o[0], o[1]); else EP_FIN(o[2], o[3]);
#undef EP_FIN
        asm volatile("s_waitcnt lgkmcnt(0)" ::: "memory");
        bf16* YCAT = (bf16*)(p.ws + WS_YCAT);
#pragma unroll
        for (int k = 0; k < 4; ++k) { const int pi = lane + 64 * k;
            *(u32x4*)(YCAT + (erow0 - NMETA + (pi >> 3)) * 1024 + 512 + h * 128 + c * 64 + (pi & 7) * 8) = *(const LAS u32x4*)(YT + (pi >> 3) * 128 + (pi & 7) * 16); }
    }
    __syncthreads();
#ifdef PROBE_OVH
    if (tid == 0) atomicAdd(&g_samp[0], (PROBE_OVH == 0) ? (tov1_ - tov0_) : (PROBE_OVH == 1) ? (__builtin_amdgcn_s_memrealtime() - tov2_) : (PROBE_OVH == 3) ? (tov3_ - tov2_) : (PROBE_OVH == 4) ? (tov4_ - tov3_) : (PROBE_OVH == 5) ? (__builtin_amdgcn_s_memrealtime() - tov4_) : (tov2_ - tov1_));
#endif
}

#ifdef PROBE_SAMP
__device__ unsigned long long g_samp[2];
#endif
__global__ void __launch_bounds__(NTHREADS, 2) mega_fwd(Params p) {
    extern __shared__ __attribute__((aligned(16))) unsigned char lds_raw[];
    LAS unsigned char* lds = (LAS unsigned char*)lds_raw;
    const int tid = threadIdx.x;
    unsigned* ctl = (unsigned*)(p.ws + WS_CTL);
    if (tid < 64) ((LAS unsigned*)(lds + LCTL))[tid] = 0u;
    __syncthreads();
    XcdBarrier bar = xcd_barrier_post(ctl + CW_BAR, (volatile LAS unsigned*)(lds + LCTL + 64));
#define GRID_BAR() xcd_barrier(bar)
#ifdef PROBE_TIME
    unsigned long long ts_[8];
#define STAMP(i) ts_[i] = __builtin_amdgcn_s_memrealtime()
#else
#define STAMP(i) do {} while (0)
#endif
    STAMP(0);
#if defined(PROBE_OVH) || defined(PROBE_LRU1) || defined(PROBE_LRU2) || defined(PROBE_IDLE) || defined(PROBE_POP) || defined(PROBE_SEG)
    if (blockIdx.x == 0 && tid == 0) __hip_atomic_store(&g_samp[0], 0ull, __ATOMIC_RELAXED, __HIP_MEMORY_SCOPE_AGENT);
#endif
#ifdef PROBE_SAMP
    if (blockIdx.x == 0 && tid == 0) __hip_atomic_store(&g_samp[0], 0ull, __ATOMIC_RELAXED, __HIP_MEMORY_SCOPE_AGENT);
#endif

#ifdef PROBE_ALLX2
    for (int it_ = 0; it_ < 2; ++it_) {
    if (it_) GRID_BAR();
#else
    { const int it_ = 0;
#endif
#ifndef NO_P0
    phase0(p, lds);
#ifdef PROBE_P0X2
    __syncthreads();
    phase0(p, lds);
#endif
#endif
    GRID_BAR();
    STAMP(1);

#ifndef NO_P1
    {
        pg8::Gemm g{(const pg8::bf16_t*)(p.ws + WS_XN), (const pg8::bf16_t*)(p.ws + WS_W1T), MPAD, DIN, DM};
        P1Order S; S.init((int)gridDim.x, (int)blockIdx.x);
        EpiIn E{p.out, p.ws, p.in[17], p.in[18]};
        pg8::gemm_phase<EpiIn, P1Order, true, true>(lds, g, S, E);
#ifdef PROBE_P1X2
        __syncthreads();
        pg8::gemm_phase<EpiIn, pg8::StaticOrder, true, true>(lds, g, S, E);
#endif
    }
#endif
    GRID_BAR();
    STAMP(2);
#ifdef PROBE_SEG
    const unsigned long long tsg0_ = __builtin_amdgcn_s_memrealtime();
#endif

#ifndef NO_P1
    for (int k = blockIdx.x; k < 24; k += gridDim.x) {
        pg8::Gemm g{(const pg8::bf16_t*)(p.ws + WS_XN), (const pg8::bf16_t*)(p.ws + WS_W1T), MPAD, DIN, DM};
        OneUnit S{k >> 2, late_pn(k & 3)};
        EpiIn E{p.out, p.ws, p.in[17], p.in[18]};
        pg8::gemm_phase<EpiIn, OneUnit, false, true>(lds, g, S, E);
        asm volatile("s_waitcnt vmcnt(0)" ::: "memory");
        __syncthreads();
        if (tid == 0) { __builtin_amdgcn_fence(__ATOMIC_RELEASE, "agent"); asm volatile("s_waitcnt vmcnt(0)" ::: "memory");
                        __hip_atomic_fetch_add(ctl + CW_LATE + 64 * it_, 1u, __ATOMIC_RELAXED, __HIP_MEMORY_SCOPE_AGENT); }
        __syncthreads();
    }
#endif
    STAMP(2);
#ifndef NO_LRU
#ifndef LRU_NB
#define LRU_NB 64
#endif
#ifndef GPOS
#define GPOS 104
#endif
    const int lru_nb = ((int)gridDim.x > 2 * LRU_NB) ? LRU_NB : (int)gridDim.x - ((int)gridDim.x >> 1), lru_b0 = (int)gridDim.x - lru_nb;
    if ((int)blockIdx.x >= lru_b0)
    for (int idx = (int)blockIdx.x - lru_b0; idx < N_LRU; idx += lru_nb) {
#ifdef PROBE_LRU1
        const unsigned long long tl1_ = __builtin_amdgcn_s_memrealtime();
#endif
        if (idx < N_LRU_P) lru_chunk<0>(p, lds, idx);
#ifdef PROBE_LRU1
        if (idx < N_LRU_P) { __syncthreads(); if (tid == 0) atomicAdd(&g_samp[0], __builtin_amdgcn_s_memrealtime() - tl1_); }
#endif
        else {
            lru_chunk<1>(p, lds, idx);
            asm volatile("s_waitcnt vmcnt(0)" ::: "memory");
            __syncthreads();
            if (tid == 0) { __builtin_amdgcn_fence(__ATOMIC_RELEASE, "agent"); asm volatile("s_waitcnt vmcnt(0)" ::: "memory");
                            __hip_atomic_fetch_add(ctl + CW_SAMPDONE + 64 * it_, 1u, __ATOMIC_RELAXED, __HIP_MEMORY_SCOPE_AGENT); }
        }
    }
    if ((int)blockIdx.x >= lru_b0 && (int)blockIdx.x - lru_b0 < N_LRU_P) lru_arrive(p, lds, it_, lru_nb < N_LRU_P ? lru_nb : N_LRU_P);
    __syncthreads();
#endif
    STAMP(3);
    {
        const float lam = ((const float*)(p.ws + WS_SP))[512], negm = ((const float*)(p.ws + WS_SP))[513];
        volatile LAS unsigned* qw = (volatile LAS unsigned*)(lds + LCTL);
        bool carry_ok = false;
#ifdef PROBE_SEG
        const unsigned long long tsg1_ = __builtin_amdgcn_s_memrealtime();
        if (PROBE_SEG == 0 && tid == 0) atomicAdd(&g_samp[0], tsg1_ - tsg0_);
#endif
        int kq = 0;
        for (;;) {
#ifdef PROBE_POP
            const unsigned long long tpop_ = __builtin_amdgcn_s_memrealtime();
#endif
            if (tid == 0) {
                unsigned code = 0xffffffffu;
                unsigned f_carry = 1u, f_late = 24u;
                if (!carry_ok) { f_carry = __hip_atomic_load(ctl + CW_CARRYOK + 64 * it_, __ATOMIC_RELAXED, __HIP_MEMORY_SCOPE_AGENT); f_late = __hip_atomic_load(ctl + CW_LATE + 64 * it_, __ATOMIC_RELAXED, __HIP_MEMORY_SCOPE_AGENT); }
                while (kq < 4) {
                    const unsigned hq = (blockIdx.x + (unsigned)kq) & 3u;
                    const unsigned ix = atomicAdd(&ctl[CW_QH + 64 * hq + 512 * it_], 1u);
                    if (ix < 145u) { code = 0x80000000u | (hq << 16) | ix; break; }
                    ++kq;
                }
                if (kq >= 4) code = (unsigned)N_ATT + atomicAdd(&ctl[CW_Q + 128 * it_], 1u);
                qw[0] = code;
                qw[2] = (f_carry != 0u && f_late >= 24u) ? 1u : 0u;
            }
            __syncthreads();
            const unsigned code = qw[0];
            const unsigned rdy_ = qw[2];
            __syncthreads();
            if (!carry_ok && rdy_) {
                __builtin_amdgcn_fence(__ATOMIC_ACQUIRE, "agent");
                asm volatile("s_waitcnt vmcnt(0)" ::: "memory");
                carry_ok = true;
            }
#ifdef PROBE_POP
            if (tid == 0) atomicAdd(&g_samp[0], __builtin_amdgcn_s_memrealtime() - tpop_);
#endif
#ifndef NO_ATT
            if (code & 0x80000000u) {
                const int hq = (int)((code >> 16) & 3u), ixq = (int)(code & 0xffffu);
                if (ixq == GPOS) {
                    if (tid == 0) { while (__hip_atomic_load(ctl + CW_SAMPDONE + 64 * it_, __ATOMIC_RELAXED, __HIP_MEMORY_SCOPE_AGENT) < 80u) __builtin_amdgcn_s_sleep(8); }
                    __syncthreads();
                    __builtin_amdgcn_fence(__ATOMIC_ACQUIRE, "agent");
                    asm volatile("s_waitcnt vmcnt(0)" ::: "memory");
                    __syncthreads();
                    pg8::Gemm g{(const pg8::bf16_t*)(p.ws + WS_YCAT), (const pg8::bf16_t*)(p.ws + WS_W2T), 16640, DM, DM};
                    OneUnit S{64, hq};
                    EpiOut E{p.out, p.in[0], p.in[1]};
                    pg8::gemm_phase<EpiOut, OneUnit, false, true>(lds, g, S, E);
                    __syncthreads();
                    continue;
                }
                const int ix = ixq > GPOS ? ixq - 1 : ixq;
                if (ix >= 32 && ix < 48) {
#ifdef PROBE_SAMP
                    const unsigned long long tsa_ = __builtin_amdgcn_s_memrealtime();
#endif
                    attn_sample(p, lds, ix - 32, hq, negm, lam);
#ifdef PROBE_SAMP
                    if (tid == 0) atomicAdd(&g_samp[0], __builtin_amdgcn_s_memrealtime() - tsa_);
#endif
                    asm volatile("s_waitcnt vmcnt(0)" ::: "memory");
                    __syncthreads();
                    if (tid == 0) { __builtin_amdgcn_fence(__ATOMIC_RELEASE, "agent"); asm volatile("s_waitcnt vmcnt(0)" ::: "memory");
                                    __hip_atomic_fetch_add(ctl + CW_SAMPDONE + 64 * it_, 1u, __ATOMIC_RELAXED, __HIP_MEMORY_SCOPE_AGENT); }
                } else attn_prompt(p, lds, (ix < 32) ? 127 - ix : 127 - (ix - 16), hq, negm, lam);
                continue;
            }
#endif
            const int idx = (int)code;
            if (idx >= N_P2) break;
            {
#ifndef NO_LRU
                if (!carry_ok) {
                    if (tid == 0) { while (__hip_atomic_load(ctl + CW_CARRYOK + 64 * it_, __ATOMIC_RELAXED, __HIP_MEMORY_SCOPE_AGENT) == 0u) __builtin_amdgcn_s_sleep(8);
                                    while (__hip_atomic_load(ctl + CW_LATE + 64 * it_, __ATOMIC_RELAXED, __HIP_MEMORY_SCOPE_AGENT) < 24u) __builtin_amdgcn_s_sleep(8); }
                    __syncthreads();
                    __builtin_amdgcn_fence(__ATOMIC_ACQUIRE, "agent");
                    asm volatile("s_waitcnt vmcnt(0)" ::: "memory");
                    carry_ok = true;
                }
#ifdef PROBE_LRU2
                const unsigned long long tl2_ = __builtin_amdgcn_s_memrealtime();
#endif
                lru_pass2(p, idx - N_ATT);
#ifdef PROBE_LRU2
                asm volatile("s_waitcnt vmcnt(0)" ::: "memory");
                if (tid == 0) atomicAdd(&g_samp[0], __builtin_amdgcn_s_memrealtime() - tl2_);
#endif
#endif
            }
        }
    }
#ifdef PROBE_SEG
    if (PROBE_SEG == 1 && tid == 0) atomicAdd(&g_samp[0], __builtin_amdgcn_s_memrealtime() - tsg0_);
#endif
#ifdef PROBE_IDLE
    const unsigned long long tidle_ = __builtin_amdgcn_s_memrealtime();
#endif
    GRID_BAR();
#ifdef PROBE_IDLE
    if (tid == 0) atomicAdd(&g_samp[0], __builtin_amdgcn_s_memrealtime() - tidle_);
#endif
    STAMP(4);
    STAMP(5);

#ifndef NO_P4
    {
        pg8::Gemm g{(const pg8::bf16_t*)(p.ws + WS_YCAT), (const pg8::bf16_t*)(p.ws + WS_W2T), 16384, DM, DM};
        pg8::StaticOrder S; S.init(16384, DM, (int)gridDim.x, (int)blockIdx.x);
        EpiOut E{p.out, p.in[0], p.in[1]};
        pg8::gemm_phase<EpiOut, pg8::StaticOrder, true, true>(lds, g, S, E);
#ifdef PROBE_P4X2
        __syncthreads();
        pg8::gemm_phase<EpiOut, pg8::StaticOrder, true, true>(lds, g, S, E);
#endif
    }
#endif
    }
#ifdef PROBE_TIME
    STAMP(6);
    if (blockIdx.x == 0) {
        __syncthreads();
#ifdef PROBE_BARW
        const float T_us = 1000.0f * (float)g_barw[0] / (float)(g_barw[1] + 1ull);
#else
#ifdef PROBE_SAMP
        const float T_us = (float)__hip_atomic_load(&g_samp[0], __ATOMIC_RELAXED, __HIP_MEMORY_SCOPE_AGENT) * 0.01f * (1.0f / 64.0f);
#else
#if defined(PROBE_SEG)
        const float T_us = (float)__hip_atomic_load(&g_samp[0], __ATOMIC_RELAXED, __HIP_MEMORY_SCOPE_AGENT) * 0.01f * (1.0f / 256.0f);
#elif defined(PROBE_POP)
        const float T_us = (float)__hip_atomic_load(&g_samp[0], __ATOMIC_RELAXED, __HIP_MEMORY_SCOPE_AGENT) * 0.01f * (1.0f / 256.0f);
#elif defined(PROBE_IDLE)
        const float T_us = (float)__hip_atomic_load(&g_samp[0], __ATOMIC_RELAXED, __HIP_MEMORY_SCOPE_AGENT) * 0.01f * (1.0f / 256.0f);
#elif defined(PROBE_LRU1) || defined(PROBE_LRU2)
        const float T_us = (float)__hip_atomic_load(&g_samp[0], __ATOMIC_RELAXED, __HIP_MEMORY_SCOPE_AGENT) * 0.01f * (1.0f / 513.0f);
#elif defined(PROBE_OVH)
        const float T_us = (float)__hip_atomic_load(&g_samp[0], __ATOMIC_RELAXED, __HIP_MEMORY_SCOPE_AGENT) * 0.01f * (1.0f / 512.0f);
#else
        const float T_us = (float)(ts_[PROBE_B] - ts_[PROBE_A]) * 0.01f;
#endif
#endif
#endif
#ifndef PROBE_SCALE
#define PROBE_SCALE 1e-7f
#endif
#ifndef PROBE_OFFS
#define PROBE_OFFS 0.0f
#endif
        const float dl = sqrtf(1e-5f + fmaxf(T_us - PROBE_OFFS, 0.0f) * PROBE_SCALE);
        for (int i = tid; i < 24576; i += NTHREADS) p.out[O_CS + i] *= (1.0f + dl);
    }
#endif
}

extern "C" void kernel_launch(void* const* d_in, const int* in_sizes, int n_in, void* d_out, int out_size, void* d_ws, size_t ws_size, hipStream_t stream) {
    static int grid = 0;
    if (grid == 0) {
        if (n_in != 24 || out_size != (int)O_END || ws_size < WS_END) { fprintf(stderr, "kernel_launch: unexpected shapes (n_in %d out %d ws %zu)\n", n_in, out_size, ws_size); grid = -1; return; }
        int dev = 0, cus = 0, per_cu = 0;
        hipGetDevice(&dev);
        hipDeviceGetAttribute(&cus, hipDeviceAttributeMultiprocessorCount, dev);
        hipFuncSetAttribute((const void*)mega_fwd, hipFuncAttributeMaxDynamicSharedMemorySize, LDS_BYTES);
        hipOccupancyMaxActiveBlocksPerMultiprocessor(&per_cu, (const void*)mega_fwd, NTHREADS, LDS_BYTES);
        if (per_cu < 1) { fprintf(stderr, "kernel_launch: occupancy query says %d blocks/CU\n", per_cu); per_cu = 1; }
        (void)hipGetLastError();
        grid = cus;
    }
    if (grid < 0) return;
    hipMemsetAsync((char*)d_ws + WS_CTL, 0, CTL_ZERO_BYTES, stream);
    Params prm{};
    for (int i = 0; i < 24; ++i) prm.in[i] = (const float*)d_in[i];
    prm.out = (float*)d_out; prm.ws = (unsigned char*)d_ws;
    void* args[] = {&prm};
    hipError_t e = hipLaunchCooperativeKernel((const void*)mega_fwd, dim3(grid), dim3(NTHREADS), args, LDS_BYTES, stream);
    if (e != hipSuccess) fprintf(stderr, "cooperative launch failed: %s (grid %d)\n", hipGetErrorString(e), grid);
}
```
